# Optimizing an MI355X kernel written in HIP

```python
import math
import jax, jax.numpy as jnp
from jax import lax
import numpy as np

D_MODEL = 1024
BATCH = 8
SEQ = 8192
DEPTH = 2

MEM_LEN = 256
D_MIX = D_MODEL
HEAD_DIM = 64
SSM_WIDTH = D_MIX // 4
SSM_GROUP = 16
SSM_GROUPS = SSM_WIDTH // SSM_GROUP
SSM_STATE = 64
CONV_WIDTH = D_MIX // 4
CONV_K = 31
NSA_WIDTH = D_MIX // 2
NSA_HEADS = NSA_WIDTH // HEAD_DIM
NSA_KV_HEADS = 2
NSA_GROUP = NSA_HEADS // NSA_KV_HEADS
N_BRANCH = 3
L_CMP = 32
CMP_STRIDE = 16
L_SEL = 64
N_SELECT = 16
N_LOCAL = 2
WINDOW = 512
NSA_Q_BLOCK = 64
SEL_FORCE = 1e6
T5_BUCKETS = 32
T5_MAX_DIST = 128
X_HEADS = 4
X_WIDTH = X_HEADS * HEAD_DIM
D_FF = 2816
N_EXPERTS = 8
TOP_K = 2
MOE_BLOCK = 256
N_DENSE = (DEPTH + 1) // 2
N_MOE = DEPTH // 2
PROJ_WIDTH = SSM_WIDTH + 2 * CONV_WIDTH + NSA_WIDTH + 6 * NSA_KV_HEADS * HEAD_DIM + N_BRANCH * NSA_HEADS
EPS = 1e-6

kernel_name = "hybrid_s5_conformer_nsa_moe_trunk"


def _rms(x):
    xf = x.astype(jnp.float32)
    return (xf * lax.rsqrt(jnp.mean(xf * xf, axis=-1, keepdims=True) + EPS)).astype(x.dtype)


def rms_norm(x, g):
    return _rms(x) * g


def layer_norm(x, g, b):
    xf = x.astype(jnp.float32)
    mu = jnp.mean(xf, axis=-1, keepdims=True)
    var = jnp.mean(jnp.square(xf - mu), axis=-1, keepdims=True)
    return ((xf - mu) * lax.rsqrt(var + EPS)).astype(x.dtype) * g + b


def masked_softmax(s, mask):
    s = jnp.where(mask, s.astype(jnp.float32), -jnp.inf)
    m = jnp.max(s, axis=-1, keepdims=True)
    m = jnp.where(jnp.isfinite(m), m, 0.0)
    p = jnp.exp(s - m)
    return p / jnp.maximum(jnp.sum(p, axis=-1, keepdims=True), 1e-30)


def t5_bucket(dist):
    n = jnp.maximum(dist, 0)
    max_exact = T5_BUCKETS // 2
    nf = jnp.maximum(n, 1).astype(jnp.float32)
    large = max_exact + (jnp.log(nf / max_exact) / math.log(T5_MAX_DIST / max_exact)
                         * (T5_BUCKETS - max_exact)).astype(jnp.int32)
    large = jnp.minimum(large, T5_BUCKETS - 1)
    return jnp.where(n < max_exact, n, large)


def _complex_linear_combine(e1, e2):
    a1r, a1i, b1r, b1i = e1
    a2r, a2i, b2r, b2i = e2
    return (a1r * a2r - a1i * a2i,
            a1r * a2i + a1i * a2r,
            a2r * b1r - a2i * b1i + b2r,
            a2r * b1i + a2i * b1r + b2i)


def s5_mixer(u, lam_re, lam_im, log_dt, b_re, b_im, c_re, c_im, d_skip, w_glu):
    bsz, seq, _ = u.shape
    dt = jnp.exp(log_dt.astype(jnp.float32))[:, None]
    lr, li = lam_re.astype(jnp.float32), lam_im.astype(jnp.float32)
    mag = jnp.exp(lr * dt)
    ar, ai = mag * jnp.cos(li * dt), mag * jnp.sin(li * dt)
    den = lr * lr + li * li
    fr = ((ar - 1.0) * lr + ai * li) / den
    fi = (ai * lr - (ar - 1.0) * li) / den
    bbr = fr[..., None] * b_re - fi[..., None] * b_im
    bbi = fr[..., None] * b_im + fi[..., None] * b_re
    ug = u.reshape(bsz, seq, SSM_GROUPS, SSM_GROUP).astype(jnp.float32)
    bur = jnp.einsum('bsgh,gph->bsgp', ug, bbr)
    bui = jnp.einsum('bsgh,gph->bsgp', ug, bbi)
    a_r = jnp.broadcast_to(ar, (1, seq, SSM_GROUPS, SSM_STATE))
    a_i = jnp.broadcast_to(ai, (1, seq, SSM_GROUPS, SSM_STATE))
    _, _, xr, xi = lax.associative_scan(_complex_linear_combine, (a_r, a_i, bur, bui), axis=1)
    y = (jnp.einsum('bsgp,ghp->bsgh', xr, c_re) - jnp.einsum('bsgp,ghp->bsgh', xi, c_im)
         + d_skip * ug)
    y = y.reshape(bsz, seq, SSM_WIDTH).astype(u.dtype)
    a, g = jnp.split(jax.nn.gelu(y) @ w_glu, 2, axis=-1)
    return a * jax.nn.sigmoid(g)


def conv_mixer(z, w_dw, b_dw, ln_g, ln_b, w_pw):
    a, g = jnp.split(z, 2, axis=-1)
    v = a * jax.nn.sigmoid(g)
    y = lax.conv_general_dilated(v, w_dw[:, None, :], window_strides=(1,),
                                 padding=[(CONV_K - 1, 0)],
                                 dimension_numbers=('NWC', 'WIO', 'NWC'),
                                 feature_group_count=CONV_WIDTH) + b_dw
    y = jax.nn.silu(layer_norm(y, ln_g, ln_b))
    return y @ w_pw


def nsa_compress(kv, pe, w1, w2):
    seq = kv.shape[2]
    n_cmp = (seq - L_CMP) // CMP_STRIDE + 1
    idx = jnp.arange(n_cmp)[:, None] * CMP_STRIDE + jnp.arange(L_CMP)[None, :]
    blocks = kv[:, :, idx] + pe
    flat = blocks.reshape(blocks.shape[0], blocks.shape[1], n_cmp, L_CMP * HEAD_DIM)
    return jax.nn.gelu(flat @ w1) @ w2


def cmp_to_sel_overlap(n_cmp, n_sel):
    cs = jnp.arange(n_cmp) * CMP_STRIDE
    ss = jnp.arange(n_sel) * L_SEL
    ov = jnp.minimum(cs[:, None] + L_CMP, ss[None, :] + L_SEL) - jnp.maximum(cs[:, None], ss[None, :])
    return jnp.maximum(ov, 0).astype(jnp.float32) / L_CMP


def nsa_mixer(q, k_c, v_c, k_s, v_s, k_w, v_w, gate_logits, q_gain, k_gain, cmp_pe, cmp_w1, cmp_w2, t5_table):
    bsz, seq, _ = q.shape
    qb = NSA_Q_BLOCK
    q = rms_norm(q.reshape(bsz, seq, NSA_HEADS, HEAD_DIM), q_gain)
    q = q.reshape(bsz, seq, NSA_KV_HEADS, NSA_GROUP, HEAD_DIM).transpose(0, 2, 3, 1, 4)

    def kv_heads(t):
        return t.reshape(bsz, seq, NSA_KV_HEADS, HEAD_DIM).transpose(0, 2, 1, 3)

    k_cmp = rms_norm(nsa_compress(kv_heads(k_c), cmp_pe[0], cmp_w1[0], cmp_w2[0]), k_gain[0])
    v_cmp = nsa_compress(kv_heads(v_c), cmp_pe[1], cmp_w1[1], cmp_w2[1])
    n_cmp = k_cmp.shape[2]
    n_sel = seq // L_SEL
    k_sel = min(N_SELECT, n_sel)
    k_slc = rms_norm(kv_heads(k_s), k_gain[1]).reshape(bsz, NSA_KV_HEADS, n_sel, L_SEL, HEAD_DIM)
    v_slc = kv_heads(v_s).reshape(bsz, NSA_KV_HEADS, n_sel, L_SEL, HEAD_DIM)
    pad = ((0, 0), (0, 0), (WINDOW, 0), (0, 0))
    k_win = jnp.pad(rms_norm(kv_heads(k_w), k_gain[2]), pad)
    v_win = jnp.pad(kv_heads(v_w), pad)
    gates = jax.nn.sigmoid(gate_logits.reshape(bsz, seq, NSA_KV_HEADS, NSA_GROUP, N_BRANCH)
                           .astype(jnp.float32)).astype(q.dtype).transpose(0, 2, 3, 1, 4)
    overlap = cmp_to_sel_overlap(n_cmp, n_sel)
    table_kg = t5_table.T.reshape(NSA_KV_HEADS, NSA_GROUP, T5_BUCKETS)
    cmp_end = jnp.arange(n_cmp) * CMP_STRIDE + (L_CMP - 1)
    sel_blk = jnp.arange(n_sel)
    b_ix = jnp.arange(bsz)[:, None, None, None]
    h_ix = jnp.arange(NSA_KV_HEADS)[None, :, None, None]
    kv_ix = jnp.arange(NSA_KV_HEADS)[None, :, None, None, None]
    g_ix = jnp.arange(NSA_GROUP)[None, None, :, None, None]
    scale = HEAD_DIM ** -0.5

    def shared_bias(dist):
        return jnp.moveaxis(t5_table[t5_bucket(dist)], -1, 0).reshape(NSA_KV_HEADS, NSA_GROUP, *dist.shape)

    def block(c):
        start = c * qb
        t = start + jnp.arange(qb)
        qc = lax.dynamic_slice_in_dim(q, start, qb, axis=3)
        gc = lax.dynamic_slice_in_dim(gates, start, qb, axis=3)
        dist_c = t[:, None] - cmp_end[None, :]
        s_c = jnp.einsum('bkgqd,bknd->bkgqn', qc, k_cmp).astype(jnp.float32) * scale + shared_bias(dist_c)
        p_c = masked_softmax(s_c, dist_c >= 0)
        o_c = jnp.einsum('bkgqn,bknd->bkgqd', p_c.astype(v_cmp.dtype), v_cmp)
        imp = jnp.einsum('bkgqn,nj->bkqj', p_c, overlap)
        blk_t = (t // L_SEL)[:, None]
        forced = (sel_blk[None, :] == 0) | (sel_blk[None, :] > blk_t - N_LOCAL)
        imp = jnp.where(sel_blk[None, :] > blk_t, -jnp.inf, jnp.where(forced, SEL_FORCE, imp))
        top_val, top_idx = lax.top_k(imp, k_sel)
        k_g = k_slc[b_ix, h_ix, top_idx].reshape(bsz, NSA_KV_HEADS, qb, k_sel * L_SEL, HEAD_DIM)
        v_g = v_slc[b_ix, h_ix, top_idx].reshape(bsz, NSA_KV_HEADS, qb, k_sel * L_SEL, HEAD_DIM)
        pos = (top_idx[..., None] * L_SEL + jnp.arange(L_SEL)).reshape(bsz, NSA_KV_HEADS, qb, k_sel * L_SEL)
        dist_s = t[:, None] - pos
        mask_s = (dist_s >= 0) & jnp.repeat(jnp.isfinite(top_val), L_SEL, axis=-1)
        bias_s = table_kg[kv_ix, g_ix, t5_bucket(dist_s)[:, :, None]]
        s_s = jnp.einsum('bkgqd,bkqsd->bkgqs', qc, k_g).astype(jnp.float32) * scale + bias_s
        p_s = masked_softmax(s_s, mask_s[:, :, None])
        o_s = jnp.einsum('bkgqs,bkqsd->bkgqd', p_s.astype(v_g.dtype), v_g)
        kw = lax.dynamic_slice_in_dim(k_win, start, WINDOW + qb, axis=2)
        vw = lax.dynamic_slice_in_dim(v_win, start, WINDOW + qb, axis=2)
        s_pos = start - WINDOW + jnp.arange(WINDOW + qb)
        dist_w = t[:, None] - s_pos[None, :]
        mask_w = (dist_w >= 0) & (dist_w < WINDOW) & (s_pos[None, :] >= 0)
        s_w = jnp.einsum('bkgqd,bknd->bkgqn', qc, kw).astype(jnp.float32) * scale + shared_bias(dist_w)
        p_w = masked_softmax(s_w, mask_w)
        o_w = jnp.einsum('bkgqn,bknd->bkgqd', p_w.astype(vw.dtype), vw)
        return gc[..., 0:1] * o_c + gc[..., 1:2] * o_s + gc[..., 2:3] * o_w

    out = lax.map(block, jnp.arange(seq // qb))
    return out.transpose(1, 0, 4, 2, 3, 5).reshape(bsz, seq, NSA_WIDTH)


def cross_attention(hn, memn, w_q, w_kv, q_gain, k_gain, w_o):
    bsz, seq, _ = hn.shape
    q = rms_norm((hn @ w_q).reshape(bsz, seq, X_HEADS, HEAD_DIM), q_gain)
    k, v = jnp.split(memn @ w_kv, 2, axis=-1)
    k = rms_norm(k.reshape(bsz, -1, X_HEADS, HEAD_DIM), k_gain)
    v = v.reshape(bsz, -1, X_HEADS, HEAD_DIM)
    s = jnp.einsum('bshd,bmhd->bhsm', q, k).astype(jnp.float32) * HEAD_DIM ** -0.5
    p = jax.nn.softmax(s, axis=-1).astype(v.dtype)
    o = jnp.einsum('bhsm,bmhd->bshd', p, v).reshape(bsz, seq, X_WIDTH)
    return o @ w_o


def swiglu(x, w_up, w_down):
    g, v = jnp.split(x @ w_up, 2, axis=-1)
    return (jax.nn.silu(g) * v) @ w_down


def moe_swiglu(x2, w_router, w_up, w_down):
    n_tok, d = x2.shape
    logits = (x2 @ w_router).astype(jnp.float32)
    top_val, top_idx = lax.top_k(logits, TOP_K)
    gate = jax.nn.softmax(top_val, axis=-1)
    e_flat = top_idx.reshape(-1)
    tok_flat = jnp.repeat(jnp.arange(n_tok), TOP_K)
    g_flat = gate.reshape(-1)
    n_asg = e_flat.shape[0]
    order = jnp.argsort(e_flat)
    e_s, tok_s, g_s = e_flat[order], tok_flat[order], g_flat[order]
    counts = jnp.bincount(e_flat, length=N_EXPERTS)
    padded = (counts + MOE_BLOCK - 1) // MOE_BLOCK * MOE_BLOCK
    start_s = jnp.cumsum(counts) - counts
    pad_end = jnp.cumsum(padded)
    start_p = pad_end - padded
    dest = start_p[e_s] + (jnp.arange(n_asg) - start_s[e_s])
    n_rows = (n_asg + MOE_BLOCK - 1) // MOE_BLOCK * MOE_BLOCK + N_EXPERTS * MOE_BLOCK
    row_tok = jnp.full((n_rows,), n_tok, jnp.int32).at[dest].set(tok_s)
    row_gate = jnp.zeros((n_rows,), jnp.float32).at[dest].set(g_s)
    n_blk = n_rows // MOE_BLOCK
    blk_exp = jnp.minimum(jnp.searchsorted(pad_end, jnp.arange(n_blk) * MOE_BLOCK, side='right'), N_EXPERTS - 1)
    x_pad = jnp.concatenate([x2, jnp.zeros((1, d), x2.dtype)], axis=0)
    xb = x_pad[row_tok].reshape(n_blk, MOE_BLOCK, d)

    def expert_block(args):
        xblk, e = args
        return swiglu(xblk, w_up[e], w_down[e])

    yb = lax.map(expert_block, (xb, blk_exp)).reshape(n_rows, d)
    y = yb * row_gate[:, None].astype(yb.dtype)
    return jax.ops.segment_sum(y, row_tok, num_segments=n_tok + 1)[:n_tok].astype(x2.dtype)


def setup_inputs(seed: int = 0) -> dict:
    key = jax.random.key(seed)
    ks = iter(jax.random.split(key, 40))
    f32 = jnp.float32
    L = DEPTH

    def nrm(shape, scale):
        return jax.random.normal(next(ks), shape, f32) * scale

    def gain(shape):
        return 1.0 + nrm(shape, 0.02)

    inp = {}
    inp['x'] = nrm((BATCH, SEQ, D_MODEL), 1.0)
    inp['mem'] = nrm((BATCH, MEM_LEN, D_MODEL), 1.0)
    inp['norm_mix'] = gain((L, D_MODEL))
    inp['w_in'] = nrm((L, D_MODEL, PROJ_WIDTH), D_MODEL ** -0.5)
    inp['ssm_lambda_re'] = -0.5 + nrm((L, SSM_GROUPS, SSM_STATE), 0.01)
    inp['ssm_lambda_im'] = math.pi * jnp.arange(SSM_STATE, dtype=f32) + nrm((L, SSM_GROUPS, SSM_STATE), 0.01)
    inp['ssm_log_dt'] = jax.random.uniform(next(ks), (L, SSM_GROUPS), f32, math.log(1e-3), math.log(1e-1))
    inp['ssm_b_re'] = nrm((L, SSM_GROUPS, SSM_STATE, SSM_GROUP), (2 * SSM_GROUP) ** -0.5)
    inp['ssm_b_im'] = nrm((L, SSM_GROUPS, SSM_STATE, SSM_GROUP), (2 * SSM_GROUP) ** -0.5)
    inp['ssm_c_re'] = nrm((L, SSM_GROUPS, SSM_GROUP, SSM_STATE), SSM_STATE ** -0.5)
    inp['ssm_c_im'] = nrm((L, SSM_GROUPS, SSM_GROUP, SSM_STATE), SSM_STATE ** -0.5)
    inp['ssm_d'] = nrm((L, SSM_GROUPS, SSM_GROUP), 1.0)
    inp['ssm_w_glu'] = nrm((L, SSM_WIDTH, 2 * SSM_WIDTH), SSM_WIDTH ** -0.5)
    inp['conv_w_dw'] = nrm((L, CONV_K, CONV_WIDTH), CONV_K ** -0.5)
    inp['conv_b_dw'] = nrm((L, CONV_WIDTH), 0.02)
    inp['conv_ln_g'] = gain((L, CONV_WIDTH))
    inp['conv_ln_b'] = nrm((L, CONV_WIDTH), 0.02)
    inp['conv_w_pw'] = nrm((L, CONV_WIDTH, CONV_WIDTH), CONV_WIDTH ** -0.5)
    inp['nsa_q_norm'] = gain((L, HEAD_DIM))
    inp['nsa_k_norm'] = gain((L, N_BRANCH, HEAD_DIM))
    inp['nsa_cmp_pe'] = nrm((L, 2, L_CMP, HEAD_DIM), 0.1)
    inp['nsa_cmp_w1'] = nrm((L, 2, L_CMP * HEAD_DIM, HEAD_DIM), (L_CMP * HEAD_DIM) ** -0.5)
    inp['nsa_cmp_w2'] = nrm((L, 2, HEAD_DIM, HEAD_DIM), HEAD_DIM ** -0.5)
    inp['mix_out_norm'] = gain((L, D_MIX))
    inp['w_out'] = nrm((L, D_MIX, D_MODEL), D_MIX ** -0.5)
    inp['t5_table'] = nrm((T5_BUCKETS, NSA_HEADS), 0.5)
    inp['norm_cross'] = gain((L, D_MODEL))
    inp['norm_mem'] = gain((L, D_MODEL))
    inp['x_w_q'] = nrm((L, D_MODEL, X_WIDTH), D_MODEL ** -0.5)
    inp['x_w_kv'] = nrm((L, D_MODEL, 2 * X_WIDTH), D_MODEL ** -0.5)
    inp['x_q_norm'] = gain((L, HEAD_DIM))
    inp['x_k_norm'] = gain((L, HEAD_DIM))
    inp['x_w_o'] = nrm((L, X_WIDTH, D_MODEL), X_WIDTH ** -0.5)
    inp['norm_ffn'] = gain((L, D_MODEL))
    inp['ffn_w_up'] = nrm((N_DENSE, D_MODEL, 2 * D_FF), D_MODEL ** -0.5)
    inp['ffn_w_down'] = nrm((N_DENSE, D_FF, D_MODEL), D_FF ** -0.5)
    inp['moe_router'] = nrm((N_MOE, D_MODEL, N_EXPERTS), D_MODEL ** -0.5)
    inp['moe_w_up'] = nrm((N_MOE, N_EXPERTS, D_MODEL, 2 * D_FF), D_MODEL ** -0.5)
    inp['moe_w_down'] = nrm((N_MOE, N_EXPERTS, D_FF, D_MODEL), D_FF ** -0.5)
    return inp


def reference(x, mem, norm_mix, w_in, ssm_lambda_re, ssm_lambda_im, ssm_log_dt, ssm_b_re, ssm_b_im,
              ssm_c_re, ssm_c_im, ssm_d, ssm_w_glu, conv_w_dw, conv_b_dw, conv_ln_g, conv_ln_b, conv_w_pw,
              nsa_q_norm, nsa_k_norm, nsa_cmp_pe, nsa_cmp_w1, nsa_cmp_w2, mix_out_norm, w_out, t5_table,
              norm_cross, norm_mem, x_w_q, x_w_kv, x_q_norm, x_k_norm, x_w_o, norm_ffn, ffn_w_up, ffn_w_down,
              moe_router, moe_w_up, moe_w_down):
    bsz, seq, d = x.shape
    kv_w = NSA_KV_HEADS * HEAD_DIM
    cuts = [int(c) for c in np.cumsum([SSM_WIDTH, 2 * CONV_WIDTH, NSA_WIDTH] + [kv_w] * 6)]
    h = x
    for layer in range(DEPTH):
        z = rms_norm(h, norm_mix[layer]) @ w_in[layer]
        u_ssm, z_conv, q, k_c, v_c, k_s, v_s, k_w, v_w, g_nsa = jnp.split(z, cuts, axis=-1)
        y_ssm = s5_mixer(u_ssm, ssm_lambda_re[layer], ssm_lambda_im[layer], ssm_log_dt[layer],
                         ssm_b_re[layer], ssm_b_im[layer], ssm_c_re[layer], ssm_c_im[layer],
                         ssm_d[layer], ssm_w_glu[layer])
        y_conv = conv_mixer(z_conv, conv_w_dw[layer], conv_b_dw[layer], conv_ln_g[layer],
                            conv_ln_b[layer], conv_w_pw[layer])
        y_nsa = nsa_mixer(q, k_c, v_c, k_s, v_s, k_w, v_w, g_nsa, nsa_q_norm[layer], nsa_k_norm[layer],
                          nsa_cmp_pe[layer], nsa_cmp_w1[layer], nsa_cmp_w2[layer], t5_table)
        y = jnp.concatenate([_rms(y_ssm), _rms(y_conv), _rms(y_nsa)], axis=-1) * mix_out_norm[layer]
        h = h + y @ w_out[layer]
        h = h + cross_attention(rms_norm(h, norm_cross[layer]), rms_norm(mem, norm_mem[layer]),
                                x_w_q[layer], x_w_kv[layer], x_q_norm[layer], x_k_norm[layer], x_w_o[layer])
        hn = rms_norm(h, norm_ffn[layer])
        if layer % 2 == 0:
            h = h + swiglu(hn, ffn_w_up[layer // 2], ffn_w_down[layer // 2])
        else:
            h = h + moe_swiglu(hn.reshape(bsz * seq, d), moe_router[layer // 2], moe_w_up[layer // 2],
                               moe_w_down[layer // 2]).reshape(bsz, seq, d)
    return h
```

```cpp
#include <hip/hip_runtime.h>
#include <cstdio>
#include <cstdint>
#include <cmath>

#define LAS __attribute__((address_space(3)))
#define GAS __attribute__((address_space(1)))
#define DI __device__ __forceinline__
typedef unsigned short bf16_t;
typedef short bf16x8 __attribute__((ext_vector_type(8)));
typedef float f32x2 __attribute__((ext_vector_type(2)));
typedef float f32x4 __attribute__((ext_vector_type(4)));
typedef float f32x16 __attribute__((ext_vector_type(16)));
typedef unsigned u32x2 __attribute__((ext_vector_type(2)));
typedef unsigned u32x4 __attribute__((ext_vector_type(4)));
typedef __bf16 bf16x2_t __attribute__((ext_vector_type(2)));
typedef unsigned long long u64;

#ifndef WOUT_F8
#define WOUT_F8 2
#endif
constexpr int NB = 8, SEQ = 8192, DM = 1024, MTOK = NB * SEQ;
constexpr int MEMLEN = 256, MMEM = NB * MEMLEN;
constexpr int NLAYER = 2;
constexpr int SSMW = 256, SSMG = 16, SSMH = 16, SSMP = 64;
constexpr int CHL = 64, NCHUNK = MTOK / CHL;
constexpr int SKX = CHL * SSMH + 2 * SSMP;
constexpr int CONVW = 256, CONVK = 31;
constexpr int NSAW = 512, NQH = 8, NKVH = 2, HD = 64;
constexpr int NCMP = 511, NCMPP = 512, NSEL = 128;
constexpr int PROJW = 2072, PROJP = 2304;
constexpr int XW = 256, DFF = 2816, NEXP = 8;
constexpr int MOEROWS = MTOK + NEXP * 256;
constexpr float EPS = 1e-6f;
constexpr float LOG2E = 1.4426950408889634f;
constexpr float QSCALE = 0.125f * LOG2E;
constexpr float SS_FIX = 16777216.0f;

constexpr size_t MiB = 1u << 20;
constexpr size_t WS_CTL = 0, CTL_ZERO_BYTES = 8 * MiB;
constexpr size_t CTL_BAR = 64 * 1024;
constexpr size_t CTL_SS = 1 * MiB;
constexpr size_t CTL_SSMEM = 5 * MiB;
constexpr size_t CTL_MOE = 6 * MiB;
constexpr size_t WS_W = 8 * MiB;
constexpr size_t W_IN = WS_W;
constexpr size_t W_GLU = W_IN + (size_t)NLAYER * PROJP * DM * 2;
constexpr size_t W_PW = W_GLU + (size_t)NLAYER * 512 * 256 * 2;
constexpr size_t W_OUT = W_PW + (size_t)NLAYER * 256 * 256 * 2;
constexpr size_t W_XQ = W_OUT + (size_t)NLAYER * DM * DM * 2;
constexpr size_t W_XKV = W_XQ + (size_t)NLAYER * XW * DM * 2;
constexpr size_t W_XO = W_XKV + (size_t)NLAYER * 2 * XW * DM * 2;
constexpr size_t W_UP = W_XO + (size_t)NLAYER * DM * XW * 2;
constexpr size_t W_DN = W_UP + (size_t)2 * DFF * DM * 2;
constexpr size_t W_MUP = W_DN + (size_t)DM * DFF * 2;
constexpr size_t W_MDN = W_MUP + (size_t)NEXP * 2 * DFF * DM * 2;
constexpr size_t W_ST = W_MDN + (size_t)NEXP * DM * DFF * 2;
constexpr size_t W_SZ = W_ST + (size_t)NLAYER * SSMG * 1024 * SKX * 2;
constexpr size_t W_C1 = W_SZ + (size_t)NLAYER * SSMG * 256 * 1024 * 2;
constexpr size_t W_C2 = W_C1 + (size_t)NLAYER * 2 * 64 * 2048 * 2;
constexpr size_t W_END = W_C2 + (size_t)NLAYER * 2 * 64 * 64 * 2;
constexpr size_t WS_TAB = (W_END + MiB - 1) / MiB * MiB;
constexpr size_t T_KTAB = WS_TAB;
constexpr size_t T_CB = T_KTAB + 2 * MiB;
constexpr size_t T_BIAS = T_CB + 4096;
constexpr size_t T_BND = T_BIAS + 6144;
constexpr size_t T_A64 = T_BIAS + 8192;
constexpr size_t T_KM = T_A64 + 32768;
constexpr size_t T_VMT = T_KM + 2 * MiB;
constexpr size_t T_MEMB = T_VMT + 2 * MiB;
constexpr size_t T_ROUTE = T_MEMB + 4 * MiB;
constexpr size_t T_END = T_ROUTE + 4 * MiB;
constexpr size_t WS_HB = (T_END + MiB - 1) / MiB * MiB;
constexpr size_t WS_ACT = WS_HB + (size_t)MTOK * DM * 2;
constexpr size_t A_UX = WS_ACT;
constexpr size_t A_CVIN = A_UX + (size_t)SSMG * NCHUNK * SKX * 2;
constexpr size_t A_Q = A_CVIN + (size_t)MTOK * 256 * 2;
constexpr size_t A_KC = A_Q + (size_t)MTOK * 512 * 2;
constexpr size_t A_VC = A_KC + (size_t)MTOK * 128 * 2 + 4096;
constexpr size_t A_KS = A_VC + (size_t)MTOK * 128 * 2 + 4096;
constexpr size_t A_KW = A_KS + (size_t)MTOK * 128 * 2;
constexpr size_t A_VST = A_KW + (size_t)MTOK * 128 * 2;
constexpr size_t A_VWT = A_VST + (size_t)MTOK * 128 * 2;
constexpr size_t A_GATE = A_VWT + (size_t)MTOK * 128 * 2;
constexpr size_t A_OC = A_GATE + (size_t)MTOK * 24 * 4;
constexpr size_t A_OS = A_OC + (size_t)MTOK * 512 * 2;
constexpr size_t A_OW = A_OS + (size_t)MTOK * 512 * 2;
constexpr size_t A_ZC = A_OW + (size_t)MTOK * 512 * 2;
constexpr size_t A_YG = A_ZC + (size_t)SSMG * NCHUNK * 128 * 4;
constexpr size_t A_YSSM = A_YG + (size_t)MTOK * 256 * 2;
constexpr size_t A_CV = A_YSSM + (size_t)MTOK * 256 * 2;
constexpr size_t A_YCONV = A_CV + (size_t)MTOK * 256 * 2;
constexpr size_t A_KCMP = A_YCONV + (size_t)MTOK * 256 * 2;
constexpr size_t A_VCMPT = A_KCMP + 1 * MiB;
constexpr size_t A_SEL = A_VCMPT + 1 * MiB;
constexpr size_t A_MIXEND = A_SEL + 2 * MiB;
constexpr size_t A_AMIX = A_Q;
static_assert(A_AMIX + (size_t)MTOK * DM * 2 <= A_VST, "AMIX overlay");
constexpr size_t A_QX = WS_ACT;
constexpr size_t A_OX = A_QX + (size_t)MTOK * 256 * 2;
constexpr size_t A_FFA = A_OX + (size_t)MTOK * 256 * 2;
constexpr size_t A_XB = A_FFA + (size_t)MOEROWS * DFF;
constexpr size_t A_H8 = A_XB + (size_t)MOEROWS * DM;
constexpr size_t A_FFEND = A_H8 + (size_t)MTOK * DM;
constexpr size_t WS_END = (A_MIXEND > A_FFEND ? A_MIXEND : A_FFEND);
static_assert(WS_END <= (size_t)1024 * MiB, "d_ws map must fit 1 GiB");

DI unsigned cvtpk(float lo, float hi) { f32x2 v = {lo, hi}; bf16x2_t b = __builtin_convertvector(v, bf16x2_t); return __builtin_bit_cast(unsigned, b); }
DI bf16_t f2bf(float f) { return (bf16_t)(cvtpk(f, 0.f) & 0xffffu); }
DI float bf2f(bf16_t h) { return __uint_as_float((unsigned)h << 16); }
DI float bflo(unsigned w) { return __uint_as_float(w << 16); }
DI float bfhi(unsigned w) { return __uint_as_float(w & 0xffff0000u); }
#define DPPF(v, ctrl) __builtin_bit_cast(float, __builtin_amdgcn_mov_dpp(__builtin_bit_cast(int, (v)), (ctrl), 0xF, 0xF, true))
DI float dpp_sum16(float v) {
    v += DPPF(v, 0xB1); v += DPPF(v, 0x4E); v += DPPF(v, 0x141); v += DPPF(v, 0x140); return v;
}
DI float wave_sum(float v) { v = dpp_sum16(v); v += __shfl_xor(v, 16); v += __shfl_xor(v, 32); return v; }
DI float rcpf_(float x) { return __builtin_amdgcn_rcpf(x); }
DI float gelu_tanh(float x) { const float u = 0.7978845608028654f * (x + 0.044715f * x * x * x); const float e = __expf(-2.f * u); return x * rcpf_(1.f + e); }
DI float sigmoidf_(float x) { return rcpf_(1.f + __expf(-x)); }
DI float siluf_(float x) { return x * rcpf_(1.f + __expf(-x)); }
constexpr float W8_SCALE = 32.0f;
typedef int v8i_t __attribute__((ext_vector_type(8)));
DI unsigned pack_fp8x4(float a, float b, float c, float d) { unsigned w = 0u; w = __builtin_amdgcn_cvt_pk_fp8_f32(a, b, w, false); w = __builtin_amdgcn_cvt_pk_fp8_f32(c, d, w, true); return w; }
DI int perm_kv(int s) { return (s & ~12) | ((s & 4) << 1) | ((s & 8) >> 1); }
#define LDS_WAIT() asm volatile("s_waitcnt lgkmcnt(0)" ::: "memory")
#define VM_WAIT() asm volatile("s_waitcnt vmcnt(0)" ::: "memory")
#define XB_TMO      128
#define XB_XCNT(j)  (256  + 64 * (j))
#define XB_XSUB(j)  (1280 + 64 * (j))
#define XB_XGEN(j)  (2304 + 64 * (j))
#define XB_TOP      3328
#define XB_TOPGEN   3392
#define XCD_BAR_WORDS 3456
#define XB_SPIN_CAP (1u << 18)

__device__ __forceinline__ unsigned xb_ld(unsigned* p)              { return __hip_atomic_load(p, __ATOMIC_RELAXED, __HIP_MEMORY_SCOPE_AGENT); }
__device__ __forceinline__ unsigned xb_add(unsigned* p, unsigned v) { return __hip_atomic_fetch_add(p, v, __ATOMIC_RELAXED, __HIP_MEMORY_SCOPE_AGENT); }
__device__ __forceinline__ unsigned xb_xcc_id() { return (unsigned)__builtin_amdgcn_s_getreg((3 << 11) | 20) & 0xFu; }
#define XB_SPIN(cond, bar) do { unsigned _sp = 0; while (cond) { __builtin_amdgcn_s_sleep(1); \
    if ((++_sp & 255u) == 0u) { if (xb_ld(&(bar)[XB_TMO])) break; if (_sp > XB_SPIN_CAP) { atomicAdd(&(bar)[XB_TMO], 1u); break; } } } } while (0)

struct XcdBarrier {
    unsigned* bar; unsigned x;
    volatile LAS unsigned* st;
};

__device__ __forceinline__ XcdBarrier xcd_barrier_post(unsigned* bar, volatile LAS unsigned* st) {
    XcdBarrier b; b.bar = bar; b.x = xb_xcc_id(); b.st = st;
    if (threadIdx.x == 0) (void)xb_add(&bar[XB_XCNT(b.x)], 1u);
    return b;
}
__device__ __forceinline__ void xcd_barrier_complete(unsigned* bar, unsigned x, unsigned& nloc, unsigned& nx) {
    const unsigned G = gridDim.x * gridDim.y * gridDim.z;
    unsigned sum, cnt, mine, sp = 0u;
    for (;;) {
        sum = 0u; cnt = 0u; mine = 0u;
#pragma unroll
        for (unsigned j = 0; j < 16; ++j) { const unsigned c = xb_ld(&bar[XB_XCNT(j)]); sum += c; cnt += (c > 0u) ? 1u : 0u; mine = (j == x) ? c : mine; }
        if (sum == G) break;
        __builtin_amdgcn_s_sleep(1);
        if ((++sp & 255u) == 0u) { if (xb_ld(&bar[XB_TMO])) break; if (sp > XB_SPIN_CAP) { atomicAdd(&bar[XB_TMO], 1u); break; } }
    }
    nloc = mine > 0u ? mine : 1u; nx = cnt > 0u ? cnt : 1u;
}

__device__ __forceinline__ void xcd_barrier(const XcdBarrier& b) {
    asm volatile("s_waitcnt vmcnt(0)" ::: "memory");
    __syncthreads();
    if (threadIdx.x == 0) {
        unsigned* bar = b.bar;
        __builtin_amdgcn_s_waitcnt(0);
        unsigned nloc = b.st[0], nx = b.st[1];
        if (nloc == 0u) { xcd_barrier_complete(bar, b.x, nloc, nx); b.st[0] = nloc; b.st[1] = nx; }
        const unsigned old = xb_add(&bar[XB_XSUB(b.x)], 1u);
        const unsigned gen = old / nloc;
        if (old + 1u == (gen + 1u) * nloc) {
            __builtin_amdgcn_fence(__ATOMIC_RELEASE, "agent");
            asm volatile("s_waitcnt vmcnt(0)" ::: "memory");
            const unsigned og = xb_add(&bar[XB_TOP], 1u);
            const unsigned tg = og / nx;
            if (og + 1u == (tg + 1u) * nx) xb_add(&bar[XB_TOPGEN], 1u);
            else XB_SPIN(xb_ld(&bar[XB_TOPGEN]) == tg, bar);
            __builtin_amdgcn_fence(__ATOMIC_ACQUIRE, "agent");
            xb_add(&bar[XB_XGEN(b.x)], 1u);
            asm volatile("s_waitcnt vmcnt(0)" ::: "memory");
        } else {
            XB_SPIN(xb_ld(&bar[XB_XGEN(b.x)]) == gen, bar);
            __builtin_amdgcn_fence(__ATOMIC_ACQUIRE, "agent");
            asm volatile("s_waitcnt vmcnt(0)" ::: "memory");
        }
    }
    __syncthreads();
}
namespace pg8 {
constexpr int BM = 256, BK = 64, HALF = 128, HTB = HALF * BK * 2  , STAGE_BYTES = 8 * HTB, NXCD = 8, WGM = 8;

DI int lds_byte(int r, int c) { const int st = (r >> 4) * 2 + (c >> 5), rr = r & 15, cc = c & 31, ob = rr * 64 + cc * 2; return st * 1024 + (ob ^ (((ob >> 9) & 1) << 5)); }
DI void stage_rc(int b, int& R, int& C) { const int st = b / 1024, sb = b % 1024, swz = sb ^ (((sb >> 9) & 1) << 5); R = (st >> 1) * 16 + swz / 64; C = (st & 1) * 32 + (swz % 64) / 2; }
DI int perm32(int rho) { const int n = rho >> 4, i = rho & 15; return 8 * (i >> 2) + 4 * n + (i & 3); }

struct Unit { int pm, pn, g; const char* A; const char* B; };
struct Gemm { int K, lda, ldb; };

struct TileOrder {
    int nM, nN, ngrp, nwg, G, c; const char* A; const char* B; size_t tA, tB, gA, gB;
    DI void init(int nM_, int nN_, int ngrp_, int G_, int c_, const void* A_, size_t tA_, size_t gA_, const void* B_, size_t tB_, size_t gB_) {
        nM = nM_; nN = nN_; ngrp = ngrp_; nwg = nM * nN; G = G_; c = c_; A = (const char*)A_; B = (const char*)B_; tA = tA_; tB = tB_; gA = gA_; gB = gB_; }
    DI bool next(int i, Unit& u) const {
        const long L = (long)i * G + c; if (L >= (long)nwg * ngrp) return false;
        const int grp = (int)(L / nwg); int wgid = (int)(L % nwg);
        if ((nwg % NXCD) == 0 && (G % NXCD) == 0) { const int q = nwg / NXCD, xcd = wgid % NXCD, off = wgid / NXCD; wgid = xcd * q + off; }
        const int nig = WGM * nN, gid = wgid / nig, fm = gid * WGM, gsz = (nM - fm) < WGM ? (nM - fm) : WGM;
        u.pm = fm + ((wgid % nig) % gsz); u.pn = (wgid % nig) / gsz; u.g = grp;
        u.A = A + (size_t)grp * gA + (size_t)u.pm * tA; u.B = B + (size_t)grp * gB + (size_t)u.pn * tB; return true;
    }
};

template <class Epi, class Sched, bool ALIGN_EPI, bool F8 = false>
DI void gemm_phase(LAS unsigned char* lds, const Gemm g, const Sched& S, const Epi& E, const int tid) {
    const int wid = __builtin_amdgcn_readfirstlane(tid >> 6), lane = tid & 63, wr = wid >> 2, wc = wid & 3, fr = lane & 15, fq = lane >> 4;
    const int K = g.K, nt = K / BK;
    unsigned voffA[2], voffB[2];
#pragma unroll
    for (int i = 0; i < 2; ++i) { int R, C; stage_rc(tid * 16 + i * 8192, R, C); const int Rb = Epi::PERM ? ((R & ~31) + perm32(R & 31)) : R;
        voffA[i] = (unsigned)(R * g.lda + C) * 2u; voffB[i] = (unsigned)(Rb * g.ldb + C) * 2u; }
    const size_t kstep = (size_t)(BK * 2);
    const size_t hstepA = (size_t)HALF * g.lda * 2, hstepB = (size_t)HALF * g.ldb * 2;
    const unsigned ldsw = (unsigned)wid * 1024u;
    const int aoff = lds_byte(wr * 64 + fr, fq * 8), boff = lds_byte(wc * 32 + fr, fq * 8);
#define PG8_SA(b, h) (((b) * 2 + (h)) * HTB)
#define PG8_SB(b, h) ((4 + (b) * 2 + (h)) * HTB)
#define PG8_STAGE(bufoff, gbase, voff) do { _Pragma("unroll") for (int _i = 0; _i < 2; ++_i) \
        __builtin_amdgcn_global_load_lds((const unsigned*)((const char*)(gbase) + (voff)[_i]), (LAS unsigned*)(lds + (bufoff) + ldsw + _i * 8192), 16, 0, 0); } while (0)
#define PG8_LD8(addr) __builtin_bit_cast(v8i_t, __builtin_shufflevector(*(const LAS u32x4*)(addr), *(const LAS u32x4*)((addr) + 1024), 0, 1, 2, 3, 4, 5, 6, 7))
#define PG8_LDA(dst, b, h) do { _Pragma("unroll") for (int m = 0; m < 4; ++m) { if constexpr (F8) dst##8[m] = PG8_LD8(lds + PG8_SA(b, h) + aoff + m * 2048); \
        else { _Pragma("unroll") for (int k = 0; k < 2; ++k) dst[m][k] = *(const LAS bf16x8*)(lds + PG8_SA(b, h) + aoff + m * 2048 + k * 1024); } } } while (0)
#define PG8_LDB(dst, b, h) do { _Pragma("unroll") for (int n = 0; n < 2; ++n) { if constexpr (F8) dst##8[n] = PG8_LD8(lds + PG8_SB(b, h) + boff + n * 2048); \
        else { _Pragma("unroll") for (int k = 0; k < 2; ++k) dst[n][k] = *(const LAS bf16x8*)(lds + PG8_SB(b, h) + boff + n * 2048 + k * 1024); } } } while (0)
#define PG8_MMA(ai, bj, At, Bt) do { __builtin_amdgcn_s_setprio(1); _Pragma("unroll") for (int m = 0; m < 4; ++m) _Pragma("unroll") for (int n = 0; n < 2; ++n) { \
        if constexpr (F8) asm volatile("v_mfma_scale_f32_16x16x128_f8f6f4 %0, %1, %2, %0, %3, %3 op_sel_hi:[0,0,0]" : "+v"(acc[ai][bj][m][n]) : "v"(Bt##8[n]), "v"(At##8[m]), "v"(sc8)); \
        else { _Pragma("unroll") for (int k = 0; k < 2; ++k) acc[ai][bj][m][n] = __builtin_amdgcn_mfma_f32_16x16x32_bf16(Bt[n][k], At[m][k], acc[ai][bj][m][n], 0, 0, 0); } } \
        __builtin_amdgcn_s_setprio(0); } while (0)
#define PG8_WAIT_V(n) asm volatile("s_waitcnt vmcnt(" #n ")" ::: "memory")
#define PG8_WAIT_L(n) asm volatile("s_waitcnt lgkmcnt(" #n ")" ::: "memory")
#define PG8_BAR __builtin_amdgcn_s_barrier()
#define PG8_SCHED __builtin_amdgcn_sched_barrier(0)
    unsigned sc8 = 0x7F7F7F7Fu; asm volatile("" : "+v"(sc8));
    Unit cur, nxt; int ui = 0;
    if (!S.next(0, cur)) return;
    f32x4 acc[2][2][4][2];
#pragma unroll
    for (int a = 0; a < 2; ++a)
#pragma unroll
        for (int b = 0; b < 2; ++b)
#pragma unroll
            for (int m = 0; m < 4; ++m)
#pragma unroll
                for (int n = 0; n < 2; ++n) acc[a][b][m][n] = (f32x4){0.f, 0.f, 0.f, 0.f};
    bf16x8 At[F8 ? 1 : 4][2], B0[2][2], B1[2][2]; v8i_t At8[F8 ? 4 : 1], B08[2], B18[2];
    const char* cA = cur.A; const char* cB = cur.B;
    PG8_STAGE(PG8_SB(0, 0), cB, voffB); PG8_STAGE(PG8_SB(0, 1), cB + hstepB, voffB); PG8_STAGE(PG8_SA(0, 0), cA, voffA); PG8_STAGE(PG8_SA(0, 1), cA + hstepA, voffA);
    if (wr == 1) PG8_BAR;
    PG8_WAIT_V(2); PG8_BAR;
    PG8_STAGE(PG8_SB(1, 0), cB + kstep, voffB); PG8_STAGE(PG8_SA(1, 0), cA + kstep, voffA); PG8_STAGE(PG8_SB(1, 1), cB + hstepB + kstep, voffB);
    PG8_WAIT_V(6); PG8_BAR;
    for (;;) {
        const bool has_next = S.next(ui + 1, nxt);
        const char* nA = has_next ? nxt.A : cA; const char* nB = has_next ? nxt.B : cB;
#pragma unroll 1
        for (int t = 0; t < nt; t += 2) {
            const bool last = (t == nt - 2);
            asm volatile("" : "+v"(voffA[0]), "+v"(voffA[1]), "+v"(voffB[0]), "+v"(voffB[1]));
            const char* a1 = cA + (size_t)(t + 1) * kstep;
            const char* a2 = last ? nA : cA + (size_t)(t + 2) * kstep; const char* b2 = last ? nB : cB + (size_t)(t + 2) * kstep;
            const char* a3 = a2 + kstep; const char* b3 = b2 + kstep;
            PG8_LDB(B0, 0, 0); PG8_LDB(B1, 0, 1); PG8_SCHED; PG8_LDA(At, 0, 0); PG8_STAGE(PG8_SA(1, 1), a1 + hstepA, voffA);
            PG8_WAIT_V(8); PG8_WAIT_L(0); PG8_BAR; PG8_MMA(0, 0, At, B0); PG8_MMA(0, 1, At, B1); PG8_BAR; PG8_SCHED;
            PG8_LDA(At, 0, 1); PG8_STAGE(PG8_SB(0, 0), b2, voffB); PG8_STAGE(PG8_SB(0, 1), b2 + hstepB, voffB); PG8_STAGE(PG8_SA(0, 0), a2, voffA);
            PG8_WAIT_V(8); PG8_WAIT_L(0); PG8_BAR; PG8_MMA(1, 0, At, B0); PG8_MMA(1, 1, At, B1); PG8_BAR; PG8_SCHED;
            PG8_LDB(B0, 1, 0); PG8_LDB(B1, 1, 1); PG8_SCHED; PG8_LDA(At, 1, 0); PG8_STAGE(PG8_SA(0, 1), a2 + hstepA, voffA);
            PG8_WAIT_V(8); PG8_WAIT_L(0); PG8_BAR; PG8_MMA(0, 0, At, B0); PG8_MMA(0, 1, At, B1); PG8_BAR; PG8_SCHED;
            PG8_LDA(At, 1, 1); PG8_STAGE(PG8_SB(1, 0), b3, voffB); PG8_STAGE(PG8_SB(1, 1), b3 + hstepB, voffB); PG8_STAGE(PG8_SA(1, 0), a3, voffA);
            PG8_WAIT_V(8); PG8_WAIT_L(0); PG8_BAR; PG8_MMA(1, 0, At, B0); PG8_MMA(1, 1, At, B1); PG8_BAR; PG8_SCHED;
        }
        if constexpr (F8) asm volatile("s_nop 15\n\ts_nop 15\n\ts_nop 15\n\ts_nop 15" ::: "memory");
        if constexpr (ALIGN_EPI) { if (wr == 0) PG8_BAR; }
        if constexpr (!Epi::AFTER_DRAIN) { int fr2 = fr, fq2 = fq; asm volatile("" : "+v"(fr2), "+v"(fq2)); E(acc, cur, wr, wc, fr2, fq2); }
        if (!has_next) break;
#pragma unroll
        for (int a = 0; a < 2; ++a)
#pragma unroll
            for (int b = 0; b < 2; ++b)
#pragma unroll
                for (int m = 0; m < 4; ++m)
#pragma unroll
                    for (int n = 0; n < 2; ++n) acc[a][b][m][n] = (f32x4){0.f, 0.f, 0.f, 0.f};
        cur = nxt; cA = nA; cB = nB; ++ui;
        if constexpr (ALIGN_EPI) { if (wr == 1) PG8_BAR; }
    }
    PG8_WAIT_V(0);
    if constexpr (!ALIGN_EPI) { if (wr == 0) PG8_BAR; }
    PG8_BAR;
    if constexpr (Epi::AFTER_DRAIN) { E.fused(acc, cur, wr, wc, fr, fq, lds, wid, lane); }
#undef PG8_SA
#undef PG8_SB
#undef PG8_STAGE
#undef PG8_LDA
#undef PG8_LDB
#undef PG8_MMA
#undef PG8_LD8
#undef PG8_WAIT_V
#undef PG8_WAIT_L
#undef PG8_BAR
#undef PG8_SCHED
}
}
namespace epi {
using pg8::Unit;
typedef f32x4 Acc[2][2][4][2];
DI float rstd_of(const u64* ss, int row) { return rsqrtf((float)ss[row] * (1.0f / (SS_FIX * 1024.0f)) + EPS); }
DI void rstd8(const u64* ss, int row0, float (&rs)[8]) {
    u64 t[8];
#pragma unroll
    for (int q = 0; q < 8; ++q) t[q] = ss[row0 + (q >> 2) * 128 + (q & 3) * 16];
#pragma unroll
    for (int q = 0; q < 8; ++q) rs[q] = rsqrtf((float)t[q] * (1.0f / (SS_FIX * 1024.0f)) + EPS);
}
DI u32x4 pack8(const f32x4 a, const f32x4 b) { u32x4 w; w.x = cvtpk(a[0], a[1]); w.y = cvtpk(a[2], a[3]); w.z = cvtpk(b[0], b[1]); w.w = cvtpk(b[2], b[3]); return w; }

DI void gains4(const float* gain, int fq, f32x4 (&gvv)[4]) {
#pragma unroll
    for (int bj = 0; bj < 2; ++bj)
#pragma unroll
        for (int n = 0; n < 2; ++n) gvv[2 * bj + n] = *(const f32x4*)(gain + 32 * bj + 8 * fq + 4 * n);
}
template <int MODE>
DI void head_store(const Acc& acc, int ai, int m, float rs, const f32x4 (&gvv)[4], float scale, bf16_t* dst, int fq, int tpitch, int spos) {
    f32x4 v[2][2];
#pragma unroll
    for (int bj = 0; bj < 2; ++bj)
#pragma unroll
        for (int n = 0; n < 2; ++n) v[bj][n] = acc[ai][bj][m][n] * rs;
    if (MODE == 0 || MODE == 3) {
        float s = 0.f;
#pragma unroll
        for (int bj = 0; bj < 2; ++bj)
#pragma unroll
            for (int n = 0; n < 2; ++n) s += (v[bj][n][0] * v[bj][n][0] + v[bj][n][1] * v[bj][n][1]) + (v[bj][n][2] * v[bj][n][2] + v[bj][n][3] * v[bj][n][3]);
        s += __shfl_xor(s, 16); s += __shfl_xor(s, 32);
        const float r2 = rsqrtf(s * (1.0f / 64.0f) + EPS) * scale;
#pragma unroll
        for (int bj = 0; bj < 2; ++bj)
#pragma unroll
            for (int n = 0; n < 2; ++n) v[bj][n] = v[bj][n] * gvv[2 * bj + n] * r2;
    }
    if (MODE == 0 || MODE == 1) {
#pragma unroll
        for (int bj = 0; bj < 2; ++bj) *(u32x4*)(dst + 32 * bj + 8 * fq) = pack8(v[bj][0], v[bj][1]);
    } else if (MODE == 3) {
#pragma unroll
        for (int bj = 0; bj < 2; ++bj) { const int d8 = 32 * bj + 8 * fq, f = 2 * (d8 >> 4) + (spos >> 5), ln = (spos & 31) + 32 * ((d8 >> 3) & 1);
            *(u32x4*)(dst + (f * 64 + ln) * 8) = pack8(v[bj][0], v[bj][1]); }
    } else if (MODE == 4) {
        const int ks = spos >> 4, w = spos & 15, hi_ = (w >> 2) & 1, el = 4 * (w >> 3) + (w & 3);
#pragma unroll
        for (int bj = 0; bj < 2; ++bj)
#pragma unroll
            for (int n = 0; n < 2; ++n)
#pragma unroll
                for (int i = 0; i < 4; ++i) { const int d = 32 * bj + 8 * fq + 4 * n + i; dst[((2 * ks + (d >> 5)) * 64 + (d & 31) + 32 * hi_) * 8 + el] = f2bf(v[bj][n][i]); }
    } else {
        bf16_t* p = dst + (size_t)(8 * fq) * tpitch + perm_kv(spos);
#pragma unroll
        for (int bj = 0; bj < 2; ++bj) {
#pragma unroll
            for (int n = 0; n < 2; ++n)
#pragma unroll
                for (int i = 0; i < 4; ++i) p[(size_t)(4 * n + i) * tpitch] = f2bf(v[bj][n][i]);
            p += (size_t)32 * tpitch; asm volatile("" : "+v"(p) :: "memory");
        }
    }
}

struct EpiWin {
    static constexpr bool PERM = true, AFTER_DRAIN = false;
    const u64* ss; bf16_t *UX, *CVIN, *Q, *KC, *VC, *KS, *KW, *VST, *VWT; float* GATE; const float *qg, *kg;
    DI void operator()(const Acc& acc, const Unit& u, int wr, int wc, int fr, int fq) const {
        const int row0 = u.pm * 256 + wr * 64 + fr;
        float rsv[8]; rstd8(ss, row0, rsv);
        f32x4 gvv[4]; gains4(u.pn == 6 ? kg + 64 : (u.pn == 7 ? kg + 128 : qg), fq, gvv);
#pragma unroll
        for (int ai = 0; ai < 2; ++ai)
#pragma unroll
            for (int m = 0; m < 4; ++m) {
                const int row = row0 + ai * 128 + m * 16; const float rs = rsv[ai * 4 + m];
                const int b = row >> 13, s = row & (SEQ - 1);
                if (u.pn == 0) {
                    const int chunk = row >> 6, tau = row & 63;
#pragma unroll
                    for (int bj = 0; bj < 2; ++bj) { const int ch = 128 * bj + 32 * wc + 8 * fq, g = ch >> 4, h = ch & 15;
                        *(u32x4*)(UX + ((size_t)g * NCHUNK + chunk) * SKX + tau * 16 + h) = pack8(acc[ai][bj][m][0] * rs, acc[ai][bj][m][1] * rs); }
                } else if (u.pn <= 2) {
#pragma unroll
                    for (int bj = 0; bj < 2; ++bj) { const int ch = 128 * (u.pn - 1) + 4 * (16 * bj + 4 * wc + fq);
                        const f32x4 a = acc[ai][bj][m][0] * rs, g = acc[ai][bj][m][1] * rs;
                        u32x2 w; w.x = cvtpk(a[0] * sigmoidf_(g[0]), a[1] * sigmoidf_(g[1])); w.y = cvtpk(a[2] * sigmoidf_(g[2]), a[3] * sigmoidf_(g[3]));
                        *(u32x2*)(CVIN + (size_t)row * 256 + ch) = w; }
                } else if (u.pn <= 4) {
                    const int head = 4 * (u.pn - 3) + wc;
                    head_store<0>(acc, ai, m, rs, gvv, QSCALE, Q + ((size_t)row * 8 + head) * 64, fq, 0, 0);
                } else if (u.pn == 5) {
                    bf16_t* base = (wc >> 1) ? VC : KC;
                    head_store<1>(acc, ai, m, rs, gvv, 1.f, base + ((size_t)(b * 2 + (wc & 1)) * SEQ + s) * 64, fq, 0, 0);
                } else if (u.pn == 6) {
                    const int kvh = wc & 1; const size_t tileb = ((size_t)(b * 2 + kvh) * 128 + (s >> 6)) * 4096;
                    if (wc < 2) head_store<3>(acc, ai, m, rs, gvv, 1.f, KS + tileb, fq, 0, s & 63);
                    else head_store<4>(acc, ai, m, rs, gvv, 1.f, VST + tileb, fq, 0, s & 63);
                } else if (u.pn <= 7) {
                    const int kvh = wc & 1; const size_t plane = (size_t)(b * 2 + kvh) * SEQ * 64;
                    if (wc < 2) head_store<0>(acc, ai, m, rs, gvv, 1.f, KW + plane + (size_t)s * 64, fq, 0, 0);
                    else head_store<2>(acc, ai, m, rs, gvv, 1.f, VWT + plane + (size_t)(s >> 6) * 4096, fq, 64, s & 63);
                } else {
                    if (wc == 0 && fq < 3) {
#pragma unroll
                        for (int n = 0; n < 2; ++n) { const f32x4 v = acc[ai][0][m][n] * rs; f32x4 o; o[0] = sigmoidf_(v[0]); o[1] = sigmoidf_(v[1]); o[2] = sigmoidf_(v[2]); o[3] = sigmoidf_(v[3]);
                            *(f32x4*)(GATE + (size_t)row * 24 + 8 * fq + 4 * n) = o; }
                    }
                }
                asm volatile("" ::: "memory");
            }
    }
};

struct EpiXQ {
    static constexpr bool PERM = true, AFTER_DRAIN = false;
    const u64* ss; bf16_t* QX; const float* qg;
    DI void operator()(const Acc& acc, const Unit& u, int wr, int wc, int fr, int fq) const {
        const int row0 = u.pm * 256 + wr * 64 + fr;
        float rsv[8]; rstd8(ss, row0, rsv);
        f32x4 gvv[4]; gains4(qg, fq, gvv);
#pragma unroll
        for (int ai = 0; ai < 2; ++ai)
#pragma unroll
            for (int m = 0; m < 4; ++m) { const int row = row0 + ai * 128 + m * 16;
                head_store<0>(acc, ai, m, rsv[ai * 4 + m], gvv, QSCALE, QX + ((size_t)row * 4 + wc) * 64, fq, 0, 0); }
    }
};
struct EpiMemKV {
    static constexpr bool PERM = true, AFTER_DRAIN = false;
    const u64* ss; bf16_t *KM, *VMT; const float* kg;
    DI void operator()(const Acc& acc, const Unit& u, int wr, int wc, int fr, int fq) const {
        const int row0 = u.pm * 256 + wr * 64 + fr;
        float rsv[8]; rstd8(ss, row0, rsv);
        f32x4 gvv[4]; gains4(kg + u.g * 64, fq, gvv);
#pragma unroll
        for (int ai = 0; ai < 2; ++ai)
#pragma unroll
            for (int m = 0; m < 4; ++m) { const int row = row0 + ai * 128 + m * 16, b = row >> 8, mm = row & 255; const float rs = rsv[ai * 4 + m];
                const size_t plane = ((size_t)u.g * 32 + b * 4 + wc) * 256 * 64;
                if (u.pn == 0) head_store<0>(acc, ai, m, rs, gvv, 1.f, KM + plane + (size_t)mm * 64, fq, 0, 0);
                else head_store<2>(acc, ai, m, rs, gvv, 1.f, VMT + plane, fq, 256, mm);
                asm volatile("" ::: "memory"); }
    }
};

template <int MODE, bool F8OUT = false> struct EpiGate {
    static constexpr bool PERM = true, AFTER_DRAIN = false;
    bf16_t* O; int ldo; const u64* ss; const int* row_tok;
    DI void operator()(const Acc& acc, const Unit& u, int wr, int wc, int fr, int fq) const {
        const int row0 = u.pm * 256 + wr * 64 + fr;
        float rsv[8];
        if (MODE == 1) rstd8(ss, row0, rsv);
        if (MODE == 2) { int tk[8]; u64 t[8];
#pragma unroll
            for (int q = 0; q < 8; ++q) tk[q] = row_tok[row0 + (q >> 2) * 128 + (q & 3) * 16];
#pragma unroll
            for (int q = 0; q < 8; ++q) t[q] = ss[tk[q] < 0 ? 0 : tk[q]];
#pragma unroll
            for (int q = 0; q < 8; ++q) rsv[q] = tk[q] >= 0 ? rsqrtf((float)t[q] * (1.0f / (SS_FIX * 1024.0f)) + EPS) : 0.f; }
#pragma unroll
        for (int ai = 0; ai < 2; ++ai)
#pragma unroll
            for (int m = 0; m < 4; ++m) { const int row = row0 + ai * 128 + m * 16; float rs = 1.f;
                if (MODE == 1 || MODE == 2) rs = rsv[ai * 4 + m];
                if (F8OUT) rs *= (1.0f / W8_SCALE);
#pragma unroll
                for (int bj = 0; bj < 2; ++bj) { const int ch = 128 * u.pn + 4 * (16 * bj + 4 * wc + fq);
                    const f32x4 a = acc[ai][bj][m][0] * rs, g = acc[ai][bj][m][1] * rs; f32x4 o;
#pragma unroll
                    for (int i = 0; i < 4; ++i) { o[i] = (MODE == 0) ? a[i] * sigmoidf_(g[i]) : siluf_(a[i]) * g[i]; }
                    if (F8OUT) *(unsigned*)((unsigned char*)O + (size_t)row * ldo + ch) = pack_fp8x4(o[0], o[1], o[2], o[3]);
                    else { u32x2 w; w.x = cvtpk(o[0], o[1]); w.y = cvtpk(o[2], o[3]); *(u32x2*)(O + (size_t)row * ldo + ch) = w; } } }
    }
};
struct EpiPlain {
    static constexpr bool PERM = true, AFTER_DRAIN = false;
    bf16_t* O; int ldo;
    DI void operator()(const Acc& acc, const Unit& u, int wr, int wc, int fr, int fq) const {
        const int row0 = u.pm * 256 + wr * 64 + fr;
#pragma unroll
        for (int ai = 0; ai < 2; ++ai)
#pragma unroll
            for (int m = 0; m < 4; ++m) { bf16_t* rp = O + (size_t)(row0 + ai * 128 + m * 16) * ldo + u.pn * 256 + wc * 32 + 8 * fq;
#pragma unroll
                for (int bj = 0; bj < 2; ++bj) *(u32x4*)(rp + bj * 128) = pack8(acc[ai][bj][m][0], acc[ai][bj][m][1]); }
    }
};
template <bool MOE, bool STATS> struct EpiRes {
    static_assert(!(MOE && STATS), "row statistics are only kept for the dense residual epilogue");
    static constexpr bool PERM = true, AFTER_DRAIN = false;
    const bf16_t* hbase; float* out; bf16_t* hb; u64* ssout; const int* row_tok; const float* row_gate; float ascale; unsigned char* h8;
    DI void operator()(const Acc& acc, const Unit& u, int wr, int wc, int fr, int fq) const {
        const int row0 = u.pm * 256 + wr * 64 + fr, col0 = u.pn * 256 + wc * 32 + 8 * fq;
        int rowv[8]; float gtv[8];
#pragma unroll
        for (int q = 0; q < 8; ++q) { rowv[q] = row0 + (q >> 2) * 128 + (q & 3) * 16; gtv[q] = ascale; }
        if (MOE) {
#pragma unroll
            for (int q = 0; q < 8; ++q) { const int r = rowv[q]; rowv[q] = row_tok[r]; gtv[q] = row_gate[r]; }
#pragma unroll
            for (int q = 0; q < 8; ++q) gtv[q] *= ascale;
        }
#pragma unroll
        for (int ai = 0; ai < 2; ++ai) {
            u32x4 bb[4][2];
#pragma unroll
            for (int m = 0; m < 4; ++m) { const int rr = rowv[ai * 4 + m] < 0 ? 0 : rowv[ai * 4 + m];
#pragma unroll
                for (int bj = 0; bj < 2; ++bj) bb[m][bj] = *(const u32x4*)(hbase + (size_t)rr * DM + col0 + bj * 128); }
#pragma unroll
            for (int m = 0; m < 4; ++m) { const int row = rowv[ai * 4 + m]; const float gt = gtv[ai * 4 + m];
                float s = 0.f;
                if (!MOE || row >= 0) {
#pragma unroll
                    for (int bj = 0; bj < 2; ++bj) { const size_t off = (size_t)row * DM + col0 + bj * 128;
                        const u32x4 b4 = bb[m][bj];
                        const f32x4 b0 = (f32x4){bflo(b4.x), bfhi(b4.x), bflo(b4.y), bfhi(b4.y)}, b1 = (f32x4){bflo(b4.z), bfhi(b4.z), bflo(b4.w), bfhi(b4.w)};
                        const f32x4 v0 = b0 + acc[ai][bj][m][0] * gt, v1 = b1 + acc[ai][bj][m][1] * gt;
                        if (out) { *(f32x4*)(out + off) = v0; *(f32x4*)(out + off + 4) = v1; }
                        if (hb) *(u32x4*)(hb + off) = pack8(v0, v1);
                        if (STATS && h8) { u32x2 w8; w8.x = pack_fp8x4(v0[0], v0[1], v0[2], v0[3]); w8.y = pack_fp8x4(v1[0], v1[1], v1[2], v1[3]); *(u32x2*)(h8 + off) = w8; }
                        if (STATS) s += (v0[0] * v0[0] + v0[1] * v0[1]) + (v0[2] * v0[2] + v0[3] * v0[3]) + (v1[0] * v1[0] + v1[1] * v1[1]) + (v1[2] * v1[2] + v1[3] * v1[3]); }
                }
                if (STATS) { s += __shfl_xor(s, 16); s += __shfl_xor(s, 32);
                    if (fq == 0) atomicAdd((unsigned long long*)(ssout + row), (unsigned long long)(s * SS_FIX + 0.5f)); }
                asm volatile("" ::: "memory");
            }
        }
    }
};
struct EpiS5State {
    static constexpr bool PERM = true, AFTER_DRAIN = false;
    float* ZC;
    DI void operator()(const Acc& acc, const Unit& u, int wr, int wc, int fr, int fq) const {
        const int row0 = u.pm * 256 + wr * 64 + fr;
#pragma unroll
        for (int ai = 0; ai < 2; ++ai)
#pragma unroll
            for (int m = 0; m < 4; ++m) { float* rp = ZC + ((size_t)u.g * NCHUNK + row0 + ai * 128 + m * 16) * 128 + wc * 32 + 8 * fq;
                *(f32x4*)rp = acc[ai][0][m][0]; *(f32x4*)(rp + 4) = acc[ai][0][m][1]; }
    }
};
struct EpiS5Out {
    static constexpr bool PERM = true, AFTER_DRAIN = false;
    bf16_t* YG;
    DI void operator()(const Acc& acc, const Unit& u, int wr, int wc, int fr, int fq) const {
        const int row0 = u.pm * 256 + wr * 64 + fr;
#pragma unroll
        for (int ai = 0; ai < 2; ++ai)
#pragma unroll
            for (int m = 0; m < 4; ++m) { const int chunk = row0 + ai * 128 + m * 16;
#pragma unroll
                for (int bj = 0; bj < 2; ++bj) { const int c = u.pn * 256 + bj * 128 + wc * 32 + 8 * fq, tau = c >> 4, h = c & 15;
                    f32x4 a = acc[ai][bj][m][0], b = acc[ai][bj][m][1];
#pragma unroll
                    for (int i = 0; i < 4; ++i) { a[i] = gelu_tanh(a[i]); b[i] = gelu_tanh(b[i]); }
                    *(u32x4*)(YG + ((size_t)chunk * 64 + tau) * 256 + u.g * 16 + h) = pack8(a, b); } }
    }
};
}
namespace att {
constexpr int TP = 144;
constexpr int TILEB = 64 * TP;
constexpr int L_K0 = 0, L_K1 = TILEB, L_V0 = 2 * TILEB, L_V1 = 3 * TILEB, L_BIAS = 4 * TILEB  , L_UNI = L_BIAS + 8 * 132 * 4  ,
              L_IMP = L_UNI + 64  , L_OVT = L_IMP + 256 * 132 * 2  , L_INVL = L_OVT + 32 * TP  , L_END = L_INVL + 1024;
static_assert(L_END <= 131072, "attention LDS");
DI int crow(int r, int hi) { return (r & 3) + 8 * (r >> 2) + 4 * hi; }
#define MFMA32(a, b, c) __builtin_amdgcn_mfma_f32_32x32x16_bf16((a), (b), (c), 0, 0, 0)

struct TileRegs { u32x4 k, v; };
DI void tile_fetch(TileRegs& t, const bf16_t* ksrc, int kp, const bf16_t* vsrc, int vp, int tid) {
    const int row = tid >> 3, ch = (tid & 7) * 8;
    t.k = *(const u32x4*)(ksrc + (size_t)row * kp + ch);
    t.v = *(const u32x4*)(vsrc + (size_t)row * vp + ch);
}
DI void tile_fetch_k(TileRegs& t, const bf16_t* ksrc, int kp, int tid) { const int row = tid >> 3, ch = (tid & 7) * 8; t.k = *(const u32x4*)(ksrc + (size_t)row * kp + ch); }
DI void tile_put(const TileRegs& t, LAS unsigned char* kd, LAS unsigned char* vd, int tid) {
    const int off = (tid >> 3) * TP + (tid & 7) * 16;
    *(LAS u32x4*)(kd + off) = t.k; *(LAS u32x4*)(vd + off) = t.v;
}
DI void tile_fetch_v(TileRegs& t, const bf16_t* vsrc, int vp, int tid) { const int row = tid >> 3, ch = (tid & 7) * 8; t.v = *(const u32x4*)(vsrc + (size_t)row * vp + ch); }
DI void tile_put_v(const TileRegs& t, LAS unsigned char* vd, int tid) { *(LAS u32x4*)(vd + (tid >> 3) * TP + (tid & 7) * 16) = t.v; }
DI void tile_put_k(const TileRegs& t, LAS unsigned char* kd, int tid) { *(LAS u32x4*)(kd + (tid >> 3) * TP + (tid & 7) * 16) = t.k; }

DI void load_kfrag(bf16x8 (&kf)[8], const LAS unsigned char* kt, int r32, int hi) {
    const LAS unsigned char* kb = kt + r32 * TP + hi * 16;
#pragma unroll
    for (int d0 = 0; d0 < 4; ++d0) { kf[2 * d0] = *(const LAS bf16x8*)(kb + d0 * 32); kf[2 * d0 + 1] = *(const LAS bf16x8*)(kb + 32 * TP + d0 * 32); }
}
DI void load_vfrag(bf16x8 (&vf)[8], const LAS unsigned char* vt, int r32, int hi) {
    const LAS unsigned char* vb = vt + r32 * TP + hi * 16;
#pragma unroll
    for (int ks = 0; ks < 4; ++ks) { vf[2 * ks] = *(const LAS bf16x8*)(vb + ks * 32); vf[2 * ks + 1] = *(const LAS bf16x8*)(vb + 32 * TP + ks * 32); }
}
DI void qk_mma(f32x16& p0, f32x16& p1, const bf16x8 (&kf)[8], const bf16x8 (&qf)[4]) {
#pragma unroll
    for (int i = 0; i < 16; ++i) { p0[i] = 0.f; p1[i] = 0.f; }
#pragma unroll
    for (int d0 = 0; d0 < 4; ++d0) { p0 = MFMA32(kf[2 * d0], qf[d0], p0); p1 = MFMA32(kf[2 * d0 + 1], qf[d0], p1); }
}
DI void qk_tile(f32x16& p0, f32x16& p1, const LAS unsigned char* kt, const bf16x8 (&qf)[4], int r32, int hi) {
    bf16x8 kf[8]; load_kfrag(kf, kt, r32, hi); __builtin_amdgcn_sched_barrier(0); qk_mma(p0, p1, kf, qf);
}
DI bf16x8 pack_p(const f32x16& p, int s) {
    u32x4 w; w.x = cvtpk(p[8 * s], p[8 * s + 1]); w.y = cvtpk(p[8 * s + 2], p[8 * s + 3]); w.z = cvtpk(p[8 * s + 4], p[8 * s + 5]); w.w = cvtpk(p[8 * s + 6], p[8 * s + 7]);
    return __builtin_bit_cast(bf16x8, w);
}
DI void pv_mma(f32x16 (&o)[2], const bf16x8 (&vf)[8], const f32x16& p0, const f32x16& p1) {
#pragma unroll
    for (int ks = 0; ks < 4; ++ks) { const bf16x8 pf = (ks < 2) ? pack_p(p0, ks) : pack_p(p1, ks - 2); o[0] = MFMA32(vf[2 * ks], pf, o[0]); o[1] = MFMA32(vf[2 * ks + 1], pf, o[1]); }
}
DI void pv_tile(f32x16 (&o)[2], const LAS unsigned char* vt, const f32x16& p0, const f32x16& p1, int r32, int hi) {
    bf16x8 vf[8]; load_vfrag(vf, vt, r32, hi); __builtin_amdgcn_sched_barrier(0); pv_mma(o, vf, p0, p1);
}
DI void softmax_step(f32x16& p0, f32x16& p1, float& m, float& l, f32x16 (&o)[2]) {
    float mx = __builtin_fmaxf(p0[0], p1[0]), my = __builtin_fmaxf(p0[1], p1[1]);
#pragma unroll
    for (int i = 2; i < 16; i += 2) { mx = __builtin_fmaxf(__builtin_fmaxf(mx, p0[i]), p1[i]); my = __builtin_fmaxf(__builtin_fmaxf(my, p0[i + 1]), p1[i + 1]); }
    mx = __builtin_fmaxf(mx, my);
    mx = __builtin_fmaxf(mx, __shfl_xor(mx, 32));
    const float mn = __builtin_fmaxf(m, mx), mu = (mn == -INFINITY) ? 0.f : mn;
    const float al = __builtin_amdgcn_exp2f(m - mu);
    float s = 0.f;
#pragma unroll
    for (int i = 0; i < 16; ++i) { p0[i] = __builtin_amdgcn_exp2f(p0[i] - mu); p1[i] = __builtin_amdgcn_exp2f(p1[i] - mu); s += p0[i] + p1[i]; }
    l = l * al + s; m = mn;
    if (__any(al != 1.f)) {
#pragma unroll
        for (int i = 0; i < 16; ++i) { o[0][i] *= al; o[1][i] *= al; }
    }
}
DI void exp_tile(f32x16& p0, f32x16& p1) {
#pragma unroll
    for (int i = 0; i < 16; ++i) { p0[i] = __builtin_amdgcn_exp2f(p0[i]); p1[i] = __builtin_amdgcn_exp2f(p1[i]); }
}
DI void qk_tile_c(f32x16& p0, f32x16& p1, const LAS unsigned char* kt, const bf16x8 (&qf)[4], float cval, int r32, int hi) {
    const LAS unsigned char* kb = kt + r32 * TP + hi * 16;
    f32x16 cv;
#pragma unroll
    for (int i = 0; i < 16; ++i) cv[i] = cval;
    bf16x8 ka[4], kc[4];
    ka[0] = *(const LAS bf16x8*)(kb); ka[1] = *(const LAS bf16x8*)(kb + 32 * TP); ka[2] = *(const LAS bf16x8*)(kb + 32); ka[3] = *(const LAS bf16x8*)(kb + 32 * TP + 32);
    __builtin_amdgcn_sched_barrier(0);
    p0 = MFMA32(ka[0], qf[0], cv); p1 = MFMA32(ka[1], qf[0], cv);
    kc[0] = *(const LAS bf16x8*)(kb + 64); kc[1] = *(const LAS bf16x8*)(kb + 32 * TP + 64); kc[2] = *(const LAS bf16x8*)(kb + 96); kc[3] = *(const LAS bf16x8*)(kb + 32 * TP + 96);
    p0 = MFMA32(ka[2], qf[1], p0); p1 = MFMA32(ka[3], qf[1], p1);
    __builtin_amdgcn_sched_barrier(0);
    p0 = MFMA32(kc[0], qf[2], p0); p1 = MFMA32(kc[1], qf[2], p1); p0 = MFMA32(kc[2], qf[3], p0); p1 = MFMA32(kc[3], qf[3], p1);
}
DI void pv_tile_sum(f32x16 (&o)[2], f32x16& lacc, const LAS unsigned char* vt, const f32x16& p0, const f32x16& p1, int r32, int hi) {
    const bf16x8 ones = (bf16x8){0x3F80, 0x3F80, 0x3F80, 0x3F80, 0x3F80, 0x3F80, 0x3F80, 0x3F80};
    const LAS unsigned char* vb = vt + r32 * TP + hi * 16;
    bf16x8 va[4], vc[4];
    va[0] = *(const LAS bf16x8*)(vb); va[1] = *(const LAS bf16x8*)(vb + 32 * TP); va[2] = *(const LAS bf16x8*)(vb + 32); va[3] = *(const LAS bf16x8*)(vb + 32 * TP + 32);
    const bf16x8 pf0 = pack_p(p0, 0), pf1 = pack_p(p0, 1);
    __builtin_amdgcn_sched_barrier(0);
    o[0] = MFMA32(va[0], pf0, o[0]); o[1] = MFMA32(va[1], pf0, o[1]); lacc = MFMA32(ones, pf0, lacc);
    vc[0] = *(const LAS bf16x8*)(vb + 64); vc[1] = *(const LAS bf16x8*)(vb + 32 * TP + 64); vc[2] = *(const LAS bf16x8*)(vb + 96); vc[3] = *(const LAS bf16x8*)(vb + 32 * TP + 96);
    o[0] = MFMA32(va[2], pf1, o[0]); o[1] = MFMA32(va[3], pf1, o[1]); lacc = MFMA32(ones, pf1, lacc);
    const bf16x8 pf2 = pack_p(p1, 0), pf3 = pack_p(p1, 1);
    __builtin_amdgcn_sched_barrier(0);
    o[0] = MFMA32(vc[0], pf2, o[0]); o[1] = MFMA32(vc[1], pf2, o[1]); lacc = MFMA32(ones, pf2, lacc);
    o[0] = MFMA32(vc[2], pf3, o[0]); o[1] = MFMA32(vc[3], pf3, o[1]); lacc = MFMA32(ones, pf3, lacc);
}
DI void store_o(const f32x16 (&o)[2], float inv, bf16_t* dst, int hi) {
#pragma unroll
    for (int dh = 0; dh < 2; ++dh)
#pragma unroll
        for (int g = 0; g < 4; ++g) { u32x2 w; w.x = cvtpk(o[dh][4 * g] * inv, o[dh][4 * g + 1] * inv); w.y = cvtpk(o[dh][4 * g + 2] * inv, o[dh][4 * g + 3] * inv);
            *(u32x2*)(dst + 32 * dh + 8 * g + 4 * hi) = w; }
}
DI void load_q(bf16x8 (&qf)[4], const bf16_t* qrow, int hi) {
#pragma unroll
    for (int d0 = 0; d0 < 4; ++d0) qf[d0] = *(const bf16x8*)(qrow + 16 * d0 + 8 * hi);
}

DI void bias_mask_half(f32x16& p, const LAS float* btab, int dbase, int hi, int hiD) {
#pragma unroll
    for (int h8 = 0; h8 < 2; ++h8) {
        float bv[8];
#pragma unroll
        for (int r = 0; r < 8; ++r) { const int d = dbase - crow(8 * h8 + r, hi); bv[r] = btab[d < 0 ? 0 : (d < 128 ? d : 128)]; }
#pragma unroll
        for (int r = 0; r < 8; ++r) { const int d = dbase - crow(8 * h8 + r, hi); p[8 * h8 + r] = (d >= 0 && d < hiD) ? p[8 * h8 + r] + bv[r] : -INFINITY; }
        asm volatile("" ::: "memory");
    }
}
DI void bias_mask(f32x16& p0, f32x16& p1, const LAS float* btab  , int t, int s0, int hi, int hiD) {
    bias_mask_half(p0, btab, t - s0, hi, hiD); bias_mask_half(p1, btab, t - s0 - 32, hi, hiD);
}
DI void bias_mask_x(f32x16& p0, f32x16& p1, const LAS float* xt  , int t, int s0, int hi) {
    const LAS float* b0 = xt + (t - s0 + 128 - 4 * hi - 27); const LAS float* b1 = b0 - 32;
#pragma unroll
    for (int h8 = 0; h8 < 2; ++h8) {
        float v0[8], v1[8];
#pragma unroll
        for (int r = 0; r < 8; ++r) { const int rr = 8 * h8 + r, cr = (rr & 3) + 8 * (rr >> 2); v0[r] = b0[27 - cr]; v1[r] = b1[27 - cr]; }
#pragma unroll
        for (int r = 0; r < 8; ++r) { p0[8 * h8 + r] += v0[r]; p1[8 * h8 + r] += v1[r]; }
        asm volatile("" ::: "memory");
    }
}
constexpr int XT_WIN = 704, XT_SEL = 320;
DI void fill_xt(LAS float* xt, const LAS float* tb  , int len, int hiD, int tid) {
    for (int i = tid; i < 8 * len; i += 512) { const int h = i / len, d = i % len - 128; float v = -INFINITY; if (d >= 0 && d < hiD) v = tb[h * 132 + (d < 128 ? d : 128)]; xt[i] = v; }
}
DI void bias_const(f32x16& p0, f32x16& p1, float c) {
#pragma unroll
    for (int r = 0; r < 16; ++r) { p0[r] += c; p1[r] += c; }
}
DI void fill_ninf(f32x16& p0, f32x16& p1) {
#pragma unroll
    for (int r = 0; r < 16; ++r) { p0[r] = -INFINITY; p1[r] = -INFINITY; }
}

DI int next_bit(u64 lo, u64 hi_, int from, int c) {
    if (from < 64) { const u64 x = lo & (~0ull << from); if (x) { const int j = __ffsll((unsigned long long)x) - 1; return j <= c ? j : -1; } from = 64; }
    if (from < 128) { const u64 x = hi_ & (~0ull << (from - 64)); if (x) { const int j = 64 + __ffsll((unsigned long long)x) - 1; return j <= c ? j : -1; } }
    return -1;
}
template <class POL>
DI float flash_loop(LAS unsigned char* lds, const POL& P, const bf16x8 (&qf)[4], f32x16 (&o)[2], float cval_on, int tid, int r32, int hi) {
    int jc = P.first(), jn = P.next(jc);
    TileRegs tr;
    { TileRegs t2;
      tile_fetch_k(tr, P.kptr(jc), P.kp, tid); tile_fetch_v(tr, P.vptr(jc), P.vp, tid); if (jn >= 0) tile_fetch_k(t2, P.kptr(jn), P.kp, tid);
      __syncthreads();
      tile_put_k(tr, lds + L_K0, tid); tile_put_v(tr, lds + L_V0, tid); if (jn >= 0) tile_put_k(t2, lds + L_K1, tid); }
    __syncthreads();
    f32x16 lacc;
#pragma unroll
    for (int i = 0; i < 16; ++i) lacc[i] = 0.f;
    f32x16 sA0, sA1, sB0, sB1;
    if (P.active(jc)) qk_tile_c(sA0, sA1, lds + L_K0, qf, P.lane_on(jc) ? cval_on : -INFINITY, r32, hi);
    __syncthreads();
    int kb = 1, vb = 0;
#define FL_STEP(C0, C1, N0, N1) { const int jn2 = jn >= 0 ? P.next(jn) : -1; \
        const bool actn = jn >= 0 && P.active(jn), actc = P.active(jc); \
        if (jn >= 0) tile_fetch_v(tr, P.vptr(jn), P.vp, tid); if (jn2 >= 0) tile_fetch_k(tr, P.kptr(jn2), P.kp, tid); \
        if (actn) qk_tile_c(N0, N1, lds + (kb ? L_K1 : L_K0), qf, P.lane_on(jn) ? cval_on : -INFINITY, r32, hi); \
        if (actc) { P.adjust(C0, C1, jc); exp_tile(C0, C1); pv_tile_sum(o, lacc, lds + (vb ? L_V1 : L_V0), C0, C1, r32, hi); } \
        if (jn >= 0) tile_put_v(tr, lds + (vb ? L_V0 : L_V1), tid); if (jn2 >= 0) tile_put_k(tr, lds + (kb ? L_K0 : L_K1), tid); \
        __syncthreads(); kb ^= 1; vb ^= 1; jc = jn; jn = jn2; }
    for (;;) { FL_STEP(sA0, sA1, sB0, sB1) if (jc < 0) break; FL_STEP(sB0, sB1, sA0, sA1) if (jc < 0) break; }
#undef FL_STEP
    return lacc[0];
}

struct WindowPol {
    const bf16_t* Kp; const bf16_t* Vp; int kp, vp, c, j0, t, hi; const LAS float* btab;
    DI int first() const { return j0; }
    DI int next(int j) const { return j < c ? j + 1 : -1; }
    DI const bf16_t* kptr(int j) const { return Kp + (size_t)j * 64 * 64; }
    DI const bf16_t* vptr(int j) const { return Vp + (size_t)j * 4096; }
    DI bool active(int) const { int one = 1; asm volatile("" : "+s"(one)); return one != 0; }
    DI bool lane_on(int) const { return true; }
    DI void adjust(f32x16& p0, f32x16& p1, int j) const { if (j == c - 8 || j + 2 >= c) bias_mask_x(p0, p1, btab, t, 64 * j, hi); }
};
DI void window_unit(LAS unsigned char* lds, int b, int kvh, int c, const bf16_t* Q, const bf16_t* KW, const bf16_t* VWT, bf16_t* OW, const float* bnd, const int tid_) {
    int tid = tid_; asm volatile("" : "+v"(tid));
    const int lane = tid & 63, wid = __builtin_amdgcn_readfirstlane(tid >> 6), r32 = lane & 31, hi = lane >> 5;
    const int tl = 8 * wid + (r32 >> 2), g = r32 & 3, t = 64 * c + tl;
    const size_t plane = (size_t)(b * 2 + kvh);
    bf16x8 qf[4]; load_q(qf, Q + (((size_t)b * SEQ + t) * 8 + kvh * 4 + g) * 64, hi);
    const WindowPol P{KW + plane * SEQ * 64, VWT + plane * 64 * SEQ, 64, 64, c, c >= 8 ? c - 8 : 0, t, hi, (const LAS float*)(lds + L_IMP) + (kvh * 4 + g) * XT_WIN};
    f32x16 o[2];
#pragma unroll
    for (int i = 0; i < 16; ++i) { o[0][i] = 0.f; o[1][i] = 0.f; }
    const float lt = flash_loop(lds, P, qf, o, -bnd[kvh * 4 + g], tid, r32, hi);
    int t2 = tid; asm volatile("" : "+v"(t2));
    { const int l2 = t2 & 63, r2 = l2 & 31, tl2 = 8 * (t2 >> 6) + (r2 >> 2), g2 = r2 & 3; store_o(o, lt > 0.f ? 1.f / lt : 0.f, OW + (((size_t)b * SEQ + 64 * c + tl2) * 8 + kvh * 4 + g2) * 64, l2 >> 5); }
}

struct SelPol {
    const bf16_t* Kp; const bf16_t* Vp; int kp, vp, c, t, hi; const LAS float* btab; u64 ulo, uhi, wlo, whi, mlo, mhi;
    DI int first() const { return next_bit(ulo, uhi, 0, c); }
    DI int next(int j) const { return next_bit(ulo, uhi, j + 1, c); }
    DI const bf16_t* kptr(int j) const { return Kp + (size_t)j * 64 * 64; }
    DI const bf16_t* vptr(int j) const { return Vp + (size_t)j * 4096; }
    DI bool active(int j) const { return ((j < 64 ? wlo >> j : whi >> (j - 64)) & 1ull) != 0ull; }
    DI bool lane_on(int j) const { return ((j < 64 ? mlo >> j : mhi >> (j - 64)) & 1ull) != 0ull; }
    DI void adjust(f32x16& p0, f32x16& p1, int j) const { if (j + 2 >= c) bias_mask(p0, p1, btab, t, 64 * j, hi, 1 << 30); }
};
DI void selected_unit(LAS unsigned char* lds, int b, int kvh, int c, const bf16_t* Q, const bf16_t* KS, const bf16_t* VST, const unsigned* SEL, bf16_t* OS, const float* bnd, const int tid_) {
    int tid = tid_; asm volatile("" : "+v"(tid));
    const int lane = tid & 63, wid = __builtin_amdgcn_readfirstlane(tid >> 6), r32 = lane & 31, hi = lane >> 5;
    const int tl = 8 * wid + (r32 >> 2), g = r32 & 3, t = 64 * c + tl;
    const size_t plane = (size_t)(b * 2 + kvh);
    LAS unsigned* uni = (LAS unsigned*)(lds + L_UNI);
    __syncthreads();
    if (tid < 4) uni[tid] = 0u;
    __syncthreads();
    const u32x4 mk = *(const u32x4*)(SEL + (plane * SEQ + t) * 4);
    unsigned w0 = mk.x, w1 = mk.y, w2 = mk.z, w3 = mk.w;
#pragma unroll
    for (int o_ = 4; o_ < 64; o_ <<= 1) { w0 |= __shfl_xor(w0, o_); w1 |= __shfl_xor(w1, o_); w2 |= __shfl_xor(w2, o_); w3 |= __shfl_xor(w3, o_); }
    w0 = __builtin_amdgcn_readfirstlane(w0); w1 = __builtin_amdgcn_readfirstlane(w1); w2 = __builtin_amdgcn_readfirstlane(w2); w3 = __builtin_amdgcn_readfirstlane(w3);
    if (lane == 0) { __hip_atomic_fetch_or(uni + 0, w0, __ATOMIC_RELAXED, __HIP_MEMORY_SCOPE_WORKGROUP); __hip_atomic_fetch_or(uni + 1, w1, __ATOMIC_RELAXED, __HIP_MEMORY_SCOPE_WORKGROUP);
                     __hip_atomic_fetch_or(uni + 2, w2, __ATOMIC_RELAXED, __HIP_MEMORY_SCOPE_WORKGROUP); __hip_atomic_fetch_or(uni + 3, w3, __ATOMIC_RELAXED, __HIP_MEMORY_SCOPE_WORKGROUP); }
    __syncthreads();
    const u64 ulo = (u64)__builtin_amdgcn_readfirstlane(uni[0]) | ((u64)__builtin_amdgcn_readfirstlane(uni[1]) << 32), uhi = (u64)__builtin_amdgcn_readfirstlane(uni[2]) | ((u64)__builtin_amdgcn_readfirstlane(uni[3]) << 32);
    bf16x8 qf[4]; load_q(qf, Q + (((size_t)b * SEQ + t) * 8 + kvh * 4 + g) * 64, hi);
    const SelPol P{KS + plane * SEQ * 64, VST + plane * 64 * SEQ, 64, 64, c, t, hi, (const LAS float*)(lds + L_BIAS) + (kvh * 4 + g) * 132, ulo, uhi,
                   (u64)w0 | ((u64)w1 << 32), (u64)w2 | ((u64)w3 << 32), (u64)mk.x | ((u64)mk.y << 32), (u64)mk.z | ((u64)mk.w << 32)};
    f32x16 o[2];
#pragma unroll
    for (int i = 0; i < 16; ++i) { o[0][i] = 0.f; o[1][i] = 0.f; }
    const float lt = flash_loop(lds, P, qf, o, -bnd[kvh * 4 + g], tid, r32, hi);
    int t2 = tid; asm volatile("" : "+v"(t2));
    { const int l2 = t2 & 63, r2 = l2 & 31, tl2 = 8 * (t2 >> 6) + (r2 >> 2), g2 = r2 & 3; store_o(o, lt > 0.f ? 1.f / lt : 0.f, OS + (((size_t)b * SEQ + 64 * c + tl2) * 8 + kvh * 4 + g2) * 64, l2 >> 5); }
}

struct CrossPol {
    const bf16_t* Kp; const bf16_t* Vp; int kp, vp;
    DI int first() const { return 0; }
    DI int next(int j) const { return j < 3 ? j + 1 : -1; }
    DI const bf16_t* kptr(int j) const { return Kp + (size_t)j * 64 * 64; }
    DI const bf16_t* vptr(int j) const { return Vp + j * 64; }
    DI bool active(int) const { return true; }
    DI bool lane_on(int) const { return true; }
    DI void adjust(f32x16&, f32x16&, int) const {}
};
DI void cross_unit(LAS unsigned char* lds, int b, int h, int qt, const bf16_t* QX, const bf16_t* KM, const bf16_t* VMT, bf16_t* OX, const float* bnd, const int tid_) {
    int tid = tid_; asm volatile("" : "+v"(tid));
    const int lane = tid & 63, wid = __builtin_amdgcn_readfirstlane(tid >> 6), r32 = lane & 31, hi = lane >> 5;
    const size_t row = (size_t)b * SEQ + 256 * qt + 32 * wid + r32;
    bf16x8 qf[4]; load_q(qf, QX + (row * 4 + h) * 64, hi);
    const CrossPol P{KM + (size_t)(b * 4 + h) * 256 * 64, VMT + (size_t)(b * 4 + h) * 64 * 256, 64, 256};
    f32x16 o[2];
#pragma unroll
    for (int i = 0; i < 16; ++i) { o[0][i] = 0.f; o[1][i] = 0.f; }
    const float lt = flash_loop(lds, P, qf, o, -bnd[h], tid, r32, hi);
    store_o(o, 1.f / lt, OX + row * 256 + h * 64, hi);
}
constexpr int SP_OACC = 0, SP_LACC = 256 * 65 * 4, SP_BIAS = 69632, SP_SCR = SP_BIAS + 8 * 132 * 4, SP_Q = SP_SCR + 8 * 64  , SP_END = SP_Q + 256 * TP;
DI int cvt_rpi(float x) { int i; asm("v_cvt_rpi_i32_f32 %0, %1" : "=v"(i) : "v"(x)); return i; }
constexpr float SP_FS = 131072.0f;
static_assert(SP_END + 8 * 320 * 4 <= 131072, "sparse selected LDS");
DI void sel_sparse_unit(LAS unsigned char* lds, int b, int kvh, int c, const bf16_t* Q, const bf16_t* KS, const bf16_t* VSB, const unsigned* SEL, bf16_t* OS, const float* bnd, const int tid_) {
    int tid = tid_; asm volatile("" : "+v"(tid));
    const int lane = tid & 63, wid = __builtin_amdgcn_readfirstlane(tid >> 6), r32 = lane & 31, hi = lane >> 5, slot = r32 >> 2, g4 = r32 & 3;
    const size_t plane = (size_t)(b * 2 + kvh);
    const bf16_t* Kp = KS + plane * SEQ * 64; const bf16_t* Vp = VSB + plane * 64 * SEQ;
    LAS int* OACC = (LAS int*)(lds + SP_OACC); LAS int* LACC = (LAS int*)(lds + SP_LACC);
    __syncthreads();
    for (int i = tid; i < (256 * 65 + 256) / 4; i += 512) ((LAS u32x4*)lds)[i] = (u32x4){0u, 0u, 0u, 0u};
    { const int tk_ = tid >> 3, ch_ = tid & 7; const u32x4* src = (const u32x4*)(Q + (((size_t)b * SEQ + 64 * c + tk_) * 8 + kvh * 4) * 64 + ch_ * 32);
      LAS u32x4* dq = (LAS u32x4*)(lds + SP_Q + (tk_ * 4 + (ch_ >> 1)) * TP + (ch_ & 1) * 64);
      const u32x4 q0 = src[0], q1 = src[1], q2 = src[2], q3 = src[3]; dq[0] = q0; dq[1] = q1; dq[2] = q2; dq[3] = q3; }
    const u32x4 mk = *(const u32x4*)(SEL + (plane * SEQ + 64 * c + lane) * 4);
    const u64 mlo = (u64)mk.x | ((u64)mk.y << 32), mhi = (u64)mk.z | ((u64)mk.w << 32);
    LAS unsigned char* scr = lds + SP_SCR + wid * 64;
    const float cval = 17.0f - bnd[kvh * 4 + g4];
    const LAS float* btab = (const LAS float*)(lds + SP_END) + (kvh * 4 + g4) * XT_SEL;
    __syncthreads();
    int jn = -1, tokN0 = 0, tokN1 = 0; bool validN0 = false, validN1 = false;
#define SP_FIND(from) { jn = -1; for (int j_ = (from); j_ <= c; ++j_) { const bool bit_ = ((j_ < 64 ? mlo >> j_ : mhi >> (j_ - 64)) & 1ull) != 0ull; const u64 M_ = __ballot(bit_); \
        const int n_ = __popcll(M_), g_ = (wid - j_) & 7; \
        if (16 * g_ < n_) { const int rank_ = __builtin_amdgcn_mbcnt_hi((unsigned)(M_ >> 32), __builtin_amdgcn_mbcnt_lo((unsigned)M_, 0u)); if (bit_) scr[rank_] = (unsigned char)lane; \
            const int idx_ = 16 * g_ + slot; validN0 = idx_ < n_; validN1 = idx_ + 8 < n_; tokN0 = validN0 ? (int)scr[idx_] : 0; tokN1 = validN1 ? (int)scr[idx_ + 8] : 0; jn = j_; break; } } }
#define SP_LOAD_K() { const bf16_t* kb_ = Kp + (size_t)jn * 4096 + lane * 8; _Pragma("unroll") for (int f = 0; f < 8; ++f) kf[f] = *(const bf16x8*)(kb_ + f * 512); }
#define SP_LOAD_V() { const bf16_t* vb_ = Vp + (size_t)jn * 4096 + lane * 8; _Pragma("unroll") for (int f = 0; f < 8; ++f) vf[f] = *(const bf16x8*)(vb_ + f * 512); }
#define SP_SUB(TOK, VALID, LAST) { const int tok = (TOK); const bool valid = (VALID); const int t = 64 * c + tok; bf16x8 qf[4]; \
        { const LAS unsigned char* qr_ = lds + SP_Q + (tok * 4 + g4) * TP + hi * 16; _Pragma("unroll") for (int d0 = 0; d0 < 4; ++d0) qf[d0] = *(const LAS bf16x8*)(qr_ + d0 * 32); } \
        f32x16 p0, p1, cv; { const float cvl = valid ? cval : -INFINITY; _Pragma("unroll") for (int i = 0; i < 16; ++i) cv[i] = cvl; } \
        p0 = MFMA32(kf[0], qf[0], cv); p1 = MFMA32(kf[1], qf[0], cv); \
        _Pragma("unroll") for (int d0 = 1; d0 < 4; ++d0) { p0 = MFMA32(kf[2 * d0], qf[d0], p0); p1 = MFMA32(kf[2 * d0 + 1], qf[d0], p1); } \
        if (LAST) { __builtin_amdgcn_sched_barrier(0); SP_FIND(j + 1) if (jn >= 0) SP_LOAD_K() __builtin_amdgcn_sched_barrier(0); } \
        if (j + 2 >= c) bias_mask_x(p0, p1, btab, t, 64 * j, hi); \
        exp_tile(p0, p1); \
        f32x16 o[2], lacc; _Pragma("unroll") for (int i = 0; i < 16; ++i) { o[0][i] = 0.f; o[1][i] = 0.f; lacc[i] = 0.f; } \
        { const bf16x8 ones = (bf16x8){0x3F80, 0x3F80, 0x3F80, 0x3F80, 0x3F80, 0x3F80, 0x3F80, 0x3F80}; \
          _Pragma("unroll") for (int ks = 0; ks < 4; ++ks) { const bf16x8 pf = (ks < 2) ? pack_p(p0, ks) : pack_p(p1, ks - 2); \
              o[0] = MFMA32(vf[2 * ks], pf, o[0]); o[1] = MFMA32(vf[2 * ks + 1], pf, o[1]); lacc = MFMA32(ones, pf, lacc); } } \
        if (LAST) { __builtin_amdgcn_sched_barrier(0); if (jn >= 0) SP_LOAD_V() __builtin_amdgcn_sched_barrier(0); } \
        if (valid) { LAS int* orow = OACC + (tok * 4 + g4) * 65; \
            _Pragma("unroll") for (int dh = 0; dh < 2; ++dh) _Pragma("unroll") for (int r = 0; r < 16; ++r) \
                __hip_atomic_fetch_add(orow + 32 * dh + crow(r, hi), cvt_rpi(o[dh][r]), __ATOMIC_RELAXED, __HIP_MEMORY_SCOPE_WORKGROUP); \
            if (hi == 0) __hip_atomic_fetch_add(LACC + tok * 4 + g4, cvt_rpi(lacc[0]), __ATOMIC_RELAXED, __HIP_MEMORY_SCOPE_WORKGROUP); } }
    bf16x8 kf[8], vf[8];
    SP_FIND(0)
    if (jn >= 0) { SP_LOAD_K() SP_LOAD_V() }
    while (jn >= 0) {
        const int j = jn, t1_ = tokN1; const bool v1_ = validN1; int tcur = tokN0; bool vcur = validN0;
        const int nsub = __any(v1_) ? 2 : 1;
#pragma unroll 1
        for (int sg = 0; sg < nsub; ++sg) { const bool last = (sg == nsub - 1); SP_SUB(tcur, vcur, last) tcur = t1_; vcur = v1_; }
    }
#undef SP_FIND
#undef SP_LOAD_K
#undef SP_LOAD_V
#undef SP_SUB
    __syncthreads();
    { const int row = 32 * wid + r32; const LAS int* orow = OACC + row * 65; const int li = LACC[row];
      const float inv = li > 0 ? 1.0f / (float)li : 0.f;
      bf16_t* dst = OS + (((size_t)b * SEQ + 64 * c + (row >> 2)) * 8 + kvh * 4 + (row & 3)) * 64;
#pragma unroll
      for (int dh = 0; dh < 2; ++dh)
#pragma unroll
          for (int g = 0; g < 4; ++g) { const int d = 32 * dh + 8 * g + 4 * hi;
              u32x2 w; w.x = cvtpk((float)orow[d] * inv, (float)orow[d + 1] * inv); w.y = cvtpk((float)orow[d + 2] * inv, (float)orow[d + 3] * inv);
              *(u32x2*)(dst + d) = w; } }
}
}
namespace att {
DI void cmp_bias_half(f32x16& p, const LAS float* btab, int dbase, int hi) {
    float bv[16];
#pragma unroll
    for (int r = 0; r < 16; ++r) { const int d = dbase - 16 * crow(r, hi); bv[r] = btab[d < 0 ? 0 : (d < 128 ? d : 128)]; }
#pragma unroll
    for (int r = 0; r < 16; ++r) { const int d = dbase - 16 * crow(r, hi); p[r] = d >= 0 ? p[r] + bv[r] : -INFINITY; }
}
DI void cmp_bias_mask(f32x16& p0, f32x16& p1, const LAS float* btab, int t, int k, int hi) {
    const int base = t - 31 - 16 * 64 * k;
    cmp_bias_half(p0, btab, base, hi); asm volatile("" ::: "memory"); cmp_bias_half(p1, btab, base - 16 * 32, hi);
}
DI void qk_tile_s(f32x16& p0, f32x16& p1, const LAS unsigned char* kt, const bf16x8 (&qf)[4], float cval, int r32, int hi) {
    const LAS unsigned char* kb = kt + r32 * TP + hi * 16;
#pragma unroll
    for (int i = 0; i < 16; ++i) { p0[i] = cval; p1[i] = cval; }
#pragma unroll
    for (int d0 = 0; d0 < 4; ++d0) { const bf16x8 k0 = *(const LAS bf16x8*)(kb + d0 * 32), k1 = *(const LAS bf16x8*)(kb + 32 * TP + d0 * 32); p0 = MFMA32(k0, qf[d0], p0); p1 = MFMA32(k1, qf[d0], p1); }
}
DI void pv_tile_s(f32x16 (&o)[2], const LAS unsigned char* vt, const f32x16& p0, const f32x16& p1, int r32, int hi) {
    const LAS unsigned char* vb = vt + r32 * TP + hi * 16;
#pragma unroll
    for (int ks = 0; ks < 4; ++ks) { const bf16x8 pf = (ks < 2) ? pack_p(p0, ks) : pack_p(p1, ks - 2);
        const bf16x8 v0 = *(const LAS bf16x8*)(vb + ks * 32), v1 = *(const LAS bf16x8*)(vb + 32 * TP + ks * 32); o[0] = MFMA32(v0, pf, o[0]); o[1] = MFMA32(v1, pf, o[1]); }
}
DI void build_ovt(LAS unsigned char* lds, int tid) {
    for (int e = tid; e < 32 * 64; e += 512) { const int js = e >> 6, nl = e & 63; const int cs = 16 * nl, ss = 64 * js;
        int ov = (cs + 32 < ss + 64 ? cs + 32 : ss + 64) - (cs > ss ? cs : ss); ov = ov > 0 ? ov : 0; if (js > 16) ov = 0;
        *(LAS bf16_t*)(lds + L_OVT + js * TP + perm_kv(nl) * 2) = f2bf((float)ov * (1.0f / 32.0f)); }
}
DI void cmp_unit(LAS unsigned char* lds, int b, int kvh, int c, const bf16_t* Q, const bf16_t* KCMP, const bf16_t* VCMPT, bf16_t* OC, unsigned* SEL, const float* bnd, const int tid_) {
    int tid = tid_; asm volatile("" : "+v"(tid));
    const int lane = tid & 63, wid = __builtin_amdgcn_readfirstlane(tid >> 6), r32 = lane & 31, hi = lane >> 5;
    const int tl = 8 * wid + (r32 >> 2), g = r32 & 3, t = 64 * c + tl;
    const size_t plane = (size_t)(b * 2 + kvh);
    const bf16_t* Kp = KCMP + plane * NCMPP * 64; const bf16_t* Vp = VCMPT + plane * 64 * NCMPP;
    bf16x8 qf[4]; load_q(qf, Q + (((size_t)b * SEQ + t) * 8 + kvh * 4 + g) * 64, hi);
    const LAS float* btab = (const LAS float*)(lds + L_BIAS) + (kvh * 4 + g) * 132;
    const int nt = ((4 * c + 2) >> 6) + 1;
    f32x16 p0, p1; float l = 0.f; const float cval = -bnd[kvh * 4 + g];
    TileRegs tr;
    LAS bf16_t* raw = (LAS bf16_t*)(lds + L_IMP); LAS float* invl = (LAS float*)(lds + L_INVL);
    f32x16 o[2];
#pragma unroll
    for (int i = 0; i < 16; ++i) { o[0][i] = 0.f; o[1][i] = 0.f; }
    float carry = 0.f;
    tile_fetch(tr, Kp, 64, Vp, NCMPP, tid);
    __syncthreads();
    tile_put(tr, lds + L_K0, lds + L_V0, tid);
    __syncthreads();
    for (int k = 0; k < nt; ++k) {
        const int bsel = k & 1;
        if (k + 1 < nt) tile_fetch(tr, Kp + (size_t)(k + 1) * 64 * 64, 64, Vp + (k + 1) * 64, NCMPP, tid);
        qk_tile_c(p0, p1, lds + (bsel ? L_K1 : L_K0), qf, cval, r32, hi);
        if (64 * c < 1024 * k + 1167) cmp_bias_mask(p0, p1, btab, t, k, hi);
        float s = 0.f;
#pragma unroll
        for (int i = 0; i < 16; ++i) { p0[i] = __builtin_amdgcn_exp2f(p0[i]); p1[i] = __builtin_amdgcn_exp2f(p1[i]); s += p0[i] + p1[i]; }
        l += s;
        pv_tile_s(o, lds + (bsel ? L_V1 : L_V0), p0, p1, r32, hi);
        f32x16 im;
#pragma unroll
        for (int i = 0; i < 16; ++i) im[i] = 0.f;
        { const LAS unsigned char* ob = lds + L_OVT + r32 * TP + hi * 16;
#pragma unroll
          for (int ks = 0; ks < 4; ++ks) { const bf16x8 pf = (ks < 2) ? pack_p(p0, ks) : pack_p(p1, ks - 2); im = MFMA32(*(const LAS bf16x8*)(ob + ks * 32), pf, im); } }
        if (hi == 0) im[0] += carry;
        carry = im[8];
        { LAS bf16_t* rr_ = raw + (tl * 4 + g) * 132 + 16 * k + 4 * hi;
          u32x2 w0, w1; w0.x = cvtpk(im[0], im[1]); w0.y = cvtpk(im[2], im[3]); w1.x = cvtpk(im[4], im[5]); w1.y = cvtpk(im[6], im[7]);
          *(LAS u32x2*)rr_ = w0; *(LAS u32x2*)(rr_ + 8) = w1; }
        if (k + 1 < nt) tile_put(tr, lds + (bsel ? L_K0 : L_K1), lds + (bsel ? L_V0 : L_V1), tid);
        __syncthreads();
    }
    const float lt = l + __shfl_xor(l, 32);
    const float inv = lt > 0.f ? 1.f / lt : 0.f;
    if (hi == 0) invl[tl * 4 + g] = inv;
    store_o(o, inv, OC + (((size_t)b * SEQ + t) * 8 + kvh * 4 + g) * 64, hi);
    {
        const int ti = lane >> 3, sub = lane & 7, tk = 8 * wid + ti;
        unsigned sel16 = 0u;
        if (c < 16) { sel16 = sub == 0 ? ((2u << c) - 1u) : 0u; }
        else {
            int key[16];
            float kv[16];
#pragma unroll
            for (int k = 0; k < 16; ++k) kv[k] = 0.f;
#pragma unroll
            for (int h = 0; h < 4; ++h) { const float il = invl[tk * 4 + h]; const LAS u32x4* rp = (const LAS u32x4*)(raw + (tk * 4 + h) * 132 + 16 * sub); const u32x4 a = rp[0], b2 = rp[1];
                kv[0] += il * bflo(a.x); kv[1] += il * bfhi(a.x); kv[2] += il * bflo(a.y); kv[3] += il * bfhi(a.y); kv[4] += il * bflo(a.z); kv[5] += il * bfhi(a.z); kv[6] += il * bflo(a.w); kv[7] += il * bfhi(a.w);
                kv[8] += il * bflo(b2.x); kv[9] += il * bfhi(b2.x); kv[10] += il * bflo(b2.y); kv[11] += il * bfhi(b2.y); kv[12] += il * bflo(b2.z); kv[13] += il * bfhi(b2.z); kv[14] += il * bflo(b2.w); kv[15] += il * bfhi(b2.w); }
#pragma unroll
            for (int k = 0; k < 16; ++k) { const int j = 16 * sub + k; key[k] = (j >= 1 && j <= c - 2) ? __float_as_int(kv[k]) : -1; }
#define GRP8_SUM(v) { v += __builtin_amdgcn_mov_dpp(v, 0xB1, 0xF, 0xF, true); v += __builtin_amdgcn_mov_dpp(v, 0x4E, 0xF, 0xF, true); v += __builtin_amdgcn_mov_dpp(v, 0x141, 0xF, 0xF, true); }
            int T = 0;
#pragma unroll 1
            for (int bit = 30; bit >= 0; --bit) { const int T2 = T | (1 << bit); int cnt = 0;
#pragma unroll
                for (int k = 0; k < 16; ++k) cnt += (key[k] >= T2) ? 1 : 0;
                GRP8_SUM(cnt)
                T = cnt >= 13 ? T2 : T; }
            int ngt = 0, nt = 0;
#pragma unroll
            for (int k = 0; k < 16; ++k) { ngt += (key[k] > T) ? 1 : 0; nt += (key[k] == T) ? 1 : 0; }
            int pre = nt;
            { int s1 = __builtin_amdgcn_mov_dpp(pre, 0x111, 0xF, 0xF, true); if (sub >= 1) pre += s1;
              int s2 = __builtin_amdgcn_mov_dpp(pre, 0x112, 0xF, 0xF, true); if (sub >= 2) pre += s2;
              int s4 = __builtin_amdgcn_mov_dpp(pre, 0x114, 0xF, 0xF, true); if (sub >= 4) pre += s4; }
            GRP8_SUM(ngt)
            const int need = 13 - ngt; int run = pre - nt;
#pragma unroll
            for (int k = 0; k < 16; ++k) { const bool tie = key[k] == T; if (key[k] > T || (tie && run < need)) sel16 |= 1u << k; run += tie ? 1 : 0; }
#undef GRP8_SUM
            if (sub == 0) sel16 |= 1u;
            if (sub == ((c - 1) >> 4)) sel16 |= 1u << ((c - 1) & 15);
            if (sub == (c >> 4)) sel16 |= 1u << (c & 15);
        }
        ((unsigned short*)SEL)[((plane * SEQ + 64 * c + tk) * 8) + sub] = (unsigned short)sel16;
    }
}

DI void compress_task(int which, int plane, int n0, const bf16_t* src, const bf16_t* W1T, const float* cbias, const bf16_t* W2T, const float* kgain, bf16_t* KCMP, bf16_t* VCMPT, int lane) {
    const int r32 = lane & 31, hi = lane >> 5, n = n0 + r32;
    const bf16_t* arow = src + (size_t)plane * SEQ * 64 + (size_t)n * 16 * 64 + 8 * hi;
    const bf16_t* w0 = W1T + (size_t)r32 * 2048 + 8 * hi; const bf16_t* w1 = w0 + 32 * 2048;
    f32x16 p0, p1;
#pragma unroll
    for (int i = 0; i < 16; ++i) { p0[i] = 0.f; p1[i] = 0.f; }
#pragma unroll 1
    for (int ks = 0; ks < 128; ks += 8) {
        bf16x8 a[8], b0[8], b1[8];
#pragma unroll
        for (int j = 0; j < 8; ++j) { a[j] = *(const bf16x8*)(arow + 16 * (ks + j)); b0[j] = *(const bf16x8*)(w0 + 16 * (ks + j)); b1[j] = *(const bf16x8*)(w1 + 16 * (ks + j)); }
        __builtin_amdgcn_sched_barrier(0);
#pragma unroll
        for (int j = 0; j < 8; ++j) { p0 = MFMA32(b0[j], a[j], p0); p1 = MFMA32(b1[j], a[j], p1); }
    }
#pragma unroll
    for (int r = 0; r < 16; ++r) { p0[r] = gelu_tanh(p0[r] + cbias[crow(r, hi)]); p1[r] = gelu_tanh(p1[r] + cbias[32 + crow(r, hi)]); }
    f32x16 y[2];
#pragma unroll
    for (int i = 0; i < 16; ++i) { y[0][i] = 0.f; y[1][i] = 0.f; }
#pragma unroll
    for (int ks = 0; ks < 4; ++ks) {
        const bf16x8 pf = (ks < 2) ? pack_p(p0, ks) : pack_p(p1, ks - 2);
#pragma unroll
        for (int oh = 0; oh < 2; ++oh) {
            const bf16_t* wr_ = W2T + (size_t)(32 * oh + r32) * 64 + 16 * ks + 4 * hi;
            const u32x2 lo = *(const u32x2*)wr_, hi2 = *(const u32x2*)(wr_ + 8);
            u32x4 w; w.x = lo.x; w.y = lo.y; w.z = hi2.x; w.w = hi2.y;
            y[oh] = MFMA32(__builtin_bit_cast(bf16x8, w), pf, y[oh]);
        }
    }
    const bool dead = (n >= NCMP);
    if (which == 0) {
        float s = 0.f;
#pragma unroll
        for (int i = 0; i < 16; ++i) s += y[0][i] * y[0][i] + y[1][i] * y[1][i];
        s += __shfl_xor(s, 32);
        const float rr = dead ? 0.f : rsqrtf(s * (1.0f / 64.0f) + EPS);
        bf16_t* dst = KCMP + ((size_t)plane * NCMPP + n) * 64;
#pragma unroll
        for (int oh = 0; oh < 2; ++oh)
#pragma unroll
            for (int q = 0; q < 4; ++q) { const int d = 32 * oh + 8 * q + 4 * hi; const f32x4 gv = *(const f32x4*)(kgain + d);
                u32x2 w; w.x = cvtpk(dead ? 0.f : y[oh][4 * q] * rr * gv[0], dead ? 0.f : y[oh][4 * q + 1] * rr * gv[1]); w.y = cvtpk(dead ? 0.f : y[oh][4 * q + 2] * rr * gv[2], dead ? 0.f : y[oh][4 * q + 3] * rr * gv[3]);
                *(u32x2*)(dst + d) = w; }
    } else {
        bf16_t* dst = VCMPT + (size_t)plane * 64 * NCMPP + perm_kv(n);
#pragma unroll
        for (int oh = 0; oh < 2; ++oh)
#pragma unroll
            for (int r = 0; r < 16; ++r) dst[(size_t)(32 * oh + crow(r, hi)) * NCMPP] = dead ? (bf16_t)0 : f2bf(y[oh][r]);
    }
}
}
namespace thin {
enum { MAP_ID = 0, MAP_GLU = 1, MAP_HEAD = 2, MAP_WIN = 3 };
DI int colmap(int map, int N, int np) {
    if (map == MAP_ID) return np;
    const int pn = np >> 8, c = np & 255;
    if (map == MAP_GLU) { const int q = c >> 3, i8 = c & 7; return (i8 >> 2) * (N >> 1) + 128 * pn + 4 * q + (i8 & 3); }
    const int bj = c >> 7, wc = (c >> 5) & 3, w = c & 31, hd = 32 * bj + w;
    if (map == MAP_HEAD) return 256 * pn + 64 * wc + hd;
    if (pn == 0) return c;
    if (pn <= 2) { const int q = c >> 3, i8 = c & 7; return 256 + (i8 >> 2) * 256 + 128 * (pn - 1) + 4 * q + (i8 & 3); }
    if (pn <= 4) return 768 + (4 * (pn - 3) + wc) * 64 + hd;
    if (pn <= 7) return 1280 + 256 * (pn - 5) + (wc >> 1) * 128 + (wc & 1) * 64 + hd;
    return c < 24 ? 2048 + c : -1;
}
struct XDesc { const float* W; const float* gain; bf16_t* out; int K, N, Nout, map; int nbatch, f8; size_t wstride, ostride; };

DI void xload(const XDesc& D, int item, f32x4 (&v)[8], float (&gv)[8], int lane) {
    const int per = (D.K / 64) * (D.Nout / 32), bi = item / per, it = item % per, nblk = D.Nout / 32, kb = it / nblk, nb = it % nblk, k0 = 64 * kb, n0 = 32 * nb;
    const float* W = D.W + (size_t)bi * D.wstride;
    const int r8 = lane >> 3, q4 = (lane & 7) * 4, col = colmap(D.map, D.N, n0 + q4);
#pragma unroll
    for (int i = 0; i < 8; ++i) { const int kk = 8 * i + r8; v[i] = (f32x4){0.f, 0.f, 0.f, 0.f}; gv[i] = 1.f;
        if (col >= 0) { v[i] = *(const f32x4*)(W + (size_t)(k0 + kk) * D.N + col); if (D.gain) gv[i] = D.gain[k0 + kk]; } }
}
DI void xstore(const XDesc& D, int item, const f32x4 (&v)[8], const float (&gv)[8], LAS float* scr, int lane) {
    const int per = (D.K / 64) * (D.Nout / 32), bi = item / per, it = item % per, nblk = D.Nout / 32, kb = it / nblk, nb = it % nblk, k0 = 64 * kb, n0 = 32 * nb;
    bf16_t* O = D.out + (size_t)bi * D.ostride;
    unsigned char* O8 = (unsigned char*)D.out + (size_t)bi * D.ostride;
    const int r8 = lane >> 3, q4 = (lane & 7) * 4;
#pragma unroll
    for (int i = 0; i < 8; ++i) { const int kk = 8 * i + r8; LAS float* d = scr + kk * 33 + q4; d[0] = v[i][0] * gv[i]; d[1] = v[i][1] * gv[i]; d[2] = v[i][2] * gv[i]; d[3] = v[i][3] * gv[i]; }
    LDS_WAIT(); asm volatile("" ::: "memory");
    const int c = lane & 7;
#pragma unroll
    for (int j = 0; j < 4; ++j) { const int n = (lane >> 3) + 8 * j; const LAS float* s = scr + (8 * c) * 33 + n;
        if (D.f8) { u32x2 o; o.x = pack_fp8x4(s[0 * 33] * W8_SCALE, s[1 * 33] * W8_SCALE, s[2 * 33] * W8_SCALE, s[3 * 33] * W8_SCALE); o.y = pack_fp8x4(s[4 * 33] * W8_SCALE, s[5 * 33] * W8_SCALE, s[6 * 33] * W8_SCALE, s[7 * 33] * W8_SCALE);
            *(u32x2*)(O8 + (size_t)(n0 + n) * D.K + k0 + 8 * c) = o; }
        else { u32x4 o; o.x = cvtpk(s[0 * 33], s[1 * 33]); o.y = cvtpk(s[2 * 33], s[3 * 33]); o.z = cvtpk(s[4 * 33], s[5 * 33]); o.w = cvtpk(s[6 * 33], s[7 * 33]);
            *(u32x4*)(O + (size_t)(n0 + n) * D.K + k0 + 8 * c) = o; } }
    LDS_WAIT(); asm volatile("" ::: "memory");
}
DI void row_to_bf16_ss(const float* xrow, bf16_t* orow, u64* ss, int lane) {
    const f32x4* xr = (const f32x4*)xrow + lane; float s = 0.f; f32x4 v[4];
#pragma unroll
    for (int j = 0; j < 4; ++j) { v[j] = xr[64 * j]; s += (v[j][0] * v[j][0] + v[j][1] * v[j][1]) + (v[j][2] * v[j][2] + v[j][3] * v[j][3]); }
    s = wave_sum(s);
    u32x2* o8 = (u32x2*)orow + lane;
#pragma unroll
    for (int j = 0; j < 4; ++j) { u32x2 w; w.x = cvtpk(v[j][0], v[j][1]); w.y = cvtpk(v[j][2], v[j][3]); o8[64 * j] = w; }
    if (lane == 0) *ss = (u64)(s * SS_FIX + 0.5f);
}
DI void row2_to_bf16_ss(const float* xrow, bf16_t* orow, u64* ss, int lane) {
    const f32x4* xr = (const f32x4*)xrow + lane; float s0 = 0.f, s1 = 0.f; f32x4 v[8];
#pragma unroll
    for (int j = 0; j < 8; ++j) v[j] = xr[64 * j];
#pragma unroll
    for (int j = 0; j < 4; ++j) { s0 += (v[j][0] * v[j][0] + v[j][1] * v[j][1]) + (v[j][2] * v[j][2] + v[j][3] * v[j][3]);
        s1 += (v[4 + j][0] * v[4 + j][0] + v[4 + j][1] * v[4 + j][1]) + (v[4 + j][2] * v[4 + j][2] + v[4 + j][3] * v[4 + j][3]); }
    s0 = dpp_sum16(s0); s1 = dpp_sum16(s1);
#pragma unroll
    for (int o = 16; o < 64; o <<= 1) { s0 += __shfl_xor(s0, o); s1 += __shfl_xor(s1, o); }
    u32x2* o8 = (u32x2*)orow + lane;
#pragma unroll
    for (int j = 0; j < 8; ++j) { u32x2 w; w.x = cvtpk(v[j][0], v[j][1]); w.y = cvtpk(v[j][2], v[j][3]); o8[64 * j] = w; }
    if (lane == 0) { ss[0] = (u64)(s0 * SS_FIX + 0.5f); ss[1] = (u64)(s1 * SS_FIX + 0.5f); }
}
DI int t5_bucket(int n) {
    if (n < 16) return n;
    int large = 16 + (int)(logf((float)n / 16.0f) / 2.0794415416798357f * 16.0f);
    return large < 31 ? large : 31;
}
struct S5P { const float *lre, *lim, *ldt, *bre, *bim, *cre, *cim, *dsk; };
DI void lam_pow(const S5P& P, int g, int p, float tau, float& wr, float& wi) {
    const float dt = expf(P.ldt[g]), lr = P.lre[g * 64 + p], li = P.lim[g * 64 + p];
    const float mag = expf(lr * dt * tau); float sn, cs; sincosf(li * dt * tau, &sn, &cs); wr = mag * cs; wi = mag * sn;
}
DI void zoh_f(const S5P& P, int g, int p, float& fr, float& fi) {
    const float lr = P.lre[g * 64 + p], li = P.lim[g * 64 + p]; float ar, ai; lam_pow(P, g, p, 1.f, ar, ai);
    const float den = lr * lr + li * li; fr = ((ar - 1.f) * lr + ai * li) / den; fi = (ai * lr - (ar - 1.f) * li) / den;
}
DI void ktab_task(const S5P& P, float* ktab, int g, int tau, LAS float* scr, int lane) {
    LAS float* cs = scr + 2048;
#pragma unroll
    for (int i = 0; i < 4; ++i) { *(LAS f32x4*)(cs + 4 * lane + 256 * i) = *(const f32x4*)(P.cre + g * 1024 + 4 * lane + 256 * i); *(LAS f32x4*)(cs + 1024 + 4 * lane + 256 * i) = *(const f32x4*)(P.cim + g * 1024 + 4 * lane + 256 * i); }
    { const int p = lane; float wr, wi, fr, fi; lam_pow(P, g, p, (float)tau, wr, wi); zoh_f(P, g, p, fr, fi);
      const float gr = wr * fr - wi * fi, gi = wr * fi + wi * fr;
#pragma unroll
      for (int h = 0; h < 16; ++h) { const float br = P.bre[(g * 64 + p) * 16 + h], bi = P.bim[(g * 64 + p) * 16 + h];
          scr[(p * 16 + h) * 2] = gr * br - gi * bi; scr[(p * 16 + h) * 2 + 1] = gr * bi + gi * br; } }
    LDS_WAIT(); asm volatile("" ::: "memory");
#pragma unroll 1
    for (int k = 0; k < 4; ++k) { const int idx = lane + 64 * k, ho = idx >> 4, hi = idx & 15; float a = 0.f;
#pragma unroll 8
        for (int p = 0; p < 64; ++p) a += cs[ho * 64 + p] * scr[(p * 16 + hi) * 2] - cs[1024 + ho * 64 + p] * scr[(p * 16 + hi) * 2 + 1];
        ktab[((size_t)(g * 64 + tau) * 16 + ho) * 16 + hi] = a; }
    LDS_WAIT(); asm volatile("" ::: "memory");
}
DI void st_load8(const float* ktab, int g, int n, int k0, f32x4& a, f32x4& b) {
    const int to = n >> 4, ho = n & 15, ti = k0 >> 4, h0 = k0 & 15;
    a = (f32x4){0.f, 0.f, 0.f, 0.f}; b = a;
    if (to >= ti) { const float* kp = ktab + ((size_t)(g * 64 + (to - ti)) * 16 + ho) * 16 + h0; a = *(const f32x4*)kp; b = *(const f32x4*)(kp + 4); }
}
DI void st_store8(const S5P& P, bf16_t* ST, int g, int n, int k0, f32x4 a, f32x4 b) {
    const int to = n >> 4, ho = n & 15, ti = k0 >> 4, h0 = k0 & 15;
    if (to == ti && (ho >> 3) == (h0 >> 3)) { const float d = P.dsk[g * 16 + ho]; const int j = ho & 7;
        a[0] += (j == 0) ? d : 0.f; a[1] += (j == 1) ? d : 0.f; a[2] += (j == 2) ? d : 0.f; a[3] += (j == 3) ? d : 0.f;
        b[0] += (j == 4) ? d : 0.f; b[1] += (j == 5) ? d : 0.f; b[2] += (j == 6) ? d : 0.f; b[3] += (j == 7) ? d : 0.f; }
    u32x4 w; w.x = cvtpk(a[0], a[1]); w.y = cvtpk(a[2], a[3]); w.z = cvtpk(b[0], b[1]); w.w = cvtpk(b[2], b[3]);
    *(u32x4*)(ST + ((size_t)g * 1024 + n) * SKX + k0) = w;
}
DI void st_carry(const S5P& P, bf16_t* ST, int g, int to, int p) {
    float wr, wi; lam_pow(P, g, p, (float)(to + 1), wr, wi);
#pragma unroll 4
    for (int ho = 0; ho < 16; ++ho) { const float cr = P.cre[(g * 16 + ho) * 64 + p], ci = P.cim[(g * 16 + ho) * 64 + p];
        bf16_t* row = ST + ((size_t)g * 1024 + to * 16 + ho) * SKX + 1024;
        row[p] = f2bf(cr * wr - ci * wi); row[64 + p] = f2bf(-(cr * wi + ci * wr)); }
}
DI void sz_fill8(const S5P& P, bf16_t* SZ, int g, int n, int k0) {
    float v[8];
    if (n < 128) { const int p = n & 63, ti = k0 >> 4, h0 = k0 & 15; float wr, wi, fr, fi; lam_pow(P, g, p, (float)(63 - ti), wr, wi); zoh_f(P, g, p, fr, fi);
        const float gr = wr * fr - wi * fi, gi = wr * fi + wi * fr;
#pragma unroll
        for (int j = 0; j < 8; ++j) { const float br = P.bre[(g * 64 + p) * 16 + h0 + j], bi = P.bim[(g * 64 + p) * 16 + h0 + j]; v[j] = (n < 64) ? (gr * br - gi * bi) : (gr * bi + gi * br); }
    } else {
#pragma unroll
        for (int j = 0; j < 8; ++j) v[j] = 0.f;
    }
    u32x4 w; w.x = cvtpk(v[0], v[1]); w.y = cvtpk(v[2], v[3]); w.z = cvtpk(v[4], v[5]); w.w = cvtpk(v[6], v[7]);
    *(u32x4*)(SZ + ((size_t)g * 256 + n) * 1024 + k0) = w;
}

DI void conv_unit(LAS unsigned char* lds, int tile, const bf16_t* CVIN, const float* wdw, const float* bdw, const float* lng, const float* lnb, bf16_t* CV, const int tid) {
    const int c = tid & 255, half = tid >> 8, lane = tid & 63, wid = __builtin_amdgcn_readfirstlane(tid >> 6);
    const int row0 = tile * 64 + 32 * half, s0 = row0 & (SEQ - 1);
    LAS float* y = (LAS float*)lds;
    float w[31];
#pragma unroll
    for (int k = 0; k < 31; ++k) w[k] = wdw[k * 256 + c];
    const float bias = bdw[c];
    float v[62];
#pragma unroll
    for (int i = 0; i < 62; ++i) { const int sp = s0 - 30 + i; v[i] = sp >= 0 ? bf2f(CVIN[(size_t)(row0 - 30 + i) * 256 + c]) : 0.f; }
    __syncthreads();
#pragma unroll
    for (int tt = 0; tt < 32; ++tt) { float a = bias;
#pragma unroll
        for (int k = 0; k < 31; ++k) a += w[k] * v[tt + k];
        y[(32 * half + tt) * 256 + c] = a; }
    __syncthreads();
    const f32x4 gg = *(const f32x4*)(lng + 4 * lane), bb = *(const f32x4*)(lnb + 4 * lane);
#pragma unroll
    for (int i = 0; i < 8; ++i) { const int tk = 8 * wid + i; const f32x4 x = *(const LAS f32x4*)(y + tk * 256 + 4 * lane);
        const float mean = wave_sum((x[0] + x[1]) + (x[2] + x[3])) * (1.0f / 256.0f);
        const f32x4 d = x - mean; const float var = wave_sum((d[0] * d[0] + d[1] * d[1]) + (d[2] * d[2] + d[3] * d[3])) * (1.0f / 256.0f);
        const float rs = rsqrtf(var + EPS);
        f32x4 o = d * rs * gg + bb;
        u32x2 wv; wv.x = cvtpk(siluf_(o[0]), siluf_(o[1])); wv.y = cvtpk(siluf_(o[2]), siluf_(o[3]));
        *(u32x2*)(CV + (size_t)(tile * 64 + tk) * 256 + 4 * lane) = wv; }
}

DI void s5_combine(const float* __restrict__ a64, const float* __restrict__ ZC, bf16_t* __restrict__ UX, int gt) {
    const int p = gt & 63, g = (gt >> 6) & 15, b = gt >> 10;
    const float ar = a64[(g * 64 + p) * 2], ai = a64[(g * 64 + p) * 2 + 1];
    float xr = 0.f, xi = 0.f;
    const size_t ch0 = (size_t)g * NCHUNK + b * 128;
    float zr[2][16], zi[2][16];
#pragma unroll
    for (int j = 0; j < 16; ++j) { zr[0][j] = ZC[(ch0 + j) * 128 + p]; zi[0][j] = ZC[(ch0 + j) * 128 + 64 + p]; }
#pragma unroll
    for (int c8 = 0; c8 < 8; ++c8) {
        if (c8 < 7) {
#pragma unroll
            for (int j = 0; j < 16; ++j) { const size_t ch = ch0 + 16 * (c8 + 1) + j; zr[(c8 + 1) & 1][j] = ZC[ch * 128 + p]; zi[(c8 + 1) & 1][j] = ZC[ch * 128 + 64 + p]; }
        }
#pragma unroll
        for (int j = 0; j < 16; ++j) { const size_t ch = ch0 + 16 * c8 + j;
            UX[ch * SKX + 1024 + p] = f2bf(xr); UX[ch * SKX + 1088 + p] = f2bf(xi);
            const float nr = ar * xr - ai * xi + zr[c8 & 1][j], ni = ar * xi + ai * xr + zi[c8 & 1][j]; xr = nr; xi = ni; }
    }
}

template <bool F8OUT> DI void mixnorm_row2(int row, const bf16_t* YSSM, const bf16_t* YCONV, const bf16_t* OC, const bf16_t* OS, const bf16_t* OW, const float* GATE, bf16_t* AMIX, int lane) {
    u32x4 q[2][6]; float gt[2][3];
#pragma unroll
    for (int t = 0; t < 2; ++t) {
        if (lane < 32) { const bf16_t* src = (lane < 16 ? YSSM : YCONV) + (size_t)(row + t) * 256 + 16 * (lane & 15); q[t][0] = *(const u32x4*)src; q[t][1] = *(const u32x4*)(src + 8); }
        else { const int head = (lane - 32) >> 2; const size_t off = (size_t)(row + t) * 512 + 16 * (lane - 32);
            gt[t][0] = GATE[(size_t)(row + t) * 24 + head * 3]; gt[t][1] = GATE[(size_t)(row + t) * 24 + head * 3 + 1]; gt[t][2] = GATE[(size_t)(row + t) * 24 + head * 3 + 2];
            q[t][0] = *(const u32x4*)(OC + off); q[t][1] = *(const u32x4*)(OS + off); q[t][2] = *(const u32x4*)(OW + off);
            q[t][3] = *(const u32x4*)(OC + off + 8); q[t][4] = *(const u32x4*)(OS + off + 8); q[t][5] = *(const u32x4*)(OW + off + 8); }
    }
#pragma unroll
    for (int t = 0; t < 2; ++t) {
        float v[16];
        if (lane < 32) { const u32x4 a = q[t][0], b = q[t][1];
            v[0] = bflo(a.x); v[1] = bfhi(a.x); v[2] = bflo(a.y); v[3] = bfhi(a.y); v[4] = bflo(a.z); v[5] = bfhi(a.z); v[6] = bflo(a.w); v[7] = bfhi(a.w);
            v[8] = bflo(b.x); v[9] = bfhi(b.x); v[10] = bflo(b.y); v[11] = bfhi(b.y); v[12] = bflo(b.z); v[13] = bfhi(b.z); v[14] = bflo(b.w); v[15] = bfhi(b.w);
        } else { const float g0 = gt[t][0], g1 = gt[t][1], g2 = gt[t][2];
#pragma unroll
            for (int h8 = 0; h8 < 2; ++h8) { const u32x4 a = q[t][3 * h8], b = q[t][3 * h8 + 1], c = q[t][3 * h8 + 2];
                v[8 * h8 + 0] = g0 * bflo(a.x) + g1 * bflo(b.x) + g2 * bflo(c.x); v[8 * h8 + 1] = g0 * bfhi(a.x) + g1 * bfhi(b.x) + g2 * bfhi(c.x);
                v[8 * h8 + 2] = g0 * bflo(a.y) + g1 * bflo(b.y) + g2 * bflo(c.y); v[8 * h8 + 3] = g0 * bfhi(a.y) + g1 * bfhi(b.y) + g2 * bfhi(c.y);
                v[8 * h8 + 4] = g0 * bflo(a.z) + g1 * bflo(b.z) + g2 * bflo(c.z); v[8 * h8 + 5] = g0 * bfhi(a.z) + g1 * bfhi(b.z) + g2 * bfhi(c.z);
                v[8 * h8 + 6] = g0 * bflo(a.w) + g1 * bflo(b.w) + g2 * bflo(c.w); v[8 * h8 + 7] = g0 * bfhi(a.w) + g1 * bfhi(b.w) + g2 * bfhi(c.w); }
        }
        float s = 0.f;
#pragma unroll
        for (int i = 0; i < 16; ++i) s += v[i] * v[i];
        s = dpp_sum16(s);
        const float s16 = __shfl_xor(s, 16);
        const float tot = lane < 32 ? s : s + s16;
        const float rs = rsqrtf(tot * (lane < 32 ? 1.0f / 256.0f : 1.0f / 512.0f) + EPS);
        if constexpr (F8OUT) {
        u32x4 w8; w8.x = pack_fp8x4(v[0] * rs, v[1] * rs, v[2] * rs, v[3] * rs); w8.y = pack_fp8x4(v[4] * rs, v[5] * rs, v[6] * rs, v[7] * rs);
        w8.z = pack_fp8x4(v[8] * rs, v[9] * rs, v[10] * rs, v[11] * rs); w8.w = pack_fp8x4(v[12] * rs, v[13] * rs, v[14] * rs, v[15] * rs);
        *(u32x4*)((unsigned char*)AMIX + (size_t)(row + t) * 1024 + 16 * lane) = w8;
        } else {
        u32x4 w0, w1; w0.x = cvtpk(v[0] * rs, v[1] * rs); w0.y = cvtpk(v[2] * rs, v[3] * rs); w0.z = cvtpk(v[4] * rs, v[5] * rs); w0.w = cvtpk(v[6] * rs, v[7] * rs);
        w1.x = cvtpk(v[8] * rs, v[9] * rs); w1.y = cvtpk(v[10] * rs, v[11] * rs); w1.z = cvtpk(v[12] * rs, v[13] * rs); w1.w = cvtpk(v[14] * rs, v[15] * rs);
        bf16_t* dst = AMIX + (size_t)(row + t) * 1024 + 16 * lane; *(u32x4*)dst = w0; *(u32x4*)(dst + 8) = w1; }
    }
}
}
namespace moe {
using pg8::Unit;
constexpr int NCHK = 256, CHKT = 256;
struct Route { int* counts; int* startp; int* tok_e; int* tok_rank; float* tok_g; int* row_tok; float* row_gate; };
constexpr int L_WRT = 0  , L_LE = 32768  , L_CNT = 0  , L_SP = 16384  , L_TOT = 16384 + 128  ;

DI void load_router(LAS unsigned char* lds, const float* wr, const float* gain, int tid) {
    LAS float* wrt = (LAS float*)(lds + L_WRT);
    float wv[16], gv[16];
#pragma unroll
    for (int q = 0; q < 16; ++q) { const int i = tid + 512 * q; wv[q] = wr[i]; gv[q] = gain[i >> 3]; }
#pragma unroll
    for (int q = 0; q < 16; ++q) { const int i = tid + 512 * q, k = i >> 3, e = i & 7; wrt[e * 1024 + k] = wv[q] * gv[q]; }
}
DI void route1_chunk(LAS unsigned char* lds, int chunk, const bf16_t* H, const u64* ss, const Route& R, const int tid) {
    const int lane = tid & 63, wid = __builtin_amdgcn_readfirstlane(tid >> 6);
    const LAS float* wrt = (const LAS float*)(lds + L_WRT); LAS int* le = (LAS int*)(lds + L_LE);
    u32x2 qa[4], qb[4];
    { const int tok0 = chunk * CHKT + 32 * wid;
#pragma unroll
      for (int j = 0; j < 4; ++j) { qa[j] = *(const u32x2*)(H + (size_t)tok0 * DM + 4 * lane + 256 * j); qb[j] = *(const u32x2*)(H + (size_t)(tok0 + 1) * DM + 4 * lane + 256 * j); } }
    for (int i = 0; i < 32; i += 2) {
        const int tok = chunk * CHKT + 32 * wid + i;
        f32x4 ha[4], hb[4];
#pragma unroll
        for (int j = 0; j < 4; ++j) { ha[j] = (f32x4){bflo(qa[j].x), bfhi(qa[j].x), bflo(qa[j].y), bfhi(qa[j].y)}; hb[j] = (f32x4){bflo(qb[j].x), bfhi(qb[j].x), bflo(qb[j].y), bfhi(qb[j].y)}; }
        { const int tn = (i + 2 < 32) ? tok + 2 : tok;
#pragma unroll
          for (int j = 0; j < 4; ++j) { qa[j] = *(const u32x2*)(H + (size_t)tn * DM + 4 * lane + 256 * j); qb[j] = *(const u32x2*)(H + (size_t)(tn + 1) * DM + 4 * lane + 256 * j); } }
        const float rsa = rsqrtf((float)ss[tok] * (1.0f / (SS_FIX * 1024.0f)) + EPS), rsb = rsqrtf((float)ss[tok + 1] * (1.0f / (SS_FIX * 1024.0f)) + EPS);
        float la[8], lb[8];
#pragma unroll
        for (int e = 0; e < 8; ++e) { la[e] = 0.f; lb[e] = 0.f; }
#pragma unroll
        for (int j = 0; j < 4; ++j)
#pragma unroll
            for (int e = 0; e < 8; ++e) { const f32x4 wv = *(const LAS f32x4*)(wrt + e * 1024 + 4 * lane + 256 * j);
                la[e] += (ha[j][0] * wv[0] + ha[j][1] * wv[1]) + (ha[j][2] * wv[2] + ha[j][3] * wv[3]); lb[e] += (hb[j][0] * wv[0] + hb[j][1] * wv[1]) + (hb[j][2] * wv[2] + hb[j][3] * wv[3]); }
#pragma unroll
        for (int e = 0; e < 8; ++e) { la[e] = dpp_sum16(la[e]); lb[e] = dpp_sum16(lb[e]); }
#pragma unroll
        for (int o_ = 16; o_ < 64; o_ <<= 1)
#pragma unroll
            for (int e = 0; e < 8; ++e) { la[e] += __shfl_xor(la[e], o_); lb[e] += __shfl_xor(lb[e], o_); }
#pragma unroll
        for (int tt = 0; tt < 2; ++tt) {
            float lg[8];
#pragma unroll
            for (int e = 0; e < 8; ++e) lg[e] = tt ? lb[e] * rsb : la[e] * rsa;
            int e0 = 0; float v0 = lg[0];
#pragma unroll
            for (int e = 1; e < 8; ++e) if (lg[e] > v0) { v0 = lg[e]; e0 = e; }
            int e1 = -1; float v1 = -INFINITY;
#pragma unroll
            for (int e = 0; e < 8; ++e) if (e != e0 && (e1 < 0 || lg[e] > v1)) { v1 = lg[e]; e1 = e; }
            const float g0 = 1.f / (1.f + __expf(v1 - v0));
            if (lane == 0) { le[32 * wid + i + tt] = e0 | (e1 << 8); R.tok_g[(size_t)(tok + tt) * 2] = g0; R.tok_g[(size_t)(tok + tt) * 2 + 1] = 1.f - g0; }
        }
    }
    __syncthreads();
    if (wid == 0) {
#pragma unroll
        for (int s = 0; s < 2; ++s) {
            int run = 0;
            for (int rd = 0; rd < 4; ++rd) { const int tl = 64 * rd + lane, es = (le[tl] >> (8 * s)) & 0xff; int rank = 0;
#pragma unroll
                for (int e = 0; e < 8; ++e) { const u64 mk = __ballot(es == e); const int before = __popcll(mk & ((1ull << lane) - 1ull)), tot = __popcll(mk);
                    const int re = __shfl(run, e); if (es == e) rank = re + before; if (lane == e) run += tot; }
                const int tok = chunk * CHKT + tl; R.tok_e[(size_t)s * MTOK + tok] = es; R.tok_rank[(size_t)s * MTOK + tok] = rank; }
            if (lane < 8) R.counts[(chunk * 2 + s) * 8 + lane] = run;
        }
    }
    __syncthreads();
}
DI void route2(LAS unsigned char* lds, const Route& R, int G, const int tid) {
    LAS int* cnt = (LAS int*)(lds + L_CNT); LAS int* sp = (LAS int*)(lds + L_SP); LAS int* tot = (LAS int*)(lds + L_TOT);
    __syncthreads();
    { int cv[8];
#pragma unroll
      for (int q = 0; q < 8; ++q) cv[q] = R.counts[tid + 512 * q];
#pragma unroll
      for (int q = 0; q < 8; ++q) cnt[tid + 512 * q] = cv[q]; }
    __syncthreads();
    LAS int* seg = (LAS int*)(lds + L_SP + 256);
    { const int col = tid & 15, sg = tid >> 4; int run = 0;
#pragma unroll
      for (int k = 0; k < 8; ++k) { const int ix = (8 * sg + k) * 16 + col; const int v = cnt[ix]; cnt[ix] = run; run += v; }
      seg[sg * 16 + col] = run; }
    __syncthreads();
    if (tid < 16) { int a = 0; for (int sg = 0; sg < 32; ++sg) { const int v = seg[sg * 16 + tid]; seg[sg * 16 + tid] = a; a += v; } tot[tid] = a; }
    __syncthreads();
    if (tid < 2) { int a = 0; for (int e = 0; e < 8; ++e) { sp[tid * 16 + e] = a; a += (tot[tid * 8 + e] + 255) & ~255; } sp[tid * 16 + 8] = a;
        if (blockIdx.x == 0) for (int e = 0; e < 9; ++e) R.startp[tid * 16 + e] = sp[tid * 16 + e]; }
    __syncthreads();
    for (int chunk = blockIdx.x; chunk < NCHK; chunk += G) {
        if (tid < CHKT) { const int tok = chunk * CHKT + tid;
#pragma unroll
            for (int s = 0; s < 2; ++s) { const int e = R.tok_e[(size_t)s * MTOK + tok]; const int dest = sp[s * 16 + e] + seg[(chunk >> 3) * 16 + s * 8 + e] + cnt[chunk * 16 + s * 8 + e] + R.tok_rank[(size_t)s * MTOK + tok];
                R.row_tok[(size_t)s * MOEROWS + dest] = tok; R.row_gate[(size_t)s * MOEROWS + dest] = R.tok_g[(size_t)tok * 2 + s]; } }
    }
    if (blockIdx.x < 16) { const int s = blockIdx.x >> 3, e = blockIdx.x & 7; const int lo = sp[s * 16 + e] + tot[s * 8 + e], hi = sp[s * 16 + e + 1];
        for (int r = lo + tid; r < hi; r += 512) { R.row_tok[(size_t)s * MOEROWS + r] = -1; R.row_gate[(size_t)s * MOEROWS + r] = 0.f; } }
}
DI void gather_rows(const Route& R, int s, const unsigned char* H8, unsigned char* XB8, int gw, int NGW, int lane) {
    const int nrows = R.startp[s * 16 + 8], per = (nrows + NGW - 1) / NGW, lo = gw * per, hi = (lo + per < nrows) ? lo + per : nrows;
    for (int r0 = lo; r0 < hi; r0 += 11) {
        const int tv = (lane < 11 && r0 + lane < hi) ? R.row_tok[(size_t)s * MOEROWS + r0 + lane] : -1;
        u32x4 a[11];
#pragma unroll
        for (int j = 0; j < 11; ++j) { const int tok = __builtin_amdgcn_readlane(tv, j); a[j] = ((const u32x4*)(H8 + (size_t)(tok < 0 ? 0 : tok) * DM))[lane];
            if (tok < 0) a[j] = (u32x4){0u, 0u, 0u, 0u}; }
#pragma unroll
        for (int j = 0; j < 11; ++j) if (r0 + j < hi) ((u32x4*)(XB8 + (size_t)(r0 + j) * DM))[lane] = a[j];
    }
}
struct MoeOrder {
    int nN, G, c, T; int s1, s2, s3, s4, s5, s6, s7; const char* A; const char* B; size_t tA, tB, eB;
    DI void init(const int* startp, int nN_, int G_, int c_, const void* A_, size_t tA_, const void* B_, size_t tB_, size_t eB_) {
        nN = nN_; G = G_; c = c_; A = (const char*)A_; B = (const char*)B_; tA = tA_; tB = tB_; eB = eB_;
        s1 = startp[1]; s2 = startp[2]; s3 = startp[3]; s4 = startp[4]; s5 = startp[5]; s6 = startp[6]; s7 = startp[7]; T = startp[8] >> 8; }
    DI bool next(int i, Unit& u) const {
        if ((G & 7) == 0) {
            const int x = c & 7, lc = c >> 3, GL = G >> 3;
            const int r0 = (x * T) >> 3, r1 = ((x + 1) * T) >> 3, nr = r1 - r0;
            const int Lx = i * GL + lc; if (Lx >= nr * nN) return false;
            const int nig = 8 * nN, gid = Lx / nig, fm = gid * 8, gsz = (nr - fm) < 8 ? (nr - fm) : 8, w = Lx - gid * nig;
            u.pm = r0 + fm + (w % gsz); u.pn = w / gsz;
        } else {
            const long L = (long)i * G + c; if (L >= (long)T * nN) return false;
            u.pm = (int)(L / nN); u.pn = (int)(L % nN);
        }
        const int r = u.pm << 8;
        const int e = (r >= s1) + (r >= s2) + (r >= s3) + (r >= s4) + (r >= s5) + (r >= s6) + (r >= s7);
        u.g = e; u.A = A + (size_t)u.pm * tA; u.B = B + (size_t)e * eB + (size_t)u.pn * tB; return true;
    }
};
}
#ifndef MK_N_LAUNCHES
#define MK_N_LAUNCHES 1
#endif
#ifndef REP_SEL
#define REP_SEL 1
#endif
#ifndef REP_ATT
#define REP_ATT 1
#endif
#ifndef REP_GEMM
#define REP_GEMM 1
#endif
#ifndef REP_UP
#define REP_UP 1
#endif
#ifndef REP_PRO
#define REP_PRO 1
#endif
#ifndef REP_WIN
#define REP_WIN 1
#endif
#ifndef REP_CMP
#define REP_CMP 1
#endif
#ifndef REP_MIX
#define REP_MIX 1
#endif
#ifndef REP_GA
#define REP_GA 1
#endif
#ifndef REP_X
#define REP_X 1
#endif
#ifndef REP_FILL
#define REP_FILL 1
#endif
#ifndef REP_KT
#define REP_KT 1
#endif
#ifndef TAIL_R
#define TAIL_R 2
#endif
#ifndef REP_THIN
#define REP_THIN 1
#endif
constexpr int NWAVES = 8, NTHR = 512;
constexpr int LDS_MISC = 131072, LDS_BYTES = 147456;
constexpr int PH_PER_LAYER = 17, N_PHASES = 2 + NLAYER * PH_PER_LAYER;
enum { I_X = 0, I_MEM, I_NORM_MIX, I_W_IN, I_LRE, I_LIM, I_LDT, I_BRE, I_BIM, I_CRE, I_CIM, I_DSK, I_WGLU, I_CWDW, I_CBDW, I_CLNG, I_CLNB, I_CWPW, I_QNORM, I_KNORM, I_CPE, I_CW1, I_CW2,
       I_MIXNORM, I_WOUT, I_T5, I_NCROSS, I_NMEM, I_XWQ, I_XWKV, I_XQN, I_XKN, I_XWO, I_NFFN, I_FUP, I_FDN, I_ROUTER, I_MUP, I_MDN, N_IN };
constexpr int xt_cnt(int nb, int K, int Nout) { return nb * (K / 64) * (Nout / 32); }
constexpr int XT_LAYER = xt_cnt(1, DM, PROJP) + xt_cnt(1, 256, 512) + xt_cnt(1, 256, 256) + xt_cnt(1, DM, DM) + xt_cnt(1, DM, XW) + xt_cnt(1, DM, 2 * XW) + xt_cnt(1, XW, DM) + xt_cnt(2, 2048, 64) + xt_cnt(2, 64, 64);
constexpr int XT_TOTAL = NLAYER * XT_LAYER + xt_cnt(1, DM, 2 * DFF) + xt_cnt(1, DFF, DM) + xt_cnt(NEXP, DM, 2 * DFF) + xt_cnt(NEXP, DFF, DM);
struct Args { const float* in[N_IN]; float* out; unsigned char* ws; int ph_lo, ph_hi; };
typedef const Args __attribute__((address_space(4)))* ArgsP;

#define UX ((bf16_t*)(ws + A_UX))
#define CVIN ((bf16_t*)(ws + A_CVIN))
#define Q ((bf16_t*)(ws + A_Q))
#define KC ((bf16_t*)(ws + A_KC))
#define VC ((bf16_t*)(ws + A_VC))
#define KS ((bf16_t*)(ws + A_KS))
#define KW ((bf16_t*)(ws + A_KW))
#define VST ((bf16_t*)(ws + A_VST))
#define VWT ((bf16_t*)(ws + A_VWT))
#define OC ((bf16_t*)(ws + A_OC))
#define OS ((bf16_t*)(ws + A_OS))
#define OW ((bf16_t*)(ws + A_OW))
#define YG ((bf16_t*)(ws + A_YG))
#define YSSM ((bf16_t*)(ws + A_YSSM))
#define CV ((bf16_t*)(ws + A_CV))
#define YCONV ((bf16_t*)(ws + A_YCONV))
#define KCMP ((bf16_t*)(ws + A_KCMP))
#define VCMPT ((bf16_t*)(ws + A_VCMPT))
#define AMIX ((bf16_t*)(ws + A_AMIX))
#define QX ((bf16_t*)(ws + A_QX))
#define OX ((bf16_t*)(ws + A_OX))
#define FFA ((bf16_t*)(ws + A_FFA))
#define XB ((bf16_t*)(ws + A_XB))
#define GATE ((float*)(ws + A_GATE))
#define ZC ((float*)(ws + A_ZC))
#define SEL ((unsigned*)(ws + A_SEL))
#define HB ((bf16_t*)(ws + WS_HB))
#define SS ((u64*)(ws + CTL_SS))
#define SSMEM ((u64*)(ws + CTL_SSMEM))
__global__ void __launch_bounds__(NTHR, 2) trunk_fwd(Args args) {
    extern __shared__ __attribute__((aligned(16))) unsigned char lds_raw[];
    LAS unsigned char* lds = (LAS unsigned char*)lds_raw;
    volatile LAS unsigned* MISC = (volatile LAS unsigned*)(lds + LDS_MISC);
    const int tid0 = threadIdx.x; const int wid0 = __builtin_amdgcn_readfirstlane(tid0 >> 6);
#define PHASE_IDS int bid = blockIdx.x, G = gridDim.x; asm volatile("" : "+s"(bid), "+s"(G)); const int NGW = G * NWAVES; (void)NGW; int lane; asm volatile("v_mbcnt_lo_u32_b32 %0, -1, 0\n\tv_mbcnt_hi_u32_b32 %0, -1, %0" : "=v"(lane)); const int wid = wid0, tid = wid * 64 + lane, gw = bid * NWAVES + wid; (void)gw; ArgsP ap = (ArgsP)__builtin_amdgcn_kernarg_segment_ptr(); asm volatile("" : "+s"(ap)); unsigned char* const ws = ap->ws; float* const out = ap->out; (void)out;
    if (tid0 < 64) MISC[tid0] = 0u;
    __syncthreads();
    XcdBarrier bar; bar.bar = (unsigned*)(args.ws + CTL_BAR); bar.x = 0; bar.st = nullptr;
    if (MK_N_LAUNCHES == 1) bar = xcd_barrier_post((unsigned*)(args.ws + CTL_BAR), MISC + 8);
    const int lo = args.ph_lo, hi = args.ph_hi;
#ifndef ONLY
#define ONLY -1
#endif
#define PHON(k) (ONLY < 0 || ONLY == (k))
#define IN(k) (lo <= (k) && (k) < hi)
#define SEAM(k) do { if (IN(k) && IN((k) + 1)) xcd_barrier(bar); } while (0)

    for (int rep0 = 0; rep0 < REP_PRO; ++rep0) if (IN(0) && PHON(100)) { PHASE_IDS
        LAS float* scr = (LAS float*)(lds + wid * 16384);
#define XD(W_, gain_, out_, K_, N_, Nout_, map_, nb_, wst_, ost_) { constexpr int cnt_ = (nb_) * ((K_) / 64) * ((Nout_) / 32); \
            if (!found_) { if (r < cnt_) { dsel = thin::XDesc{(W_), (gain_), (bf16_t*)(out_), (K_), (N_), (Nout_), (map_), (nb_), XF8, (size_t)(wst_), (size_t)(ost_)}; found_ = true; } else r -= cnt_; } }
        auto pick = [&](int it_, thin::XDesc& dsel, int& r) { r = it_; bool found_ = false;
#define XF8 0
#pragma unroll
            for (int L = 0; L < NLAYER; ++L) {
                XD(ap->in[I_W_IN] + (size_t)L * DM * PROJW, ap->in[I_NORM_MIX] + L * DM, ws + W_IN + (size_t)L * PROJP * DM * 2, DM, PROJW, PROJP, thin::MAP_WIN, 1, 0, 0)
                XD(ap->in[I_WGLU] + (size_t)L * 256 * 512, nullptr, ws + W_GLU + (size_t)L * 512 * 256 * 2, 256, 512, 512, thin::MAP_GLU, 1, 0, 0)
                XD(ap->in[I_CWPW] + (size_t)L * 256 * 256, nullptr, ws + W_PW + (size_t)L * 256 * 256 * 2, 256, 256, 256, thin::MAP_ID, 1, 0, 0)
                if ((WOUT_F8 >> L) & 1) {
#undef XF8
#define XF8 1
                XD(ap->in[I_WOUT] + (size_t)L * DM * DM, ap->in[I_MIXNORM] + L * DM, ws + W_OUT + (size_t)L * DM * DM * 2, DM, DM, DM, thin::MAP_ID, 1, 0, 0)
#undef XF8
#define XF8 0
                } else {
                XD(ap->in[I_WOUT] + (size_t)L * DM * DM, ap->in[I_MIXNORM] + L * DM, ws + W_OUT + (size_t)L * DM * DM * 2, DM, DM, DM, thin::MAP_ID, 1, 0, 0)
                }
                XD(ap->in[I_XWQ] + (size_t)L * DM * XW, ap->in[I_NCROSS] + L * DM, ws + W_XQ + (size_t)L * XW * DM * 2, DM, XW, XW, thin::MAP_HEAD, 1, 0, 0)
                XD(ap->in[I_XWKV] + (size_t)L * DM * 2 * XW, ap->in[I_NMEM] + L * DM, ws + W_XKV + (size_t)L * 2 * XW * DM * 2, DM, 2 * XW, 2 * XW, thin::MAP_HEAD, 1, 0, 0)
                XD(ap->in[I_XWO] + (size_t)L * XW * DM, nullptr, ws + W_XO + (size_t)L * DM * XW * 2, XW, DM, DM, thin::MAP_ID, 1, 0, 0)
                XD(ap->in[I_CW1] + (size_t)L * 2 * 2048 * 64, nullptr, ws + W_C1 + (size_t)L * 2 * 64 * 2048 * 2, 2048, 64, 64, thin::MAP_ID, 2, 2048 * 64, 64 * 2048)
                XD(ap->in[I_CW2] + (size_t)L * 2 * 64 * 64, nullptr, ws + W_C2 + (size_t)L * 2 * 64 * 64 * 2, 64, 64, 64, thin::MAP_ID, 2, 64 * 64, 64 * 64)
            }
#undef XF8
#define XF8 1
            XD(ap->in[I_FUP], ap->in[I_NFFN], ws + W_UP, DM, 2 * DFF, 2 * DFF, thin::MAP_GLU, 1, 0, 0)
            XD(ap->in[I_FDN], nullptr, ws + W_DN, DFF, DM, DM, thin::MAP_ID, 1, 0, 0)
            XD(ap->in[I_MUP], ap->in[I_NFFN] + DM, ws + W_MUP, DM, 2 * DFF, 2 * DFF, thin::MAP_GLU, NEXP, (size_t)DM * 2 * DFF, (size_t)2 * DFF * DM)
            XD(ap->in[I_MDN], nullptr, ws + W_MDN, DFF, DM, DM, thin::MAP_ID, NEXP, (size_t)DFF * DM, (size_t)DM * DFF)
#undef XF8
        };
        for (int it = gw; it < XT_TOTAL; it += 2 * NGW) {
            thin::XDesc dA{}, dB{}; int rA, rB; const bool hasB = it + NGW < XT_TOTAL;
            pick(it, dA, rA); pick(hasB ? it + NGW : it, dB, rB);
            f32x4 vA[8], vB[8]; float gA[8], gB[8];
            thin::xload(dA, rA, vA, gA, lane); thin::xload(dB, rB, vB, gB, lane);
            thin::xstore(dA, rA, vA, gA, scr, lane);
            if (hasB) thin::xstore(dB, rB, vB, gB, scr, lane);
        }
#undef XD
        for (int repx = 0; repx < REP_X; ++repx) for (int r = 2 * gw; r < MTOK; r += 2 * NGW) thin::row2_to_bf16_ss(ap->in[I_X] + (size_t)r * DM, HB + (size_t)r * DM, SS + r, lane);
        for (int r = gw; r < MMEM; r += NGW) thin::row_to_bf16_ss(ap->in[I_MEM] + (size_t)r * DM, (bf16_t*)(ws + T_MEMB) + (size_t)r * DM, SSMEM + r, lane);
        for (int o = gw; o < 256; o += NGW) {
            const int lk = o >> 6, u = o & 63; const float* pe = ap->in[I_CPE] + (size_t)lk * 2048; const float* w1 = ap->in[I_CW1] + (size_t)lk * 2048 * 64; float a = 0.f;
#pragma unroll 1
            for (int k0 = 0; k0 < 2048; k0 += 1024) {
                float pv[16], wv[16];
#pragma unroll
                for (int i = 0; i < 16; ++i) { const int k = k0 + lane + 64 * i; pv[i] = pe[k]; wv[i] = w1[(size_t)k * 64 + u]; }
#pragma unroll
                for (int i = 0; i < 16; ++i) a += pv[i] * wv[i]; }
            a = wave_sum(a); if (lane == 0) ((float*)(ws + T_CB))[o] = a; }
        if (bid == 1 && tid < 64) {
            const int L = tid >> 5, br = (tid >> 3) & 3, h = tid & 7; float G = 0.f, bmax = 0.f;
            if (br < 3) { for (int d = 0; d < 64; ++d) G = fmaxf(G, fabsf(ap->in[I_QNORM][L * 64 + d] * ap->in[I_KNORM][L * 192 + br * 64 + d]));
                for (int d = 0; d <= 128; ++d) bmax = fmaxf(bmax, (ap->in[I_T5][thin::t5_bucket(d) * 8 + h] - ap->in[I_T5][31 * 8 + h]) * LOG2E); }
            else { for (int d = 0; d < 64; ++d) G = fmaxf(G, fabsf(ap->in[I_XQN][L * 64 + d] * ap->in[I_XKN][L * 64 + d])); }
            ((float*)(ws + T_BND))[tid] = QSCALE * 64.0f * G * 1.001f + bmax; }
        if (bid == 0) for (int i = tid; i < 8 * 132; i += NTHR) { const int h = i / 132, d = i % 132; ((float*)(ws + T_BIAS))[i] = (ap->in[I_T5][thin::t5_bucket(d < 128 ? d : 128) * 8 + h] - ap->in[I_T5][31 * 8 + h]) * LOG2E; }
        for (int repk = 0; repk < REP_KT; ++repk) for (int tk = gw; tk < 2 * 16 * 64; tk += NGW) { const int L = tk >> 10, g = (tk >> 6) & 15, tau = tk & 63;
            const thin::S5P P{ap->in[I_LRE] + L * 1024, ap->in[I_LIM] + L * 1024, ap->in[I_LDT] + L * 16, ap->in[I_BRE] + L * 16384, ap->in[I_BIM] + L * 16384, ap->in[I_CRE] + L * 16384, ap->in[I_CIM] + L * 16384, ap->in[I_DSK] + L * 256};
            thin::ktab_task(P, (float*)(ws + T_KTAB) + (size_t)L * 16 * 64 * 256, g, tau, scr, lane); }
        for (int i = bid * NTHR + tid; i < 2 * 1024; i += G * NTHR) { const int L = i >> 10, g = (i >> 6) & 15, p = i & 63;
            const thin::S5P P{ap->in[I_LRE] + L * 1024, ap->in[I_LIM] + L * 1024, ap->in[I_LDT] + L * 16, nullptr, nullptr, nullptr, nullptr, nullptr};
            float wr, wi; thin::lam_pow(P, g, p, 64.f, wr, wi); ((float*)(ws + T_A64))[i * 2] = wr; ((float*)(ws + T_A64))[i * 2 + 1] = wi; }
    }
    SEAM(0);
    if (IN(1) && PHON(101)) { PHASE_IDS
        for (int i0 = bid * NTHR + tid; i0 < 2 * 16 * 1024 * 128; i0 += 4 * G * NTHR) {
            f32x4 fa[4], fb[4];
#pragma unroll
            for (int q = 0; q < 4; ++q) { const int i = i0 + q * G * NTHR; fa[q] = (f32x4){0.f, 0.f, 0.f, 0.f}; fb[q] = fa[q];
                if (i < 2 * 16 * 1024 * 128) { const int k8 = i & 127, r = i >> 7, n = r & 1023, g = (r >> 10) & 15, L = r >> 14; thin::st_load8((const float*)(ws + T_KTAB) + (size_t)L * 16 * 64 * 256, g, n, 8 * k8, fa[q], fb[q]); } }
#pragma unroll
            for (int q = 0; q < 4; ++q) { const int i = i0 + q * G * NTHR;
                if (i < 2 * 16 * 1024 * 128) { const int k8 = i & 127, r = i >> 7, n = r & 1023, g = (r >> 10) & 15, L = r >> 14;
                    const thin::S5P P{nullptr, nullptr, nullptr, nullptr, nullptr, nullptr, nullptr, ap->in[I_DSK] + L * 256};
                    thin::st_store8(P, (bf16_t*)(ws + W_ST) + (size_t)L * 16 * 1024 * SKX, g, n, 8 * k8, fa[q], fb[q]); } } }
        for (int rep = 0; rep < REP_FILL; ++rep) for (int i = bid * NTHR + tid; i < 2 * 16 * 64 * 64; i += G * NTHR) { const int p = i & 63, to = (i >> 6) & 63, g = (i >> 12) & 15, L = i >> 16;
            const thin::S5P P{ap->in[I_LRE] + L * 1024, ap->in[I_LIM] + L * 1024, ap->in[I_LDT] + L * 16, nullptr, nullptr, ap->in[I_CRE] + L * 16384, ap->in[I_CIM] + L * 16384, nullptr};
            thin::st_carry(P, (bf16_t*)(ws + W_ST) + (size_t)L * 16 * 1024 * SKX, g, to, p); }
        for (int rep = 0; rep < REP_FILL; ++rep) for (long i = (long)bid * NTHR + tid; i < 2L * 16 * 256 * 128; i += (long)G * NTHR) { const int k8 = (int)(i & 127); const long r = i >> 7; const int n = (int)(r & 255), g = (int)((r >> 8) & 15), L = (int)(r >> 12);
            const thin::S5P P{ap->in[I_LRE] + L * 1024, ap->in[I_LIM] + L * 1024, ap->in[I_LDT] + L * 16, ap->in[I_BRE] + L * 16384, ap->in[I_BIM] + L * 16384, nullptr, nullptr, nullptr};
            thin::sz_fill8(P, (bf16_t*)(ws + W_SZ) + (size_t)L * 16 * 256 * 1024, g, n, 8 * k8); }
    }

    for (int layer = 0; layer < NLAYER; ++layer) {
        const int pb = 2 + layer * PH_PER_LAYER;
        if (hi <= pb || lo >= pb + PH_PER_LAYER) continue;
        if (IN(pb + 0) && PHON(0)) { PHASE_IDS
            pg8::TileOrder S; S.init(MTOK / 256, PROJP / 256, 1, G, bid, HB, (size_t)256 * DM * 2, 0, ws + W_IN + (size_t)layer * PROJP * DM * 2, (size_t)256 * DM * 2, 0);
            epi::EpiWin E{SS + (size_t)(3 * layer) * MTOK, UX, CVIN, Q, KC, VC, KS, KW, VST, VWT, GATE, ap->in[I_QNORM] + layer * 64, ap->in[I_KNORM] + layer * 192};
            for (int rep = 0; rep < REP_WIN; ++rep) pg8::gemm_phase<epi::EpiWin, pg8::TileOrder, true>(lds, pg8::Gemm{DM, DM, DM}, S, E, tid);
        }
        SEAM(pb + 0);
        if (IN(pb + 1) && PHON(1)) { PHASE_IDS
            { pg8::TileOrder S; S.init(4, 1, 16, G, bid, UX, (size_t)256 * SKX * 2, (size_t)NCHUNK * SKX * 2, ws + W_SZ + (size_t)layer * 16 * 256 * 1024 * 2, (size_t)256 * 1024 * 2, (size_t)256 * 1024 * 2);
              epi::EpiS5State E{ZC};
              for (int rep = 0; rep < REP_GEMM; ++rep) pg8::gemm_phase<epi::EpiS5State, pg8::TileOrder, false>(lds, pg8::Gemm{1024, SKX, 1024}, S, E, tid); }
            if (layer == 0) {
              pg8::TileOrder S; S.init(8, 2, 2, G, (bid + G - 128 % G) % G, ws + T_MEMB, (size_t)256 * DM * 2, 0, ws + W_XKV, (size_t)256 * DM * 2, (size_t)512 * DM * 2);
              epi::EpiMemKV E{SSMEM, (bf16_t*)(ws + T_KM), (bf16_t*)(ws + T_VMT), ap->in[I_XKN]};
              pg8::gemm_phase<epi::EpiMemKV, pg8::TileOrder, false>(lds, pg8::Gemm{DM, DM, DM}, S, E, tid); }
            __syncthreads();
            for (int rep = 0; rep < REP_THIN; ++rep) for (int tk = (gw + NGW - 512 % NGW) % NGW; tk < 512; tk += NGW) { const int which = tk >> 8, plane = (tk >> 4) & 15, n0 = (tk & 15) * 32; const int lk = layer * 2 + which;
                att::compress_task(which, plane, n0, which ? VC : KC, (const bf16_t*)(ws + W_C1) + (size_t)lk * 64 * 2048, (const float*)(ws + T_CB) + lk * 64, (const bf16_t*)(ws + W_C2) + (size_t)lk * 64 * 64,
                                   ap->in[I_KNORM] + layer * 192, KCMP, VCMPT, lane); }
            { const int nu = MTOK / 64, rstat = (nu / G > 2) ? nu / G - 2 : 0;
              unsigned* ctr = (unsigned*)(ws + CTL_MOE + 524288) + layer * 64 + 32;
              volatile LAS unsigned* dq = (volatile LAS unsigned*)(lds + LDS_MISC + 128);
#pragma unroll 1
              for (int round = 0;; ++round) { int u;
                if (round < rstat) u = bid + round * G;
                else { __syncthreads(); if (tid == 0) *dq = (unsigned)(rstat * G) + __hip_atomic_fetch_add(ctr, 1u, __ATOMIC_RELAXED, __HIP_MEMORY_SCOPE_AGENT); __syncthreads(); u = (int)*dq; }
                if (u >= nu) break;
                thin::conv_unit(lds, u, CVIN, ap->in[I_CWDW] + layer * 31 * 256, ap->in[I_CBDW] + layer * 256, ap->in[I_CLNG] + layer * 256, ap->in[I_CLNB] + layer * 256, CV, tid); } }
        }
        SEAM(pb + 1);
        if (IN(pb + 2) && PHON(2)) { PHASE_IDS
            for (int rep = 0; rep < REP_THIN; ++rep) if (bid < 16) thin::s5_combine((const float*)(ws + T_A64) + layer * 2048, ZC, UX, bid * NTHR + tid);
            { pg8::TileOrder S; S.init(MTOK / 256, 1, 1, G, bid, CV, (size_t)256 * 256 * 2, 0, ws + W_PW + (size_t)layer * 256 * 256 * 2, (size_t)256 * 256 * 2, 0);
              epi::EpiPlain E{YCONV, 256};
              for (int rep = 0; rep < REP_GEMM; ++rep) pg8::gemm_phase<epi::EpiPlain, pg8::TileOrder, false>(lds, pg8::Gemm{256, 256, 256}, S, E, tid); }
            for (int i = tid; i < 8 * 132; i += NTHR) ((LAS float*)(lds + att::L_BIAS))[i] = ((const float*)(ws + T_BIAS))[i];
            att::build_ovt(lds, tid);
            __syncthreads();
            for (int rep = 0; rep < REP_CMP; ++rep) for (int u = bid; u < 2048; u += G) { const int c = 127 - (u >> 4), pl = u & 15; int lf_; asm volatile("v_mbcnt_lo_u32_b32 %0, -1, 0\n\tv_mbcnt_hi_u32_b32 %0, -1, %0" : "=v"(lf_)); att::cmp_unit(lds, pl >> 1, pl & 1, c, Q, KCMP, VCMPT, OC, SEL, (const float*)(ws + T_BND) + layer * 32 + 0, wid * 64 + lf_); }
            __syncthreads();
            att::fill_xt((LAS float*)(lds + att::L_IMP), (const LAS float*)(lds + att::L_BIAS), att::XT_WIN, 512, tid);
            __syncthreads();
            for (int rep = 0; rep < REP_ATT; ++rep) for (int u = bid; u < 2048; u += G) { const int c = 127 - (u >> 4), pl = u & 15; int lf_; asm volatile("v_mbcnt_lo_u32_b32 %0, -1, 0\n\tv_mbcnt_hi_u32_b32 %0, -1, %0" : "=v"(lf_)); att::window_unit(lds, pl >> 1, pl & 1, c, Q, KW, VWT, OW, (const float*)(ws + T_BND) + layer * 32 + 16, wid * 64 + lf_); }
        }
        SEAM(pb + 2);
        if (IN(pb + 3) && PHON(3)) { PHASE_IDS
            { pg8::TileOrder S; S.init(4, 4, 16, G, bid, UX, (size_t)256 * SKX * 2, (size_t)NCHUNK * SKX * 2, ws + W_ST + (size_t)layer * 16 * 1024 * SKX * 2, (size_t)256 * SKX * 2, (size_t)1024 * SKX * 2);
              epi::EpiS5Out E{YG};
              for (int rep = 0; rep < REP_GEMM; ++rep) pg8::gemm_phase<epi::EpiS5Out, pg8::TileOrder, false>(lds, pg8::Gemm{SKX, SKX, SKX}, S, E, tid); }
            __syncthreads();
            { float tbv[3];
#pragma unroll
              for (int q = 0; q < 3; ++q) { const int i = tid + 512 * q; tbv[q] = i < 8 * 132 ? ((const float*)(ws + T_BIAS))[i] : 0.f; }
#pragma unroll
              for (int q = 0; q < 3; ++q) { const int i = tid + 512 * q; if (i < 8 * 132) ((LAS float*)(lds + att::SP_BIAS))[i] = tbv[q]; } }
            __syncthreads();
            att::fill_xt((LAS float*)(lds + att::SP_END), (const LAS float*)(lds + att::SP_BIAS), att::XT_SEL, 1 << 30, tid);
            __syncthreads();
            { const int nstat = (2048 / G > TAIL_R) ? (2048 / G - TAIL_R) * G : 0;
              for (int u = bid; u < nstat; u += G) { const int c = 127 - (u >> 4), pl = u & 15; int lf_; asm volatile("v_mbcnt_lo_u32_b32 %0, -1, 0\n\tv_mbcnt_hi_u32_b32 %0, -1, %0" : "=v"(lf_));
                att::sel_sparse_unit(lds, pl >> 1, pl & 1, c, Q, KS, VST, SEL, OS, (const float*)(ws + T_BND) + layer * 32 + 8, wid * 64 + lf_); }
              unsigned* ctr = (unsigned*)(ws + CTL_MOE + 524288) + layer * 64;
              volatile LAS unsigned* dq = (volatile LAS unsigned*)(lds + LDS_MISC + 128);
              for (;;) {
                __syncthreads();
                if (tid == 0) *dq = (unsigned)nstat + __hip_atomic_fetch_add(ctr, 1u, __ATOMIC_RELAXED, __HIP_MEMORY_SCOPE_AGENT);
                __syncthreads();
                const int u = (int)*dq; if (u >= 2048) break;
                const int c = 127 - (u >> 4), pl = u & 15; int lf_; asm volatile("v_mbcnt_lo_u32_b32 %0, -1, 0\n\tv_mbcnt_hi_u32_b32 %0, -1, %0" : "=v"(lf_));
                att::sel_sparse_unit(lds, pl >> 1, pl & 1, c, Q, KS, VST, SEL, OS, (const float*)(ws + T_BND) + layer * 32 + 8, wid * 64 + lf_); } }
        }
        SEAM(pb + 3);
        if (IN(pb + 4) && PHON(4)) { PHASE_IDS
            pg8::TileOrder S; S.init(MTOK / 256, 2, 1, G, bid, YG, (size_t)256 * 256 * 2, 0, ws + W_GLU + (size_t)layer * 512 * 256 * 2, (size_t)256 * 256 * 2, 0);
            epi::EpiGate<0> E{YSSM, 256, nullptr, nullptr};
            for (int rep = 0; rep < REP_GEMM; ++rep) pg8::gemm_phase<epi::EpiGate<0>, pg8::TileOrder, true>(lds, pg8::Gemm{256, 256, 256}, S, E, tid);
        }
        SEAM(pb + 4);
        if (IN(pb + 5) && PHON(5)) { PHASE_IDS if ((WOUT_F8 >> layer) & 1) { for (int r = 2 * gw; r < MTOK; r += 2 * NGW) thin::mixnorm_row2<true>(r, YSSM, YCONV, OC, OS, OW, GATE, AMIX, lane); }
            else for (int rep = 0; rep < REP_MIX; ++rep) for (int r = 2 * gw; r < MTOK; r += 2 * NGW) thin::mixnorm_row2<false>(r, YSSM, YCONV, OC, OS, OW, GATE, AMIX, lane); }
        SEAM(pb + 5);
        if (IN(pb + 6) && PHON(6)) { PHASE_IDS
            if ((WOUT_F8 >> layer) & 1) {
            pg8::TileOrder S; S.init(MTOK / 256, 4, 1, G, bid, AMIX, (size_t)256 * DM, 0, ws + W_OUT + (size_t)layer * DM * DM * 2, (size_t)256 * DM, 0);
            epi::EpiRes<false, true> E{HB, nullptr, HB, SS + (size_t)(3 * layer + 1) * MTOK, nullptr, nullptr, 1.0f / W8_SCALE, nullptr};
            pg8::gemm_phase<epi::EpiRes<false, true>, pg8::TileOrder, true, true>(lds, pg8::Gemm{DM / 2, DM / 2, DM / 2}, S, E, tid);
            } else {
            pg8::TileOrder S; S.init(MTOK / 256, 4, 1, G, bid, AMIX, (size_t)256 * DM * 2, 0, ws + W_OUT + (size_t)layer * DM * DM * 2, (size_t)256 * DM * 2, 0);
            epi::EpiRes<false, true> E{HB, nullptr, HB, SS + (size_t)(3 * layer + 1) * MTOK, nullptr, nullptr, 1.f, nullptr};
            pg8::gemm_phase<epi::EpiRes<false, true>, pg8::TileOrder, true>(lds, pg8::Gemm{DM, DM, DM}, S, E, tid);
            }
        }
        SEAM(pb + 6);
        if (IN(pb + 7) && PHON(7)) { PHASE_IDS
            pg8::TileOrder S; S.init(MTOK / 256, 1, 1, G, bid, HB, (size_t)256 * DM * 2, 0, ws + W_XQ + (size_t)layer * XW * DM * 2, (size_t)256 * DM * 2, 0);
            epi::EpiXQ E{SS + (size_t)(3 * layer + 1) * MTOK, QX, ap->in[I_XQN] + layer * 64};
            for (int rep = 0; rep < REP_GEMM; ++rep) pg8::gemm_phase<epi::EpiXQ, pg8::TileOrder, false>(lds, pg8::Gemm{DM, DM, DM}, S, E, tid);
        }
        SEAM(pb + 7);
        if (IN(pb + 8) && PHON(8)) { PHASE_IDS
            __syncthreads();
            for (int rep = 0; rep < REP_ATT; ++rep) for (int u = bid; u < 1024; u += G) { const int qt = u & 31, h = (u >> 5) & 3, b = u >> 7;
                att::cross_unit(lds, b, h, qt, QX, (const bf16_t*)(ws + T_KM) + (size_t)layer * 8 * 4 * 256 * 64, (const bf16_t*)(ws + T_VMT) + (size_t)layer * 8 * 4 * 64 * 256, OX, (const float*)(ws + T_BND) + layer * 32 + 24, tid); }
        }
        SEAM(pb + 8);
        if (IN(pb + 9) && PHON(9)) { PHASE_IDS
            pg8::TileOrder S; S.init(MTOK / 256, 4, 1, G, bid, OX, (size_t)256 * XW * 2, 0, ws + W_XO + (size_t)layer * DM * XW * 2, (size_t)256 * XW * 2, 0);
            epi::EpiRes<false, true> E{HB, nullptr, HB, SS + (size_t)(3 * layer + 2) * MTOK, nullptr, nullptr, 1.f, ws + A_H8};
            pg8::gemm_phase<epi::EpiRes<false, true>, pg8::TileOrder, true>(lds, pg8::Gemm{XW, XW, XW}, S, E, tid);
        }
        SEAM(pb + 9);
        if (layer == 0) {
            if (IN(pb + 10) && PHON(10)) { PHASE_IDS
                pg8::TileOrder S; S.init(MTOK / 256, 2 * DFF / 256, 1, G, bid, ws + A_H8, (size_t)256 * DM, 0, ws + W_UP, (size_t)256 * DM, 0);
                epi::EpiGate<1, true> E{FFA, DFF, SS + (size_t)2 * MTOK, nullptr};
                pg8::gemm_phase<epi::EpiGate<1, true>, pg8::TileOrder, true, true>(lds, pg8::Gemm{DM / 2, DM / 2, DM / 2}, S, E, tid);
            }
            SEAM(pb + 10);
            if (IN(pb + 11) && PHON(11)) { PHASE_IDS
                pg8::TileOrder S; S.init(MTOK / 256, 4, 1, G, bid, FFA, (size_t)256 * DFF, 0, ws + W_DN, (size_t)256 * DFF, 0);
                epi::EpiRes<false, true> E{HB, nullptr, HB, SS + (size_t)3 * MTOK, nullptr, nullptr, 1.0f / W8_SCALE, nullptr};
                pg8::gemm_phase<epi::EpiRes<false, true>, pg8::TileOrder, true, true>(lds, pg8::Gemm{DFF / 2, DFF / 2, DFF / 2}, S, E, tid);
            }
            if (IN(pb + 11) && IN(pb + PH_PER_LAYER)) xcd_barrier(bar);
        } else {
#define MK_ROUTE int* mi = (int*)(ws + T_ROUTE); const moe::Route R{(int*)(ws + CTL_MOE), (int*)(ws + CTL_MOE + 65536), mi, mi + 2 * MTOK, (float*)(mi + 4 * MTOK), mi + 6 * MTOK, (float*)(mi + 6 * MTOK + 2 * MOEROWS)};
            if (IN(pb + 10) && PHON(10)) { PHASE_IDS MK_ROUTE
                __syncthreads();
                moe::load_router(lds, ap->in[I_ROUTER], ap->in[I_NFFN] + DM, tid);
                __syncthreads();
                for (int rep = 0; rep < REP_THIN; ++rep) for (int ch = bid; ch < moe::NCHK; ch += G) moe::route1_chunk(lds, ch, HB, SS + (size_t)5 * MTOK, R, tid);
            }
            SEAM(pb + 10);
            if (IN(pb + 11) && PHON(11)) { PHASE_IDS MK_ROUTE for (int rep = 0; rep < REP_THIN; ++rep) moe::route2(lds, R, G, tid); }
            SEAM(pb + 11);
            if (IN(pb + 12) && PHON(12)) { PHASE_IDS MK_ROUTE for (int rep = 0; rep < REP_GA; ++rep) moe::gather_rows(R, 0, ws + A_H8, ws + A_XB, gw, NGW, lane); }
            SEAM(pb + 12);
#pragma unroll 1
            for (int s = 0; s < 2; ++s) {
                if (IN(pb + 13 + 2 * s) && PHON(13)) { PHASE_IDS MK_ROUTE
                    moe::MoeOrder S; S.init(R.startp + s * 16, 2 * DFF / 256, G, bid, XB, (size_t)256 * DM, ws + W_MUP, (size_t)256 * DM, (size_t)2 * DFF * DM);
                    epi::EpiGate<2, true> E{FFA, DFF, SS + (size_t)5 * MTOK, R.row_tok + (size_t)s * MOEROWS};
                    pg8::gemm_phase<epi::EpiGate<2, true>, moe::MoeOrder, true, true>(lds, pg8::Gemm{DM / 2, DM / 2, DM / 2}, S, E, tid);
                }
                SEAM(pb + 13 + 2 * s);
                if (IN(pb + 14 + 2 * s) && PHON(14)) { PHASE_IDS MK_ROUTE
                    moe::MoeOrder S; S.init(R.startp + s * 16, 4, G, bid, FFA, (size_t)256 * DFF, ws + W_MDN, (size_t)256 * DFF, (size_t)DM * DFF);
                    epi::EpiRes<true, false> E{HB, s == 1 ? out : nullptr, s == 0 ? HB : nullptr, nullptr, R.row_tok + (size_t)s * MOEROWS, R.row_gate + (size_t)s * MOEROWS, 1.0f / W8_SCALE, nullptr};
                    pg8::gemm_phase<epi::EpiRes<true, false>, moe::MoeOrder, true, true>(lds, pg8::Gemm{DFF / 2, DFF / 2, DFF / 2}, S, E, tid);
                    if (s == 0) for (int rep = 0; rep < REP_GA; ++rep) moe::gather_rows(R, 1, ws + A_H8, ws + A_XB, gw, NGW, lane);
                }
                if (s == 0) SEAM(pb + 14);
            }
        }
    }
#undef IN
#undef SEAM
}

extern "C" void kernel_launch(void* const* d_in, const int* in_sizes, int n_in, void* d_out, int out_size, void* d_ws, size_t ws_size, hipStream_t stream) {
    static int grid = 0;
    if (grid == 0) {
        if (n_in != N_IN || in_sizes[0] != MTOK * DM || out_size != MTOK * DM || ws_size < WS_END) {
            fprintf(stderr, "kernel_launch: built for %d inputs, x/out of %d floats and >= %zu bytes of workspace; got n_in %d, in0 %d, out %d, ws %zu; nothing launched\n", N_IN, MTOK * DM, (size_t)WS_END, n_in, n_in > 0 ? in_sizes[0] : -1, out_size, ws_size);
            grid = -1; return; }
        int dev = 0, cus = 0, per_cu = 0;
        if (hipGetDevice(&dev) != hipSuccess || hipDeviceGetAttribute(&cus, hipDeviceAttributeMultiprocessorCount, dev) != hipSuccess) { grid = -1; return; }
        if (hipFuncSetAttribute((const void*)trunk_fwd, hipFuncAttributeMaxDynamicSharedMemorySize, LDS_BYTES) != hipSuccess) { fprintf(stderr, "kernel_launch: hipFuncSetAttribute failed\n"); grid = -1; return; }
        if (hipOccupancyMaxActiveBlocksPerMultiprocessor(&per_cu, (const void*)trunk_fwd, NTHR, LDS_BYTES) != hipSuccess || per_cu < 1) { fprintf(stderr, "kernel_launch: occupancy query says %d workgroups per CU\n", per_cu); (void)hipGetLastError(); grid = -1; return; }
        grid = cus;
        if (grid > 256) grid = 256;
    }
    if (grid < 0) return;
    unsigned char* ws = (unsigned char*)d_ws;
    (void)hipMemsetAsync(ws + WS_CTL, 0, CTL_ZERO_BYTES, stream);
    Args a{};
    for (int i = 0; i < N_IN; ++i) a.in[i] = (const float*)d_in[i];
    a.out = (float*)d_out; a.ws = ws;
#if MK_N_LAUNCHES == 1
    a.ph_lo = 0; a.ph_hi = N_PHASES;
    hipLaunchKernelGGL(trunk_fwd, dim3(grid), dim3(NTHR), LDS_BYTES, stream, a);
#else
    for (int p = 0; p < N_PHASES; ++p) {
        if (p >= 2 && p < 2 + PH_PER_LAYER && (p - 2) >= 12) continue;
        a.ph_lo = p; a.ph_hi = p + 1;
        hipLaunchKernelGGL(trunk_fwd, dim3(grid), dim3(NTHR), LDS_BYTES, stream, a);
    }
#endif
    const hipError_t le = hipPeekAtLastError();
    if (le != hipSuccess) fprintf(stderr, "kernel_launch: launch failed: %s (grid %d x %d threads, %d B LDS)\n", hipGetErrorName(le), grid, NTHR, LDS_BYTES);
}
```

```cpp
#include <hip/hip_runtime.h>
#include <cstdio>
#include <cstdint>
#include <cmath>

#define LAS __attribute__((address_space(3)))
#define GAS __attribute__((address_space(1)))
#define DI __device__ __forceinline__
typedef unsigned short bf16_t;
typedef short bf16x8 __attribute__((ext_vector_type(8)));
typedef float f32x2 __attribute__((ext_vector_type(2)));
typedef float f32x4 __attribute__((ext_vector_type(4)));
typedef float f32x16 __attribute__((ext_vector_type(16)));
typedef unsigned u32x2 __attribute__((ext_vector_type(2)));
typedef unsigned u32x4 __attribute__((ext_vector_type(4)));
typedef __bf16 bf16x2_t __attribute__((ext_vector_type(2)));
typedef unsigned long long u64;

#ifndef WOUT_F8
#define WOUT_F8 2
#endif
constexpr int NB = 8, SEQ = 8192, DM = 1024, MTOK = NB * SEQ;
constexpr int MEMLEN = 256, MMEM = NB * MEMLEN;
constexpr int NLAYER = 2;
constexpr int SSMW = 256, SSMG = 16, SSMH = 16, SSMP = 64;
constexpr int CHL = 64, NCHUNK = MTOK / CHL;
constexpr int SKX = CHL * SSMH + 2 * SSMP;
constexpr int CONVW = 256, CONVK = 31;
constexpr int NSAW = 512, NQH = 8, NKVH = 2, HD = 64;
constexpr int NCMP = 511, NCMPP = 512, NSEL = 128;
constexpr int PROJW = 2072, PROJP = 2304;
constexpr int XW = 256, DFF = 2816, NEXP = 8;
constexpr int MOEROWS = MTOK + NEXP * 256;
constexpr float EPS = 1e-6f;
constexpr float LOG2E = 1.4426950408889634f;
constexpr float QSCALE = 0.125f * LOG2E;
constexpr float SS_FIX = 16777216.0f;

constexpr size_t MiB = 1u << 20;
constexpr size_t WS_CTL = 0, CTL_ZERO_BYTES = 8 * MiB;
constexpr size_t CTL_BAR = 64 * 1024;
constexpr size_t CTL_SS = 1 * MiB;
constexpr size_t CTL_SSMEM = 5 * MiB;
constexpr size_t CTL_MOE = 6 * MiB;
constexpr size_t WS_W = 8 * MiB;
constexpr size_t W_IN = WS_W;
constexpr size_t W_GLU = W_IN + (size_t)NLAYER * PROJP * DM * 2;
constexpr size_t W_PW = W_GLU + (size_t)NLAYER * 512 * 256 * 2;
constexpr size_t W_OUT = W_PW + (size_t)NLAYER * 256 * 256 * 2;
constexpr size_t W_XQ = W_OUT + (size_t)NLAYER * DM * DM * 2;
constexpr size_t W_XKV = W_XQ + (size_t)NLAYER * XW * DM * 2;
constexpr size_t W_XO = W_XKV + (size_t)NLAYER * 2 * XW * DM * 2;
constexpr size_t W_UP = W_XO + (size_t)NLAYER * DM * XW * 2;
constexpr size_t W_DN = W_UP + (size_t)2 * DFF * DM * 2;
constexpr size_t W_MUP = W_DN + (size_t)DM * DFF * 2;
constexpr size_t W_MDN = W_MUP + (size_t)NEXP * 2 * DFF * DM * 2;
constexpr size_t W_ST = W_MDN + (size_t)NEXP * DM * DFF * 2;
constexpr size_t W_SZ = W_ST + (size_t)NLAYER * SSMG * 1024 * SKX * 2;
constexpr size_t W_C1 = W_SZ + (size_t)NLAYER * SSMG * 256 * 1024 * 2;
constexpr size_t W_C2 = W_C1 + (size_t)NLAYER * 2 * 64 * 2048 * 2;
constexpr size_t W_END = W_C2 + (size_t)NLAYER * 2 * 64 * 64 * 2;
constexpr size_t WS_TAB = (W_END + MiB - 1) / MiB * MiB;
constexpr size_t T_KTAB = WS_TAB;
constexpr size_t T_CB = T_KTAB + 2 * MiB;
constexpr size_t T_BIAS = T_CB + 4096;
constexpr size_t T_BND = T_BIAS + 6144;
constexpr size_t T_A64 = T_BIAS + 8192;
constexpr size_t T_KM = T_A64 + 32768;
constexpr size_t T_VMT = T_KM + 2 * MiB;
constexpr size_t T_MEMB = T_VMT + 2 * MiB;
constexpr size_t T_ROUTE = T_MEMB + 4 * MiB;
constexpr size_t T_END = T_ROUTE + 4 * MiB;
constexpr size_t WS_HB = (T_END + MiB - 1) / MiB * MiB;
constexpr size_t WS_ACT = WS_HB + (size_t)MTOK * DM * 2;
constexpr size_t A_UX = WS_ACT;
constexpr size_t A_CVIN = A_UX + (size_t)SSMG * NCHUNK * SKX * 2;
constexpr size_t A_Q = A_CVIN + (size_t)MTOK * 256 * 2;
constexpr size_t A_KC = A_Q + (size_t)MTOK * 512 * 2;
constexpr size_t A_VC = A_KC + (size_t)MTOK * 128 * 2 + 4096;
constexpr size_t A_KS = A_VC + (size_t)MTOK * 128 * 2 + 4096;
constexpr size_t A_KW = A_KS + (size_t)MTOK * 128 * 2;
constexpr size_t A_VST = A_KW + (size_t)MTOK * 128 * 2;
constexpr size_t A_VWT = A_VST + (size_t)MTOK * 128 * 2;
constexpr size_t A_GATE = A_VWT + (size_t)MTOK * 128 * 2;
constexpr size_t A_OC = A_GATE + (size_t)MTOK * 24 * 4;
constexpr size_t A_OS = A_OC + (size_t)MTOK * 512 * 2;
constexpr size_t A_OW = A_OS + (size_t)MTOK * 512 * 2;
constexpr size_t A_ZC = A_OW + (size_t)MTOK * 512 * 2;
constexpr size_t A_YG = A_ZC + (size_t)SSMG * NCHUNK * 128 * 4;
constexpr size_t A_YSSM = A_YG + (size_t)MTOK * 256 * 2;
constexpr size_t A_CV = A_YSSM + (size_t)MTOK * 256 * 2;
constexpr size_t A_YCONV = A_CV + (size_t)MTOK * 256 * 2;
constexpr size_t A_KCMP = A_YCONV + (size_t)MTOK * 256 * 2;
constexpr size_t A_VCMPT = A_KCMP + 1 * MiB;
constexpr size_t A_SEL = A_VCMPT + 1 * MiB;
constexpr size_t A_MIXEND = A_SEL + 2 * MiB;
constexpr size_t A_AMIX = A_Q;
static_assert(A_AMIX + (size_t)MTOK * DM * 2 <= A_VST, "AMIX overlay");
constexpr size_t A_QX = WS_ACT;
constexpr size_t A_OX = A_QX + (size_t)MTOK * 256 * 2;
constexpr size_t A_FFA = A_OX + (size_t)MTOK * 256 * 2;
constexpr size_t A_XB = A_FFA + (size_t)MOEROWS * DFF;
constexpr size_t A_H8 = A_XB + (size_t)MOEROWS * DM;
constexpr size_t A_FFEND = A_H8 + (size_t)MTOK * DM;
constexpr size_t WS_END = (A_MIXEND > A_FFEND ? A_MIXEND : A_FFEND);
static_assert(WS_END <= (size_t)1024 * MiB, "d_ws map must fit 1 GiB");

DI unsigned cvtpk(float lo, float hi) { f32x2 v = {lo, hi}; bf16x2_t b = __builtin_convertvector(v, bf16x2_t); return __builtin_bit_cast(unsigned, b); }
DI bf16_t f2bf(float f) { return (bf16_t)(cvtpk(f, 0.f) & 0xffffu); }
DI float bf2f(bf16_t h) { return __uint_as_float((unsigned)h << 16); }
DI float bflo(unsigned w) { return __uint_as_float(w << 16); }
DI float bfhi(unsigned w) { return __uint_as_float(w & 0xffff0000u); }
#define DPPF(v, ctrl) __builtin_bit_cast(float, __builtin_amdgcn_mov_dpp(__builtin_bit_cast(int, (v)), (ctrl), 0xF, 0xF, true))
DI float dpp_sum16(float v) {
    v += DPPF(v, 0xB1); v += DPPF(v, 0x4E); v += DPPF(v, 0x141); v += DPPF(v, 0x140); return v;
}
DI float wave_sum(float v) { v = dpp_sum16(v); v += __shfl_xor(v, 16); v += __shfl_xor(v, 32); return v; }
DI float rcpf_(float x) { return __builtin_amdgcn_rcpf(x); }
DI float gelu_tanh(float x) { const float u = 0.7978845608028654f * (x + 0.044715f * x * x * x); const float e = __expf(-2.f * u); return x * rcpf_(1.f + e); }
DI float sigmoidf_(float x) { return rcpf_(1.f + __expf(-x)); }
DI float siluf_(float x) { return x * rcpf_(1.f + __expf(-x)); }
constexpr float W8_SCALE = 32.0f;
typedef int v8i_t __attribute__((ext_vector_type(8)));
DI unsigned pack_fp8x4(float a, float b, float c, float d) { unsigned w = 0u; w = __builtin_amdgcn_cvt_pk_fp8_f32(a, b, w, false); w = __builtin_amdgcn_cvt_pk_fp8_f32(c, d, w, true); return w; }
DI int perm_kv(int s) { return (s & ~12) | ((s & 4) << 1) | ((s & 8) >> 1); }
#define LDS_WAIT() asm volatile("s_waitcnt lgkmcnt(0)" ::: "memory")
#define VM_WAIT() asm volatile("s_waitcnt vmcnt(0)" ::: "memory")
#define XB_TMO      128
#define XB_XCNT(j)  (256  + 64 * (j))
#define XB_XSUB(j)  (1280 + 64 * (j))
#define XB_XGEN(j)  (2304 + 64 * (j))
#define XB_TOP      3328
#define XB_TOPGEN   3392
#define XCD_BAR_WORDS 3456
#define XB_SPIN_CAP (1u << 18)

__device__ __forceinline__ unsigned xb_ld(unsigned* p)              { return __hip_atomic_load(p, __ATOMIC_RELAXED, __HIP_MEMORY_SCOPE_AGENT); }
__device__ __forceinline__ unsigned xb_add(unsigned* p, unsigned v) { return __hip_atomic_fetch_add(p, v, __ATOMIC_RELAXED, __HIP_MEMORY_SCOPE_AGENT); }
__device__ __forceinline__ unsigned xb_xcc_id() { return (unsigned)__builtin_amdgcn_s_getreg((3 << 11) | 20) & 0xFu; }
#define XB_SPIN(cond, bar) do { unsigned _sp = 0; while (cond) { __builtin_amdgcn_s_sleep(1); \
    if ((++_sp & 255u) == 0u) { if (xb_ld(&(bar)[XB_TMO])) break; if (_sp > XB_SPIN_CAP) { atomicAdd(&(bar)[XB_TMO], 1u); break; } } } } while (0)

struct XcdBarrier {
    unsigned* bar; unsigned x;
    volatile LAS unsigned* st;
};

__device__ __forceinline__ XcdBarrier xcd_barrier_post(unsigned* bar, volatile LAS unsigned* st) {
    XcdBarrier b; b.bar = bar; b.x = xb_xcc_id(); b.st = st;
    if (threadIdx.x == 0) (void)xb_add(&bar[XB_XCNT(b.x)], 1u);
    return b;
}
__device__ __forceinline__ void xcd_barrier_complete(unsigned* bar, unsigned x, unsigned& nloc, unsigned& nx) {
    const unsigned G = gridDim.x * gridDim.y * gridDim.z;
    unsigned sum, cnt, mine, sp = 0u;
    for (;;) {
        sum = 0u; cnt = 0u; mine = 0u;
#pragma unroll
        for (unsigned j = 0; j < 16; ++j) { const unsigned c = xb_ld(&bar[XB_XCNT(j)]); sum += c; cnt += (c > 0u) ? 1u : 0u; mine = (j == x) ? c : mine; }
        if (sum == G) break;
        __builtin_amdgcn_s_sleep(1);
        if ((++sp & 255u) == 0u) { if (xb_ld(&bar[XB_TMO])) break; if (sp > XB_SPIN_CAP) { atomicAdd(&bar[XB_TMO], 1u); break; } }
    }
    nloc = mine > 0u ? mine : 1u; nx = cnt > 0u ? cnt : 1u;
}

__device__ __forceinline__ void xcd_barrier(const XcdBarrier& b) {
    asm volatile("s_waitcnt vmcnt(0)" ::: "memory");
    __syncthreads();
    if (threadIdx.x == 0) {
        unsigned* bar = b.bar;
        __builtin_amdgcn_s_waitcnt(0);
        unsigned nloc = b.st[0], nx = b.st[1];
        if (nloc == 0u) { xcd_barrier_complete(bar, b.x, nloc, nx); b.st[0] = nloc; b.st[1] = nx; }
        const unsigned old = xb_add(&bar[XB_XSUB(b.x)], 1u);
        const unsigned gen = old / nloc;
        if (old + 1u == (gen + 1u) * nloc) {
            __builtin_amdgcn_fence(__ATOMIC_RELEASE, "agent");
            asm volatile("s_waitcnt vmcnt(0)" ::: "memory");
            const unsigned og = xb_add(&bar[XB_TOP], 1u);
            const unsigned tg = og / nx;
            if (og + 1u == (tg + 1u) * nx) xb_add(&bar[XB_TOPGEN], 1u);
            else XB_SPIN(xb_ld(&bar[XB_TOPGEN]) == tg, bar);
            __builtin_amdgcn_fence(__ATOMIC_ACQUIRE, "agent");
            xb_add(&bar[XB_XGEN(b.x)], 1u);
            asm volatile("s_waitcnt vmcnt(0)" ::: "memory");
        } else {
            XB_SPIN(xb_ld(&bar[XB_XGEN(b.x)]) == gen, bar);
            __builtin_amdgcn_fence(__ATOMIC_ACQUIRE, "agent");
            asm volatile("s_waitcnt vmcnt(0)" ::: "memory");
        }
    }
    __syncthreads();
}
namespace pg8 {
constexpr int BM = 256, BK = 64, HALF = 128, HTB = HALF * BK * 2  , STAGE_BYTES = 8 * HTB, NXCD = 8, WGM = 8;

DI int lds_byte(int r, int c) { const int st = (r >> 4) * 2 + (c >> 5), rr = r & 15, cc = c & 31, ob = rr * 64 + cc * 2; return st * 1024 + (ob ^ (((ob >> 9) & 1) << 5)); }
DI void stage_rc(int b, int& R, int& C) { const int st = b / 1024, sb = b % 1024, swz = sb ^ (((sb >> 9) & 1) << 5); R = (st >> 1) * 16 + swz / 64; C = (st & 1) * 32 + (swz % 64) / 2; }
DI int perm32(int rho) { const int n = rho >> 4, i = rho & 15; return 8 * (i >> 2) + 4 * n + (i & 3); }

struct Unit { int pm, pn, g; const char* A; const char* B; };
template <class T, class = void> struct KSkipOf { static constexpr bool v = false; };
template <class T> struct KSkipOf<T, decltype((void)&T::ktiles)> { static constexpr bool v = true; };
struct Gemm { int K, lda, ldb; };

struct TileOrder {
    int nM, nN, ngrp, nwg, G, c; const char* A; const char* B; size_t tA, tB, gA, gB;
    DI void init(int nM_, int nN_, int ngrp_, int G_, int c_, const void* A_, size_t tA_, size_t gA_, const void* B_, size_t tB_, size_t gB_) {
        nM = nM_; nN = nN_; ngrp = ngrp_; nwg = nM * nN; G = G_; c = c_; A = (const char*)A_; B = (const char*)B_; tA = tA_; tB = tB_; gA = gA_; gB = gB_; }
    DI bool next(int i, Unit& u) const {
        const long L = (long)i * G + c; if (L >= (long)nwg * ngrp) return false;
        const int grp = (int)(L / nwg); int wgid = (int)(L % nwg);
        if ((nwg % NXCD) == 0 && (G % NXCD) == 0) { const int q = nwg / NXCD, xcd = wgid % NXCD, off = wgid / NXCD; wgid = xcd * q + off; }
        const int nig = WGM * nN, gid = wgid / nig, fm = gid * WGM, gsz = (nM - fm) < WGM ? (nM - fm) : WGM;
        u.pm = fm + ((wgid % nig) % gsz); u.pn = (wgid % nig) / gsz; u.g = grp;
        u.A = A + (size_t)grp * gA + (size_t)u.pm * tA; u.B = B + (size_t)grp * gB + (size_t)u.pn * tB; return true;
    }
};

template <class Epi, class Sched, bool ALIGN_EPI, bool F8 = false>
DI void gemm_phase(LAS unsigned char* lds, const Gemm g, const Sched& S, const Epi& E, const int tid) {
    const int wid = __builtin_amdgcn_readfirstlane(tid >> 6), lane = tid & 63, wr = wid >> 2, wc = wid & 3, fr = lane & 15, fq = lane >> 4;
    const int K = g.K, nt = K / BK;
    unsigned voffA[2], voffB[2];
#pragma unroll
    for (int i = 0; i < 2; ++i) { int R, C; stage_rc(tid * 16 + i * 8192, R, C); const int Rb = Epi::PERM ? ((R & ~31) + perm32(R & 31)) : R;
        voffA[i] = (unsigned)(R * g.lda + C) * 2u; voffB[i] = (unsigned)(Rb * g.ldb + C) * 2u; }
    const size_t kstep = (size_t)(BK * 2);
    const size_t hstepA = (size_t)HALF * g.lda * 2, hstepB = (size_t)HALF * g.ldb * 2;
    const unsigned ldsw = (unsigned)wid * 1024u;
    const int aoff = lds_byte(wr * 64 + fr, fq * 8), boff = lds_byte(wc * 32 + fr, fq * 8);
#define PG8_SA(b, h) (((b) * 2 + (h)) * HTB)
#define PG8_SB(b, h) ((4 + (b) * 2 + (h)) * HTB)
#define PG8_STAGE(bufoff, gbase, voff) do { _Pragma("unroll") for (int _i = 0; _i < 2; ++_i) \
        __builtin_amdgcn_global_load_lds((const unsigned*)((const char*)(gbase) + (voff)[_i]), (LAS unsigned*)(lds + (bufoff) + ldsw + _i * 8192), 16, 0, 0); } while (0)
#define PG8_LD8(addr) __builtin_bit_cast(v8i_t, __builtin_shufflevector(*(const LAS u32x4*)(addr), *(const LAS u32x4*)((addr) + 1024), 0, 1, 2, 3, 4, 5, 6, 7))
#define PG8_LDA(dst, b, h) do { _Pragma("unroll") for (int m = 0; m < 4; ++m) { if constexpr (F8) dst##8[m] = PG8_LD8(lds + PG8_SA(b, h) + aoff + m * 2048); \
        else { _Pragma("unroll") for (int k = 0; k < 2; ++k) dst[m][k] = *(const LAS bf16x8*)(lds + PG8_SA(b, h) + aoff + m * 2048 + k * 1024); } } } while (0)
#define PG8_LDB(dst, b, h) do { _Pragma("unroll") for (int n = 0; n < 2; ++n) { if constexpr (F8) dst##8[n] = PG8_LD8(lds + PG8_SB(b, h) + boff + n * 2048); \
        else { _Pragma("unroll") for (int k = 0; k < 2; ++k) dst[n][k] = *(const LAS bf16x8*)(lds + PG8_SB(b, h) + boff + n * 2048 + k * 1024); } } } while (0)
#define PG8_MMA(ai, bj, At, Bt) do { __builtin_amdgcn_s_setprio(1); _Pragma("unroll") for (int m = 0; m < 4; ++m) _Pragma("unroll") for (int n = 0; n < 2; ++n) { \
        if constexpr (F8) asm volatile("v_mfma_scale_f32_16x16x128_f8f6f4 %0, %1, %2, %0, %3, %3 op_sel_hi:[0,0,0]" : "+v"(acc[ai][bj][m][n]) : "v"(Bt##8[n]), "v"(At##8[m]), "v"(sc8)); \
        else { _Pragma("unroll") for (int k = 0; k < 2; ++k) acc[ai][bj][m][n] = __builtin_amdgcn_mfma_f32_16x16x32_bf16(Bt[n][k], At[m][k], acc[ai][bj][m][n], 0, 0, 0); } } \
        __builtin_amdgcn_s_setprio(0); } while (0)
#define PG8_WAIT_V(n) asm volatile("s_waitcnt vmcnt(" #n ")" ::: "memory")
#define PG8_WAIT_L(n) asm volatile("s_waitcnt lgkmcnt(" #n ")" ::: "memory")
#define PG8_BAR __builtin_amdgcn_s_barrier()
#define PG8_SCHED __builtin_amdgcn_sched_barrier(0)
    unsigned sc8 = 0x7F7F7F7Fu; asm volatile("" : "+v"(sc8));
    Unit cur, nxt; int ui = 0;
    if (!S.next(0, cur)) return;
    f32x4 acc[2][2][4][2];
#pragma unroll
    for (int a = 0; a < 2; ++a)
#pragma unroll
        for (int b = 0; b < 2; ++b)
#pragma unroll
            for (int m = 0; m < 4; ++m)
#pragma unroll
                for (int n = 0; n < 2; ++n) acc[a][b][m][n] = (f32x4){0.f, 0.f, 0.f, 0.f};
    bf16x8 At[F8 ? 1 : 4][2], B0[2][2], B1[2][2]; v8i_t At8[F8 ? 4 : 1], B08[2], B18[2];
    const char* cA = cur.A; const char* cB = cur.B;
    PG8_STAGE(PG8_SB(0, 0), cB, voffB); PG8_STAGE(PG8_SB(0, 1), cB + hstepB, voffB); PG8_STAGE(PG8_SA(0, 0), cA, voffA); PG8_STAGE(PG8_SA(0, 1), cA + hstepA, voffA);
    if (wr == 1) PG8_BAR;
    PG8_WAIT_V(2); PG8_BAR;
    PG8_STAGE(PG8_SB(1, 0), cB + kstep, voffB); PG8_STAGE(PG8_SA(1, 0), cA + kstep, voffA); PG8_STAGE(PG8_SB(1, 1), cB + hstepB + kstep, voffB);
    PG8_WAIT_V(6); PG8_BAR;
    for (;;) {
        const bool has_next = S.next(ui + 1, nxt);
        const char* nA = has_next ? nxt.A : cA; const char* nB = has_next ? nxt.B : cB;
        int ntu = nt; if constexpr (KSkipOf<Epi>::v) ntu = Epi::ktiles(cur, nt);
#pragma unroll 1
        for (int t = 0; t < ntu; t += 2) {
            const bool last = (t == ntu - 2);
            asm volatile("" : "+v"(voffA[0]), "+v"(voffA[1]), "+v"(voffB[0]), "+v"(voffB[1]));
            const char* a1 = cA + (size_t)(t + 1) * kstep;
            const char* a2 = last ? nA : cA + (size_t)(t + 2) * kstep; const char* b2 = last ? nB : cB + (size_t)(t + 2) * kstep;
            const char* a3 = a2 + kstep; const char* b3 = b2 + kstep;
            PG8_LDB(B0, 0, 0); PG8_LDB(B1, 0, 1); PG8_SCHED; PG8_LDA(At, 0, 0); PG8_STAGE(PG8_SA(1, 1), a1 + hstepA, voffA);
            PG8_WAIT_V(8); PG8_WAIT_L(0); PG8_BAR; PG8_MMA(0, 0, At, B0); PG8_MMA(0, 1, At, B1); PG8_BAR; PG8_SCHED;
            PG8_LDA(At, 0, 1); PG8_STAGE(PG8_SB(0, 0), b2, voffB); PG8_STAGE(PG8_SB(0, 1), b2 + hstepB, voffB); PG8_STAGE(PG8_SA(0, 0), a2, voffA);
            PG8_WAIT_V(8); PG8_WAIT_L(0); PG8_BAR; PG8_MMA(1, 0, At, B0); PG8_MMA(1, 1, At, B1); PG8_BAR; PG8_SCHED;
            PG8_LDB(B0, 1, 0); PG8_LDB(B1, 1, 1); PG8_SCHED; PG8_LDA(At, 1, 0); PG8_STAGE(PG8_SA(0, 1), a2 + hstepA, voffA);
            PG8_WAIT_V(8); PG8_WAIT_L(0); PG8_BAR; PG8_MMA(0, 0, At, B0); PG8_MMA(0, 1, At, B1); PG8_BAR; PG8_SCHED;
            PG8_LDA(At, 1, 1); PG8_STAGE(PG8_SB(1, 0), b3, voffB); PG8_STAGE(PG8_SB(1, 1), b3 + hstepB, voffB); PG8_STAGE(PG8_SA(1, 0), a3, voffA);
            PG8_WAIT_V(8); PG8_WAIT_L(0); PG8_BAR; PG8_MMA(1, 0, At, B0); PG8_MMA(1, 1, At, B1); PG8_BAR; PG8_SCHED;
        }
        if constexpr (F8) asm volatile("s_nop 15\n\ts_nop 15\n\ts_nop 15\n\ts_nop 15" ::: "memory");
        if constexpr (ALIGN_EPI) { if (wr == 0) PG8_BAR; }
        if constexpr (!Epi::AFTER_DRAIN) { int fr2 = fr, fq2 = fq; asm volatile("" : "+v"(fr2), "+v"(fq2)); E(acc, cur, wr, wc, fr2, fq2); }
        if (!has_next) break;
#pragma unroll
        for (int a = 0; a < 2; ++a)
#pragma unroll
            for (int b = 0; b < 2; ++b)
#pragma unroll
                for (int m = 0; m < 4; ++m)
#pragma unroll
                    for (int n = 0; n < 2; ++n) acc[a][b][m][n] = (f32x4){0.f, 0.f, 0.f, 0.f};
        cur = nxt; cA = nA; cB = nB; ++ui;
        if constexpr (ALIGN_EPI) { if (wr == 1) PG8_BAR; }
    }
    PG8_WAIT_V(0);
    if constexpr (!ALIGN_EPI) { if (wr == 0) PG8_BAR; }
    PG8_BAR;
    if constexpr (Epi::AFTER_DRAIN) { E.fused(acc, cur, wr, wc, fr, fq, lds, wid, lane); }
#undef PG8_SA
#undef PG8_SB
#undef PG8_STAGE
#undef PG8_LDA
#undef PG8_LDB
#undef PG8_MMA
#undef PG8_LD8
#undef PG8_WAIT_V
#undef PG8_WAIT_L
#undef PG8_BAR
#undef PG8_SCHED
}
}
namespace epi {
using pg8::Unit;
typedef f32x4 Acc[2][2][4][2];
DI float rstd_of(const u64* ss, int row) { return rsqrtf((float)ss[row] * (1.0f / (SS_FIX * 1024.0f)) + EPS); }
DI void rstd8(const u64* ss, int row0, float (&rs)[8]) {
    u64 t[8];
#pragma unroll
    for (int q = 0; q < 8; ++q) t[q] = ss[row0 + (q >> 2) * 128 + (q & 3) * 16];
#pragma unroll
    for (int q = 0; q < 8; ++q) rs[q] = rsqrtf((float)t[q] * (1.0f / (SS_FIX * 1024.0f)) + EPS);
}
DI u32x4 pack8(const f32x4 a, const f32x4 b) { u32x4 w; w.x = cvtpk(a[0], a[1]); w.y = cvtpk(a[2], a[3]); w.z = cvtpk(b[0], b[1]); w.w = cvtpk(b[2], b[3]); return w; }

DI void gains4(const float* gain, int fq, f32x4 (&gvv)[4]) {
#pragma unroll
    for (int bj = 0; bj < 2; ++bj)
#pragma unroll
        for (int n = 0; n < 2; ++n) gvv[2 * bj + n] = *(const f32x4*)(gain + 32 * bj + 8 * fq + 4 * n);
}
template <int MODE>
DI void head_store(const Acc& acc, int ai, int m, float rs, const f32x4 (&gvv)[4], float scale, bf16_t* dst, int fq, int tpitch, int spos) {
    f32x4 v[2][2];
#pragma unroll
    for (int bj = 0; bj < 2; ++bj)
#pragma unroll
        for (int n = 0; n < 2; ++n) v[bj][n] = acc[ai][bj][m][n] * rs;
    if (MODE == 0 || MODE == 3) {
        float s = 0.f;
#pragma unroll
        for (int bj = 0; bj < 2; ++bj)
#pragma unroll
            for (int n = 0; n < 2; ++n) s += (v[bj][n][0] * v[bj][n][0] + v[bj][n][1] * v[bj][n][1]) + (v[bj][n][2] * v[bj][n][2] + v[bj][n][3] * v[bj][n][3]);
        s += __shfl_xor(s, 16); s += __shfl_xor(s, 32);
        const float r2 = rsqrtf(s * (1.0f / 64.0f) + EPS) * scale;
#pragma unroll
        for (int bj = 0; bj < 2; ++bj)
#pragma unroll
            for (int n = 0; n < 2; ++n) v[bj][n] = v[bj][n] * gvv[2 * bj + n] * r2;
    }
    if (MODE == 0 || MODE == 1) {
#pragma unroll
        for (int bj = 0; bj < 2; ++bj) *(u32x4*)(dst + 32 * bj + 8 * fq) = pack8(v[bj][0], v[bj][1]);
    } else if (MODE == 3) {
#pragma unroll
        for (int bj = 0; bj < 2; ++bj) { const int d8 = 32 * bj + 8 * fq, f = 2 * (d8 >> 4) + (spos >> 5), ln = (spos & 31) + 32 * ((d8 >> 3) & 1);
            *(u32x4*)(dst + (f * 64 + ln) * 8) = pack8(v[bj][0], v[bj][1]); }
    } else if (MODE == 4) {
        const int ks = spos >> 4, w = spos & 15, hi_ = (w >> 2) & 1, el = 4 * (w >> 3) + (w & 3);
#pragma unroll
        for (int bj = 0; bj < 2; ++bj)
#pragma unroll
            for (int n = 0; n < 2; ++n)
#pragma unroll
                for (int i = 0; i < 4; ++i) { const int d = 32 * bj + 8 * fq + 4 * n + i; dst[((2 * ks + (d >> 5)) * 64 + (d & 31) + 32 * hi_) * 8 + el] = f2bf(v[bj][n][i]); }
    } else {
        bf16_t* p = dst + (size_t)(8 * fq) * tpitch + perm_kv(spos);
#pragma unroll
        for (int bj = 0; bj < 2; ++bj) {
#pragma unroll
            for (int n = 0; n < 2; ++n)
#pragma unroll
                for (int i = 0; i < 4; ++i) p[(size_t)(4 * n + i) * tpitch] = f2bf(v[bj][n][i]);
            p += (size_t)32 * tpitch; asm volatile("" : "+v"(p) :: "memory");
        }
    }
}

struct EpiWin {
    static constexpr bool PERM = true, AFTER_DRAIN = false;
    const u64* ss; bf16_t *UX, *CVIN, *Q, *KC, *VC, *KS, *KW, *VST, *VWT; float* GATE; const float *qg, *kg;
    DI void operator()(const Acc& acc, const Unit& u, int wr, int wc, int fr, int fq) const {
        const int row0 = u.pm * 256 + wr * 64 + fr;
        float rsv[8]; rstd8(ss, row0, rsv);
        f32x4 gvv[4]; gains4(u.pn == 6 ? kg + 64 : (u.pn == 7 ? kg + 128 : qg), fq, gvv);
#pragma unroll
        for (int ai = 0; ai < 2; ++ai)
#pragma unroll
            for (int m = 0; m < 4; ++m) {
                const int row = row0 + ai * 128 + m * 16; const float rs = rsv[ai * 4 + m];
                const int b = row >> 13, s = row & (SEQ - 1);
                if (u.pn == 0) {
                    const int chunk = row >> 6, tau = row & 63;
#pragma unroll
                    for (int bj = 0; bj < 2; ++bj) { const int ch = 128 * bj + 32 * wc + 8 * fq, g = ch >> 4, h = ch & 15;
                        *(u32x4*)(UX + ((size_t)g * NCHUNK + chunk) * SKX + 128 + tau * 16 + h) = pack8(acc[ai][bj][m][0] * rs, acc[ai][bj][m][1] * rs); }
                } else if (u.pn <= 2) {
#pragma unroll
                    for (int bj = 0; bj < 2; ++bj) { const int ch = 128 * (u.pn - 1) + 4 * (16 * bj + 4 * wc + fq);
                        const f32x4 a = acc[ai][bj][m][0] * rs, g = acc[ai][bj][m][1] * rs;
                        u32x2 w; w.x = cvtpk(a[0] * sigmoidf_(g[0]), a[1] * sigmoidf_(g[1])); w.y = cvtpk(a[2] * sigmoidf_(g[2]), a[3] * sigmoidf_(g[3]));
                        *(u32x2*)(CVIN + (size_t)row * 256 + ch) = w; }
                } else if (u.pn <= 4) {
                    const int head = 4 * (u.pn - 3) + wc;
                    head_store<0>(acc, ai, m, rs, gvv, QSCALE, Q + ((size_t)row * 8 + head) * 64, fq, 0, 0);
                } else if (u.pn == 5) {
                    bf16_t* base = (wc >> 1) ? VC : KC;
                    head_store<1>(acc, ai, m, rs, gvv, 1.f, base + ((size_t)(b * 2 + (wc & 1)) * SEQ + s) * 64, fq, 0, 0);
                } else if (u.pn == 6) {
                    const int kvh = wc & 1; const size_t tileb = ((size_t)(b * 2 + kvh) * 128 + (s >> 6)) * 4096;
                    if (wc < 2) head_store<3>(acc, ai, m, rs, gvv, 1.f, KS + tileb, fq, 0, s & 63);
                    else head_store<4>(acc, ai, m, rs, gvv, 1.f, VST + tileb, fq, 0, s & 63);
                } else if (u.pn <= 7) {
                    const int kvh = wc & 1; const size_t plane = (size_t)(b * 2 + kvh) * SEQ * 64;
                    if (wc < 2) head_store<0>(acc, ai, m, rs, gvv, 1.f, KW + plane + (size_t)s * 64, fq, 0, 0);
                    else head_store<2>(acc, ai, m, rs, gvv, 1.f, VWT + plane + (size_t)(s >> 6) * 4096, fq, 64, s & 63);
                } else {
                    if (wc == 0 && fq < 3) {
#pragma unroll
                        for (int n = 0; n < 2; ++n) { const f32x4 v = acc[ai][0][m][n] * rs; f32x4 o; o[0] = sigmoidf_(v[0]); o[1] = sigmoidf_(v[1]); o[2] = sigmoidf_(v[2]); o[3] = sigmoidf_(v[3]);
                            *(f32x4*)(GATE + (size_t)row * 24 + 8 * fq + 4 * n) = o; }
                    }
                }
                asm volatile("" ::: "memory");
            }
    }
};

struct EpiXQ {
    static constexpr bool PERM = true, AFTER_DRAIN = false;
    const u64* ss; bf16_t* QX; const float* qg;
    DI void operator()(const Acc& acc, const Unit& u, int wr, int wc, int fr, int fq) const {
        const int row0 = u.pm * 256 + wr * 64 + fr;
        float rsv[8]; rstd8(ss, row0, rsv);
        f32x4 gvv[4]; gains4(qg, fq, gvv);
#pragma unroll
        for (int ai = 0; ai < 2; ++ai)
#pragma unroll
            for (int m = 0; m < 4; ++m) { const int row = row0 + ai * 128 + m * 16;
                head_store<0>(acc, ai, m, rsv[ai * 4 + m], gvv, QSCALE, QX + ((size_t)row * 4 + wc) * 64, fq, 0, 0); }
    }
};
struct EpiMemKV {
    static constexpr bool PERM = true, AFTER_DRAIN = false;
    const u64* ss; bf16_t *KM, *VMT; const float* kg;
    DI void operator()(const Acc& acc, const Unit& u, int wr, int wc, int fr, int fq) const {
        const int row0 = u.pm * 256 + wr * 64 + fr;
        float rsv[8]; rstd8(ss, row0, rsv);
        f32x4 gvv[4]; gains4(kg + u.g * 64, fq, gvv);
#pragma unroll
        for (int ai = 0; ai < 2; ++ai)
#pragma unroll
            for (int m = 0; m < 4; ++m) { const int row = row0 + ai * 128 + m * 16, b = row >> 8, mm = row & 255; const float rs = rsv[ai * 4 + m];
                const size_t plane = ((size_t)u.g * 32 + b * 4 + wc) * 256 * 64;
                if (u.pn == 0) head_store<0>(acc, ai, m, rs, gvv, 1.f, KM + plane + (size_t)mm * 64, fq, 0, 0);
                else head_store<2>(acc, ai, m, rs, gvv, 1.f, VMT + plane, fq, 256, mm);
                asm volatile("" ::: "memory"); }
    }
};

template <int MODE, bool F8OUT = false> struct EpiGate {
    static constexpr bool PERM = true, AFTER_DRAIN = false;
    bf16_t* O; int ldo; const u64* ss; const int* row_tok;
    DI void operator()(const Acc& acc, const Unit& u, int wr, int wc, int fr, int fq) const {
        const int row0 = u.pm * 256 + wr * 64 + fr;
        float rsv[8];
        if (MODE == 1) rstd8(ss, row0, rsv);
        if (MODE == 2) { int tk[8]; u64 t[8];
#pragma unroll
            for (int q = 0; q < 8; ++q) tk[q] = row_tok[row0 + (q >> 2) * 128 + (q & 3) * 16];
#pragma unroll
            for (int q = 0; q < 8; ++q) t[q] = ss[tk[q] < 0 ? 0 : tk[q]];
#pragma unroll
            for (int q = 0; q < 8; ++q) rsv[q] = tk[q] >= 0 ? rsqrtf((float)t[q] * (1.0f / (SS_FIX * 1024.0f)) + EPS) : 0.f; }
#pragma unroll
        for (int ai = 0; ai < 2; ++ai)
#pragma unroll
            for (int m = 0; m < 4; ++m) { const int row = row0 + ai * 128 + m * 16; float rs = 1.f;
                if (MODE == 1 || MODE == 2) rs = rsv[ai * 4 + m];
                if (F8OUT) rs *= (1.0f / W8_SCALE);
#pragma unroll
                for (int bj = 0; bj < 2; ++bj) { const int ch = 128 * u.pn + 4 * (16 * bj + 4 * wc + fq);
                    const f32x4 a = acc[ai][bj][m][0] * rs, g = acc[ai][bj][m][1] * rs; f32x4 o;
#pragma unroll
                    for (int i = 0; i < 4; ++i) { o[i] = (MODE == 0) ? a[i] * sigmoidf_(g[i]) : siluf_(a[i]) * g[i]; }
                    if (F8OUT) *(unsigned*)((unsigned char*)O + (size_t)row * ldo + ch) = pack_fp8x4(o[0], o[1], o[2], o[3]);
                    else { u32x2 w; w.x = cvtpk(o[0], o[1]); w.y = cvtpk(o[2], o[3]); *(u32x2*)(O + (size_t)row * ldo + ch) = w; } } }
    }
};
struct EpiPlain {
    static constexpr bool PERM = true, AFTER_DRAIN = false;
    bf16_t* O; int ldo;
    DI void operator()(const Acc& acc, const Unit& u, int wr, int wc, int fr, int fq) const {
        const int row0 = u.pm * 256 + wr * 64 + fr;
#pragma unroll
        for (int ai = 0; ai < 2; ++ai)
#pragma unroll
            for (int m = 0; m < 4; ++m) { bf16_t* rp = O + (size_t)(row0 + ai * 128 + m * 16) * ldo + u.pn * 256 + wc * 32 + 8 * fq;
#pragma unroll
                for (int bj = 0; bj < 2; ++bj) *(u32x4*)(rp + bj * 128) = pack8(acc[ai][bj][m][0], acc[ai][bj][m][1]); }
    }
};
template <bool MOE, bool STATS> struct EpiRes {
    static_assert(!(MOE && STATS), "row statistics are only kept for the dense residual epilogue");
    static constexpr bool PERM = true, AFTER_DRAIN = false;
    const bf16_t* hbase; float* out; bf16_t* hb; u64* ssout; const int* row_tok; const float* row_gate; float ascale; unsigned char* h8;
    DI void operator()(const Acc& acc, const Unit& u, int wr, int wc, int fr, int fq) const {
        const int row0 = u.pm * 256 + wr * 64 + fr, col0 = u.pn * 256 + wc * 32 + 8 * fq;
        int rowv[8]; float gtv[8];
#pragma unroll
        for (int q = 0; q < 8; ++q) { rowv[q] = row0 + (q >> 2) * 128 + (q & 3) * 16; gtv[q] = ascale; }
        if (MOE) {
#pragma unroll
            for (int q = 0; q < 8; ++q) { const int r = rowv[q]; rowv[q] = row_tok[r]; gtv[q] = row_gate[r]; }
#pragma unroll
            for (int q = 0; q < 8; ++q) gtv[q] *= ascale;
        }
#pragma unroll
        for (int ai = 0; ai < 2; ++ai) {
            u32x4 bb[4][2];
#pragma unroll
            for (int m = 0; m < 4; ++m) { const int rr = rowv[ai * 4 + m] < 0 ? 0 : rowv[ai * 4 + m];
#pragma unroll
                for (int bj = 0; bj < 2; ++bj) bb[m][bj] = *(const u32x4*)(hbase + (size_t)rr * DM + col0 + bj * 128); }
#pragma unroll
            for (int m = 0; m < 4; ++m) { const int row = rowv[ai * 4 + m]; const float gt = gtv[ai * 4 + m];
                float s = 0.f;
                if (!MOE || row >= 0) {
#pragma unroll
                    for (int bj = 0; bj < 2; ++bj) { const size_t off = (size_t)row * DM + col0 + bj * 128;
                        const u32x4 b4 = bb[m][bj];
                        const f32x4 b0 = (f32x4){bflo(b4.x), bfhi(b4.x), bflo(b4.y), bfhi(b4.y)}, b1 = (f32x4){bflo(b4.z), bfhi(b4.z), bflo(b4.w), bfhi(b4.w)};
                        const f32x4 v0 = b0 + acc[ai][bj][m][0] * gt, v1 = b1 + acc[ai][bj][m][1] * gt;
                        if (out) { *(f32x4*)(out + off) = v0; *(f32x4*)(out + off + 4) = v1; }
                        if (hb) *(u32x4*)(hb + off) = pack8(v0, v1);
                        if (STATS && h8) { u32x2 w8; w8.x = pack_fp8x4(v0[0], v0[1], v0[2], v0[3]); w8.y = pack_fp8x4(v1[0], v1[1], v1[2], v1[3]); *(u32x2*)(h8 + off) = w8; }
                        if (STATS) s += (v0[0] * v0[0] + v0[1] * v0[1]) + (v0[2] * v0[2] + v0[3] * v0[3]) + (v1[0] * v1[0] + v1[1] * v1[1]) + (v1[2] * v1[2] + v1[3] * v1[3]); }
                }
                if (STATS) { s += __shfl_xor(s, 16); s += __shfl_xor(s, 32);
                    if (fq == 0) atomicAdd((unsigned long long*)(ssout + row), (unsigned long long)(s * SS_FIX + 0.5f)); }
                asm volatile("" ::: "memory");
            }
        }
    }
};
struct EpiS5State {
    static constexpr bool PERM = true, AFTER_DRAIN = false;
    float* ZC;
    DI void operator()(const Acc& acc, const Unit& u, int wr, int wc, int fr, int fq) const {
        const int row0 = u.pm * 256 + wr * 64 + fr;
#pragma unroll
        for (int ai = 0; ai < 2; ++ai)
#pragma unroll
            for (int m = 0; m < 4; ++m) { float* rp = ZC + ((size_t)u.g * NCHUNK + row0 + ai * 128 + m * 16) * 128 + wc * 32 + 8 * fq;
                *(f32x4*)rp = acc[ai][0][m][0]; *(f32x4*)(rp + 4) = acc[ai][0][m][1]; }
    }
};
struct EpiS5Out {
    static constexpr bool PERM = true, AFTER_DRAIN = false;
    static DI int ktiles(const Unit& u, int nt) { const int k = 4 * u.pn + 6; return k < nt ? k : nt; }
    bf16_t* YG;
    DI void operator()(const Acc& acc, const Unit& u, int wr, int wc, int fr, int fq) const {
        const int row0 = u.pm * 256 + wr * 64 + fr;
#pragma unroll
        for (int ai = 0; ai < 2; ++ai)
#pragma unroll
            for (int m = 0; m < 4; ++m) { const int chunk = row0 + ai * 128 + m * 16;
#pragma unroll
                for (int bj = 0; bj < 2; ++bj) { const int c = u.pn * 256 + bj * 128 + wc * 32 + 8 * fq, tau = c >> 4, h = c & 15;
                    f32x4 a = acc[ai][bj][m][0], b = acc[ai][bj][m][1];
#pragma unroll
                    for (int i = 0; i < 4; ++i) { a[i] = gelu_tanh(a[i]); b[i] = gelu_tanh(b[i]); }
                    *(u32x4*)(YG + ((size_t)chunk * 64 + tau) * 256 + u.g * 16 + h) = pack8(a, b); } }
    }
};
}
namespace att {
constexpr int TP = 144;
constexpr int TILEB = 64 * TP;
constexpr int L_K0 = 0, L_K1 = TILEB, L_V0 = 2 * TILEB, L_V1 = 3 * TILEB, L_BIAS = 4 * TILEB  , L_UNI = L_BIAS + 8 * 132 * 4  ,
              L_IMP = L_UNI + 64  , L_OVT = L_IMP + 256 * 132 * 2  , L_INVL = L_OVT + 32 * TP  , L_END = L_INVL + 1024;
static_assert(L_END <= 131072, "attention LDS");
DI int crow(int r, int hi) { return (r & 3) + 8 * (r >> 2) + 4 * hi; }
#define MFMA32(a, b, c) __builtin_amdgcn_mfma_f32_32x32x16_bf16((a), (b), (c), 0, 0, 0)

struct TileRegs { u32x4 k, v; };
DI void tile_fetch(TileRegs& t, const bf16_t* ksrc, int kp, const bf16_t* vsrc, int vp, int tid) {
    const int row = tid >> 3, ch = (tid & 7) * 8;
    t.k = *(const u32x4*)(ksrc + (size_t)row * kp + ch);
    t.v = *(const u32x4*)(vsrc + (size_t)row * vp + ch);
}
DI void tile_fetch_k(TileRegs& t, const bf16_t* ksrc, int kp, int tid) { const int row = tid >> 3, ch = (tid & 7) * 8; t.k = *(const u32x4*)(ksrc + (size_t)row * kp + ch); }
DI void tile_put(const TileRegs& t, LAS unsigned char* kd, LAS unsigned char* vd, int tid) {
    const int off = (tid >> 3) * TP + (tid & 7) * 16;
    *(LAS u32x4*)(kd + off) = t.k; *(LAS u32x4*)(vd + off) = t.v;
}
DI void tile_fetch_v(TileRegs& t, const bf16_t* vsrc, int vp, int tid) { const int row = tid >> 3, ch = (tid & 7) * 8; t.v = *(const u32x4*)(vsrc + (size_t)row * vp + ch); }
DI void tile_put_v(const TileRegs& t, LAS unsigned char* vd, int tid) { *(LAS u32x4*)(vd + (tid >> 3) * TP + (tid & 7) * 16) = t.v; }
DI void tile_put_k(const TileRegs& t, LAS unsigned char* kd, int tid) { *(LAS u32x4*)(kd + (tid >> 3) * TP + (tid & 7) * 16) = t.k; }

DI void load_kfrag(bf16x8 (&kf)[8], const LAS unsigned char* kt, int r32, int hi) {
    const LAS unsigned char* kb = kt + r32 * TP + hi * 16;
#pragma unroll
    for (int d0 = 0; d0 < 4; ++d0) { kf[2 * d0] = *(const LAS bf16x8*)(kb + d0 * 32); kf[2 * d0 + 1] = *(const LAS bf16x8*)(kb + 32 * TP + d0 * 32); }
}
DI void load_vfrag(bf16x8 (&vf)[8], const LAS unsigned char* vt, int r32, int hi) {
    const LAS unsigned char* vb = vt + r32 * TP + hi * 16;
#pragma unroll
    for (int ks = 0; ks < 4; ++ks) { vf[2 * ks] = *(const LAS bf16x8*)(vb + ks * 32); vf[2 * ks + 1] = *(const LAS bf16x8*)(vb + 32 * TP + ks * 32); }
}
DI void qk_mma(f32x16& p0, f32x16& p1, const bf16x8 (&kf)[8], const bf16x8 (&qf)[4]) {
#pragma unroll
    for (int i = 0; i < 16; ++i) { p0[i] = 0.f; p1[i] = 0.f; }
#pragma unroll
    for (int d0 = 0; d0 < 4; ++d0) { p0 = MFMA32(kf[2 * d0], qf[d0], p0); p1 = MFMA32(kf[2 * d0 + 1], qf[d0], p1); }
}
DI void qk_tile(f32x16& p0, f32x16& p1, const LAS unsigned char* kt, const bf16x8 (&qf)[4], int r32, int hi) {
    bf16x8 kf[8]; load_kfrag(kf, kt, r32, hi); __builtin_amdgcn_sched_barrier(0); qk_mma(p0, p1, kf, qf);
}
DI bf16x8 pack_p(const f32x16& p, int s) {
    u32x4 w; w.x = cvtpk(p[8 * s], p[8 * s + 1]); w.y = cvtpk(p[8 * s + 2], p[8 * s + 3]); w.z = cvtpk(p[8 * s + 4], p[8 * s + 5]); w.w = cvtpk(p[8 * s + 6], p[8 * s + 7]);
    return __builtin_bit_cast(bf16x8, w);
}
DI void pv_mma(f32x16 (&o)[2], const bf16x8 (&vf)[8], const f32x16& p0, const f32x16& p1) {
#pragma unroll
    for (int ks = 0; ks < 4; ++ks) { const bf16x8 pf = (ks < 2) ? pack_p(p0, ks) : pack_p(p1, ks - 2); o[0] = MFMA32(vf[2 * ks], pf, o[0]); o[1] = MFMA32(vf[2 * ks + 1], pf, o[1]); }
}
DI void pv_tile(f32x16 (&o)[2], const LAS unsigned char* vt, const f32x16& p0, const f32x16& p1, int r32, int hi) {
    bf16x8 vf[8]; load_vfrag(vf, vt, r32, hi); __builtin_amdgcn_sched_barrier(0); pv_mma(o, vf, p0, p1);
}
DI void softmax_step(f32x16& p0, f32x16& p1, float& m, float& l, f32x16 (&o)[2]) {
    float mx = __builtin_fmaxf(p0[0], p1[0]), my = __builtin_fmaxf(p0[1], p1[1]);
#pragma unroll
    for (int i = 2; i < 16; i += 2) { mx = __builtin_fmaxf(__builtin_fmaxf(mx, p0[i]), p1[i]); my = __builtin_fmaxf(__builtin_fmaxf(my, p0[i + 1]), p1[i + 1]); }
    mx = __builtin_fmaxf(mx, my);
    mx = __builtin_fmaxf(mx, __shfl_xor(mx, 32));
    const float mn = __builtin_fmaxf(m, mx), mu = (mn == -INFINITY) ? 0.f : mn;
    const float al = __builtin_amdgcn_exp2f(m - mu);
    float s = 0.f;
#pragma unroll
    for (int i = 0; i < 16; ++i) { p0[i] = __builtin_amdgcn_exp2f(p0[i] - mu); p1[i] = __builtin_amdgcn_exp2f(p1[i] - mu); s += p0[i] + p1[i]; }
    l = l * al + s; m = mn;
    if (__any(al != 1.f)) {
#pragma unroll
        for (int i = 0; i < 16; ++i) { o[0][i] *= al; o[1][i] *= al; }
    }
}
DI void exp_tile(f32x16& p0, f32x16& p1) {
#pragma unroll
    for (int i = 0; i < 16; ++i) { p0[i] = __builtin_amdgcn_exp2f(p0[i]); p1[i] = __builtin_amdgcn_exp2f(p1[i]); }
}
DI void qk_tile_c(f32x16& p0, f32x16& p1, const LAS unsigned char* kt, const bf16x8 (&qf)[4], float cval, int r32, int hi) {
    const LAS unsigned char* kb = kt + r32 * TP + hi * 16;
    f32x16 cv;
#pragma unroll
    for (int i = 0; i < 16; ++i) cv[i] = cval;
    bf16x8 ka[4], kc[4];
    ka[0] = *(const LAS bf16x8*)(kb); ka[1] = *(const LAS bf16x8*)(kb + 32 * TP); ka[2] = *(const LAS bf16x8*)(kb + 32); ka[3] = *(const LAS bf16x8*)(kb + 32 * TP + 32);
    __builtin_amdgcn_sched_barrier(0);
    p0 = MFMA32(ka[0], qf[0], cv); p1 = MFMA32(ka[1], qf[0], cv);
    kc[0] = *(const LAS bf16x8*)(kb + 64); kc[1] = *(const LAS bf16x8*)(kb + 32 * TP + 64); kc[2] = *(const LAS bf16x8*)(kb + 96); kc[3] = *(const LAS bf16x8*)(kb + 32 * TP + 96);
    p0 = MFMA32(ka[2], qf[1], p0); p1 = MFMA32(ka[3], qf[1], p1);
    __builtin_amdgcn_sched_barrier(0);
    p0 = MFMA32(kc[0], qf[2], p0); p1 = MFMA32(kc[1], qf[2], p1); p0 = MFMA32(kc[2], qf[3], p0); p1 = MFMA32(kc[3], qf[3], p1);
}
DI void pv_tile_sum(f32x16 (&o)[2], f32x16& lacc, const LAS unsigned char* vt, const f32x16& p0, const f32x16& p1, int r32, int hi) {
    const bf16x8 ones = (bf16x8){0x3F80, 0x3F80, 0x3F80, 0x3F80, 0x3F80, 0x3F80, 0x3F80, 0x3F80};
    const LAS unsigned char* vb = vt + r32 * TP + hi * 16;
    bf16x8 va[4], vc[4];
    va[0] = *(const LAS bf16x8*)(vb); va[1] = *(const LAS bf16x8*)(vb + 32 * TP); va[2] = *(const LAS bf16x8*)(vb + 32); va[3] = *(const LAS bf16x8*)(vb + 32 * TP + 32);
    const bf16x8 pf0 = pack_p(p0, 0), pf1 = pack_p(p0, 1);
    __builtin_amdgcn_sched_barrier(0);
    o[0] = MFMA32(va[0], pf0, o[0]); o[1] = MFMA32(va[1], pf0, o[1]); lacc = MFMA32(ones, pf0, lacc);
    vc[0] = *(const LAS bf16x8*)(vb + 64); vc[1] = *(const LAS bf16x8*)(vb + 32 * TP + 64); vc[2] = *(const LAS bf16x8*)(vb + 96); vc[3] = *(const LAS bf16x8*)(vb + 32 * TP + 96);
    o[0] = MFMA32(va[2], pf1, o[0]); o[1] = MFMA32(va[3], pf1, o[1]); lacc = MFMA32(ones, pf1, lacc);
    const bf16x8 pf2 = pack_p(p1, 0), pf3 = pack_p(p1, 1);
    __builtin_amdgcn_sched_barrier(0);
    o[0] = MFMA32(vc[0], pf2, o[0]); o[1] = MFMA32(vc[1], pf2, o[1]); lacc = MFMA32(ones, pf2, lacc);
    o[0] = MFMA32(vc[2], pf3, o[0]); o[1] = MFMA32(vc[3], pf3, o[1]); lacc = MFMA32(ones, pf3, lacc);
}
DI void store_o(const f32x16 (&o)[2], float inv, bf16_t* dst, int hi) {
#pragma unroll
    for (int dh = 0; dh < 2; ++dh)
#pragma unroll
        for (int g = 0; g < 4; ++g) { u32x2 w; w.x = cvtpk(o[dh][4 * g] * inv, o[dh][4 * g + 1] * inv); w.y = cvtpk(o[dh][4 * g + 2] * inv, o[dh][4 * g + 3] * inv);
            *(u32x2*)(dst + 32 * dh + 8 * g + 4 * hi) = w; }
}
DI void load_q(bf16x8 (&qf)[4], const bf16_t* qrow, int hi) {
#pragma unroll
    for (int d0 = 0; d0 < 4; ++d0) qf[d0] = *(const bf16x8*)(qrow + 16 * d0 + 8 * hi);
}

DI void bias_mask_half(f32x16& p, const LAS float* btab, int dbase, int hi, int hiD) {
#pragma unroll
    for (int h8 = 0; h8 < 2; ++h8) {
        float bv[8];
#pragma unroll
        for (int r = 0; r < 8; ++r) { const int d = dbase - crow(8 * h8 + r, hi); bv[r] = btab[d < 0 ? 0 : (d < 128 ? d : 128)]; }
#pragma unroll
        for (int r = 0; r < 8; ++r) { const int d = dbase - crow(8 * h8 + r, hi); p[8 * h8 + r] = (d >= 0 && d < hiD) ? p[8 * h8 + r] + bv[r] : -INFINITY; }
        asm volatile("" ::: "memory");
    }
}
DI void bias_mask(f32x16& p0, f32x16& p1, const LAS float* btab  , int t, int s0, int hi, int hiD) {
    bias_mask_half(p0, btab, t - s0, hi, hiD); bias_mask_half(p1, btab, t - s0 - 32, hi, hiD);
}
DI void bias_mask_x(f32x16& p0, f32x16& p1, const LAS float* xt  , int t, int s0, int hi) {
    const LAS float* b0 = xt + (t - s0 + 128 - 4 * hi - 27); const LAS float* b1 = b0 - 32;
#pragma unroll
    for (int h8 = 0; h8 < 2; ++h8) {
        float v0[8], v1[8];
#pragma unroll
        for (int r = 0; r < 8; ++r) { const int rr = 8 * h8 + r, cr = (rr & 3) + 8 * (rr >> 2); v0[r] = b0[27 - cr]; v1[r] = b1[27 - cr]; }
#pragma unroll
        for (int r = 0; r < 8; ++r) { p0[8 * h8 + r] += v0[r]; p1[8 * h8 + r] += v1[r]; }
        asm volatile("" ::: "memory");
    }
}
constexpr int XT_WIN = 704, XT_SEL = 320;
DI void fill_xt(LAS float* xt, const LAS float* tb  , int len, int hiD, int tid) {
    for (int i = tid; i < 8 * len; i += 512) { const int h = i / len, d = i % len - 128; float v = -INFINITY; if (d >= 0 && d < hiD) v = tb[h * 132 + (d < 128 ? d : 128)]; xt[i] = v; }
}
DI void bias_const(f32x16& p0, f32x16& p1, float c) {
#pragma unroll
    for (int r = 0; r < 16; ++r) { p0[r] += c; p1[r] += c; }
}
DI void fill_ninf(f32x16& p0, f32x16& p1) {
#pragma unroll
    for (int r = 0; r < 16; ++r) { p0[r] = -INFINITY; p1[r] = -INFINITY; }
}

DI int next_bit(u64 lo, u64 hi_, int from, int c) {
    if (from < 64) { const u64 x = lo & (~0ull << from); if (x) { const int j = __ffsll((unsigned long long)x) - 1; return j <= c ? j : -1; } from = 64; }
    if (from < 128) { const u64 x = hi_ & (~0ull << (from - 64)); if (x) { const int j = 64 + __ffsll((unsigned long long)x) - 1; return j <= c ? j : -1; } }
    return -1;
}
template <class POL>
DI float flash_loop(LAS unsigned char* lds, const POL& P, const bf16x8 (&qf)[4], f32x16 (&o)[2], float cval_on, int tid, int r32, int hi) {
    int jc = P.first(), jn = P.next(jc);
    TileRegs tr;
    tile_fetch_k(tr, P.kptr(jc), P.kp, tid);
    __syncthreads();
    tile_put_k(tr, lds + L_K0, tid);
    tile_fetch_v(tr, P.vptr(jc), P.vp, tid); if (jn >= 0) tile_fetch_k(tr, P.kptr(jn), P.kp, tid);
    tile_put_v(tr, lds + L_V0, tid); if (jn >= 0) tile_put_k(tr, lds + L_K1, tid);
    __syncthreads();
    f32x16 lacc;
#pragma unroll
    for (int i = 0; i < 16; ++i) lacc[i] = 0.f;
    f32x16 sA0, sA1, sB0, sB1;
    if (P.active(jc)) qk_tile_c(sA0, sA1, lds + L_K0, qf, P.lane_on(jc) ? cval_on : -INFINITY, r32, hi);
    __syncthreads();
    int kb = 1, vb = 0;
#define FL_STEP(C0, C1, N0, N1) { const int jn2 = jn >= 0 ? P.next(jn) : -1; \
        const bool actn = jn >= 0 && P.active(jn), actc = P.active(jc); \
        if (jn >= 0) tile_fetch_v(tr, P.vptr(jn), P.vp, tid); if (jn2 >= 0) tile_fetch_k(tr, P.kptr(jn2), P.kp, tid); \
        if (actn) qk_tile_c(N0, N1, lds + (kb ? L_K1 : L_K0), qf, P.lane_on(jn) ? cval_on : -INFINITY, r32, hi); \
        if (actc) { P.adjust(C0, C1, jc); exp_tile(C0, C1); pv_tile_sum(o, lacc, lds + (vb ? L_V1 : L_V0), C0, C1, r32, hi); } \
        if (jn >= 0) tile_put_v(tr, lds + (vb ? L_V0 : L_V1), tid); if (jn2 >= 0) tile_put_k(tr, lds + (kb ? L_K0 : L_K1), tid); \
        __syncthreads(); kb ^= 1; vb ^= 1; jc = jn; jn = jn2; }
    for (;;) { FL_STEP(sA0, sA1, sB0, sB1) if (jc < 0) break; FL_STEP(sB0, sB1, sA0, sA1) if (jc < 0) break; }
#undef FL_STEP
    return lacc[0];
}

struct WindowPol {
    const bf16_t* Kp; const bf16_t* Vp; int kp, vp, c, j0, t, hi; const LAS float* btab;
    DI int first() const { return j0; }
    DI int next(int j) const { return j < c ? j + 1 : -1; }
    DI const bf16_t* kptr(int j) const { return Kp + (size_t)j * 64 * 64; }
    DI const bf16_t* vptr(int j) const { return Vp + (size_t)j * 4096; }
    DI bool active(int) const { int one = 1; asm volatile("" : "+s"(one)); return one != 0; }
    DI bool lane_on(int) const { return true; }
    DI void adjust(f32x16& p0, f32x16& p1, int j) const { if (j == c - 8 || j + 2 >= c) bias_mask_x(p0, p1, btab, t, 64 * j, hi); }
};
DI void window_unit(LAS unsigned char* lds, int b, int kvh, int c, const bf16_t* Q, const bf16_t* KW, const bf16_t* VWT, bf16_t* OW, const float* bnd, const int tid_) {
    int tid = tid_; asm volatile("" : "+v"(tid));
    const int lane = tid & 63, wid = __builtin_amdgcn_readfirstlane(tid >> 6), r32 = lane & 31, hi = lane >> 5;
    const int tl = 8 * wid + (r32 >> 2), g = r32 & 3, t = 64 * c + tl;
    const size_t plane = (size_t)(b * 2 + kvh);
    bf16x8 qf[4]; load_q(qf, Q + (((size_t)b * SEQ + t) * 8 + kvh * 4 + g) * 64, hi);
    const WindowPol P{KW + plane * SEQ * 64, VWT + plane * 64 * SEQ, 64, 64, c, c >= 8 ? c - 8 : 0, t, hi, (const LAS float*)(lds + L_IMP) + (kvh * 4 + g) * XT_WIN};
    f32x16 o[2];
#pragma unroll
    for (int i = 0; i < 16; ++i) { o[0][i] = 0.f; o[1][i] = 0.f; }
    const float lt = flash_loop(lds, P, qf, o, -bnd[kvh * 4 + g], tid, r32, hi);
    int t2 = tid; asm volatile("" : "+v"(t2));
    { const int l2 = t2 & 63, r2 = l2 & 31, tl2 = 8 * (t2 >> 6) + (r2 >> 2), g2 = r2 & 3; store_o(o, lt > 0.f ? 1.f / lt : 0.f, OW + (((size_t)b * SEQ + 64 * c + tl2) * 8 + kvh * 4 + g2) * 64, l2 >> 5); }
}

struct SelPol {
    const bf16_t* Kp; const bf16_t* Vp; int kp, vp, c, t, hi; const LAS float* btab; u64 ulo, uhi, wlo, whi, mlo, mhi;
    DI int first() const { return next_bit(ulo, uhi, 0, c); }
    DI int next(int j) const { return next_bit(ulo, uhi, j + 1, c); }
    DI const bf16_t* kptr(int j) const { return Kp + (size_t)j * 64 * 64; }
    DI const bf16_t* vptr(int j) const { return Vp + (size_t)j * 4096; }
    DI bool active(int j) const { return ((j < 64 ? wlo >> j : whi >> (j - 64)) & 1ull) != 0ull; }
    DI bool lane_on(int j) const { return ((j < 64 ? mlo >> j : mhi >> (j - 64)) & 1ull) != 0ull; }
    DI void adjust(f32x16& p0, f32x16& p1, int j) const { if (j + 2 >= c) bias_mask(p0, p1, btab, t, 64 * j, hi, 1 << 30); }
};
DI void selected_unit(LAS unsigned char* lds, int b, int kvh, int c, const bf16_t* Q, const bf16_t* KS, const bf16_t* VST, const unsigned* SEL, bf16_t* OS, const float* bnd, const int tid_) {
    int tid = tid_; asm volatile("" : "+v"(tid));
    const int lane = tid & 63, wid = __builtin_amdgcn_readfirstlane(tid >> 6), r32 = lane & 31, hi = lane >> 5;
    const int tl = 8 * wid + (r32 >> 2), g = r32 & 3, t = 64 * c + tl;
    const size_t plane = (size_t)(b * 2 + kvh);
    LAS unsigned* uni = (LAS unsigned*)(lds + L_UNI);
    __syncthreads();
    if (tid < 4) uni[tid] = 0u;
    __syncthreads();
    const u32x4 mk = *(const u32x4*)(SEL + (plane * SEQ + t) * 4);
    unsigned w0 = mk.x, w1 = mk.y, w2 = mk.z, w3 = mk.w;
#pragma unroll
    for (int o_ = 4; o_ < 64; o_ <<= 1) { w0 |= __shfl_xor(w0, o_); w1 |= __shfl_xor(w1, o_); w2 |= __shfl_xor(w2, o_); w3 |= __shfl_xor(w3, o_); }
    w0 = __builtin_amdgcn_readfirstlane(w0); w1 = __builtin_amdgcn_readfirstlane(w1); w2 = __builtin_amdgcn_readfirstlane(w2); w3 = __builtin_amdgcn_readfirstlane(w3);
    if (lane == 0) { __hip_atomic_fetch_or(uni + 0, w0, __ATOMIC_RELAXED, __HIP_MEMORY_SCOPE_WORKGROUP); __hip_atomic_fetch_or(uni + 1, w1, __ATOMIC_RELAXED, __HIP_MEMORY_SCOPE_WORKGROUP);
                     __hip_atomic_fetch_or(uni + 2, w2, __ATOMIC_RELAXED, __HIP_MEMORY_SCOPE_WORKGROUP); __hip_atomic_fetch_or(uni + 3, w3, __ATOMIC_RELAXED, __HIP_MEMORY_SCOPE_WORKGROUP); }
    __syncthreads();
    const u64 ulo = (u64)__builtin_amdgcn_readfirstlane(uni[0]) | ((u64)__builtin_amdgcn_readfirstlane(uni[1]) << 32), uhi = (u64)__builtin_amdgcn_readfirstlane(uni[2]) | ((u64)__builtin_amdgcn_readfirstlane(uni[3]) << 32);
    bf16x8 qf[4]; load_q(qf, Q + (((size_t)b * SEQ + t) * 8 + kvh * 4 + g) * 64, hi);
    const SelPol P{KS + plane * SEQ * 64, VST + plane * 64 * SEQ, 64, 64, c, t, hi, (const LAS float*)(lds + L_BIAS) + (kvh * 4 + g) * 132, ulo, uhi,
                   (u64)w0 | ((u64)w1 << 32), (u64)w2 | ((u64)w3 << 32), (u64)mk.x | ((u64)mk.y << 32), (u64)mk.z | ((u64)mk.w << 32)};
    f32x16 o[2];
#pragma unroll
    for (int i = 0; i < 16; ++i) { o[0][i] = 0.f; o[1][i] = 0.f; }
    const float lt = flash_loop(lds, P, qf, o, -bnd[kvh * 4 + g], tid, r32, hi);
    int t2 = tid; asm volatile("" : "+v"(t2));
    { const int l2 = t2 & 63, r2 = l2 & 31, tl2 = 8 * (t2 >> 6) + (r2 >> 2), g2 = r2 & 3; store_o(o, lt > 0.f ? 1.f / lt : 0.f, OS + (((size_t)b * SEQ + 64 * c + tl2) * 8 + kvh * 4 + g2) * 64, l2 >> 5); }
}

struct CrossPol {
    const bf16_t* Kp; const bf16_t* Vp; int kp, vp;
    DI int first() const { return 0; }
    DI int next(int j) const { return j < 3 ? j + 1 : -1; }
    DI const bf16_t* kptr(int j) const { return Kp + (size_t)j * 64 * 64; }
    DI const bf16_t* vptr(int j) const { return Vp + j * 64; }
    DI bool active(int) const { return true; }
    DI bool lane_on(int) const { return true; }
    DI void adjust(f32x16&, f32x16&, int) const {}
};
DI void cross_unit(LAS unsigned char* lds, int b, int h, int qt, const bf16_t* QX, const bf16_t* KM, const bf16_t* VMT, bf16_t* OX, const float* bnd, const int tid_) {
    int tid = tid_; asm volatile("" : "+v"(tid));
    const int lane = tid & 63, wid = __builtin_amdgcn_readfirstlane(tid >> 6), r32 = lane & 31, hi = lane >> 5;
    const size_t row = (size_t)b * SEQ + 256 * qt + 32 * wid + r32;
    bf16x8 qf[4]; load_q(qf, QX + (row * 4 + h) * 64, hi);
    const CrossPol P{KM + (size_t)(b * 4 + h) * 256 * 64, VMT + (size_t)(b * 4 + h) * 64 * 256, 64, 256};
    f32x16 o[2];
#pragma unroll
    for (int i = 0; i < 16; ++i) { o[0][i] = 0.f; o[1][i] = 0.f; }
    const float lt = flash_loop(lds, P, qf, o, -bnd[h], tid, r32, hi);
    store_o(o, 1.f / lt, OX + row * 256 + h * 64, hi);
}
constexpr int SP_OACC = 0, SP_LACC = 256 * 65 * 4, SP_BIAS = 69632, SP_SCR = SP_BIAS + 8 * 132 * 4, SP_Q = SP_SCR + 8 * 64  , SP_END = SP_Q + 256 * TP;
DI int cvt_rpi(float x) { int i; asm("v_cvt_rpi_i32_f32 %0, %1" : "=v"(i) : "v"(x)); return i; }
constexpr float SP_FS = 131072.0f;
static_assert(SP_END + 8 * 320 * 4 <= 131072, "sparse selected LDS");
DI void sel_sparse_unit(LAS unsigned char* lds, int b, int kvh, int c, const bf16_t* Q, const bf16_t* KS, const bf16_t* VSB, const unsigned* SEL, bf16_t* OS, const float* bnd, const int tid_) {
    int tid = tid_; asm volatile("" : "+v"(tid));
    const int lane = tid & 63, wid = __builtin_amdgcn_readfirstlane(tid >> 6), r32 = lane & 31, hi = lane >> 5, slot = r32 >> 2, g4 = r32 & 3;
    const size_t plane = (size_t)(b * 2 + kvh);
    const bf16_t* Kp = KS + plane * SEQ * 64; const bf16_t* Vp = VSB + plane * 64 * SEQ;
    LAS int* OACC = (LAS int*)(lds + SP_OACC); LAS int* LACC = (LAS int*)(lds + SP_LACC);
    __syncthreads();
    for (int i = tid; i < (256 * 65 + 256) / 4; i += 512) ((LAS u32x4*)lds)[i] = (u32x4){0u, 0u, 0u, 0u};
    { const int tk_ = tid >> 3, ch_ = tid & 7; const u32x4* src = (const u32x4*)(Q + (((size_t)b * SEQ + 64 * c + tk_) * 8 + kvh * 4) * 64 + ch_ * 32);
      LAS u32x4* dq = (LAS u32x4*)(lds + SP_Q + (tk_ * 4 + (ch_ >> 1)) * TP + (ch_ & 1) * 64);
      const u32x4 q0 = src[0], q1 = src[1], q2 = src[2], q3 = src[3]; dq[0] = q0; dq[1] = q1; dq[2] = q2; dq[3] = q3; }
    const u32x4 mk = *(const u32x4*)(SEL + (plane * SEQ + 64 * c + lane) * 4);
    const u64 mlo = (u64)mk.x | ((u64)mk.y << 32), mhi = (u64)mk.z | ((u64)mk.w << 32);
    LAS unsigned char* scr = lds + SP_SCR + wid * 64;
    const float cval = 17.0f - bnd[kvh * 4 + g4];
    const LAS float* btab = (const LAS float*)(lds + SP_END) + (kvh * 4 + g4) * XT_SEL;
    __syncthreads();
    int jn = -1, tokN0 = 0, tokN1 = 0; bool validN0 = false, validN1 = false;
#define SP_FIND(from) { jn = -1; for (int j_ = (from); j_ <= c; ++j_) { const bool bit_ = ((j_ < 64 ? mlo >> j_ : mhi >> (j_ - 64)) & 1ull) != 0ull; const u64 M_ = __ballot(bit_); \
        const int n_ = __popcll(M_), g_ = (wid - j_) & 7; \
        if (16 * g_ < n_) { const int rank_ = __builtin_amdgcn_mbcnt_hi((unsigned)(M_ >> 32), __builtin_amdgcn_mbcnt_lo((unsigned)M_, 0u)); if (bit_) scr[rank_] = (unsigned char)lane; \
            const int idx_ = 16 * g_ + slot; validN0 = idx_ < n_; validN1 = idx_ + 8 < n_; tokN0 = validN0 ? (int)scr[idx_] : 0; tokN1 = validN1 ? (int)scr[idx_ + 8] : 0; jn = j_; break; } } }
#define SP_LOAD_K() { const bf16_t* kb_ = Kp + (size_t)jn * 4096 + lane * 8; _Pragma("unroll") for (int f = 0; f < 8; ++f) kf[f] = *(const bf16x8*)(kb_ + f * 512); }
#define SP_LOAD_V() { const bf16_t* vb_ = Vp + (size_t)jn * 4096 + lane * 8; _Pragma("unroll") for (int f = 0; f < 8; ++f) vf[f] = *(const bf16x8*)(vb_ + f * 512); }
#define SP_SUB(TOK, VALID, LAST) { const int tok = (TOK); const bool valid = (VALID); const int t = 64 * c + tok; bf16x8 qf[4]; \
        { const LAS unsigned char* qr_ = lds + SP_Q + (tok * 4 + g4) * TP + hi * 16; _Pragma("unroll") for (int d0 = 0; d0 < 4; ++d0) qf[d0] = *(const LAS bf16x8*)(qr_ + d0 * 32); } \
        f32x16 p0, p1, cv; { const float cvl = valid ? cval : -INFINITY; _Pragma("unroll") for (int i = 0; i < 16; ++i) cv[i] = cvl; } \
        p0 = MFMA32(kf[0], qf[0], cv); p1 = MFMA32(kf[1], qf[0], cv); \
        _Pragma("unroll") for (int d0 = 1; d0 < 4; ++d0) { p0 = MFMA32(kf[2 * d0], qf[d0], p0); p1 = MFMA32(kf[2 * d0 + 1], qf[d0], p1); } \
        if (LAST) { __builtin_amdgcn_sched_barrier(0); SP_FIND(j + 1) if (jn >= 0) SP_LOAD_K() __builtin_amdgcn_sched_barrier(0); } \
        if (j + 2 >= c) bias_mask_x(p0, p1, btab, t, 64 * j, hi); \
        exp_tile(p0, p1); \
        f32x16 o[2], lacc; _Pragma("unroll") for (int i = 0; i < 16; ++i) { o[0][i] = 0.f; o[1][i] = 0.f; lacc[i] = 0.f; } \
        { const bf16x8 ones = (bf16x8){0x3F80, 0x3F80, 0x3F80, 0x3F80, 0x3F80, 0x3F80, 0x3F80, 0x3F80}; \
          _Pragma("unroll") for (int ks = 0; ks < 4; ++ks) { const bf16x8 pf = (ks < 2) ? pack_p(p0, ks) : pack_p(p1, ks - 2); \
              o[0] = MFMA32(vf[2 * ks], pf, o[0]); o[1] = MFMA32(vf[2 * ks + 1], pf, o[1]); lacc = MFMA32(ones, pf, lacc); } } \
        if (LAST) { __builtin_amdgcn_sched_barrier(0); if (jn >= 0) SP_LOAD_V() __builtin_amdgcn_sched_barrier(0); } \
        if (valid) { LAS int* orow = OACC + (tok * 4 + g4) * 65; \
            _Pragma("unroll") for (int dh = 0; dh < 2; ++dh) _Pragma("unroll") for (int r = 0; r < 16; ++r) \
                __hip_atomic_fetch_add(orow + 32 * dh + crow(r, hi), cvt_rpi(o[dh][r]), __ATOMIC_RELAXED, __HIP_MEMORY_SCOPE_WORKGROUP); \
            if (hi == 0) __hip_atomic_fetch_add(LACC + tok * 4 + g4, cvt_rpi(lacc[0]), __ATOMIC_RELAXED, __HIP_MEMORY_SCOPE_WORKGROUP); } }
    bf16x8 kf[8], vf[8];
    SP_FIND(0)
    if (jn >= 0) { SP_LOAD_K() SP_LOAD_V() }
    while (jn >= 0) {
        const int j = jn, t1_ = tokN1; const bool v1_ = validN1; int tcur = tokN0; bool vcur = validN0;
        const int nsub = __any(v1_) ? 2 : 1;
#pragma unroll 1
        for (int sg = 0; sg < nsub; ++sg) { const bool last = (sg == nsub - 1); SP_SUB(tcur, vcur, last) tcur = t1_; vcur = v1_; }
    }
#undef SP_FIND
#undef SP_LOAD_K
#undef SP_LOAD_V
#undef SP_SUB
    __syncthreads();
    { const int row = 32 * wid + r32; const LAS int* orow = OACC + row * 65; const int li = LACC[row];
      const float inv = li > 0 ? 1.0f / (float)li : 0.f;
      bf16_t* dst = OS + (((size_t)b * SEQ + 64 * c + (row >> 2)) * 8 + kvh * 4 + (row & 3)) * 64;
#pragma unroll
      for (int dh = 0; dh < 2; ++dh)
#pragma unroll
          for (int g = 0; g < 4; ++g) { const int d = 32 * dh + 8 * g + 4 * hi;
              u32x2 w; w.x = cvtpk((float)orow[d] * inv, (float)orow[d + 1] * inv); w.y = cvtpk((float)orow[d + 2] * inv, (float)orow[d + 3] * inv);
              *(u32x2*)(dst + d) = w; } }
}
}
namespace att {
DI void cmp_bias_half(f32x16& p, const LAS float* btab, int dbase, int hi) {
    float bv[16];
#pragma unroll
    for (int r = 0; r < 16; ++r) { const int d = dbase - 16 * crow(r, hi); bv[r] = btab[d < 0 ? 0 : (d < 128 ? d : 128)]; }
#pragma unroll
    for (int r = 0; r < 16; ++r) { const int d = dbase - 16 * crow(r, hi); p[r] = d >= 0 ? p[r] + bv[r] : -INFINITY; }
}
DI void cmp_bias_mask(f32x16& p0, f32x16& p1, const LAS float* btab, int t, int k, int hi) {
    const int base = t - 31 - 16 * 64 * k;
    cmp_bias_half(p0, btab, base, hi); asm volatile("" ::: "memory"); cmp_bias_half(p1, btab, base - 16 * 32, hi);
}
DI void qk_tile_s(f32x16& p0, f32x16& p1, const LAS unsigned char* kt, const bf16x8 (&qf)[4], float cval, int r32, int hi) {
    const LAS unsigned char* kb = kt + r32 * TP + hi * 16;
#pragma unroll
    for (int i = 0; i < 16; ++i) { p0[i] = cval; p1[i] = cval; }
#pragma unroll
    for (int d0 = 0; d0 < 4; ++d0) { const bf16x8 k0 = *(const LAS bf16x8*)(kb + d0 * 32), k1 = *(const LAS bf16x8*)(kb + 32 * TP + d0 * 32); p0 = MFMA32(k0, qf[d0], p0); p1 = MFMA32(k1, qf[d0], p1); }
}
DI void pv_tile_s(f32x16 (&o)[2], const LAS unsigned char* vt, const f32x16& p0, const f32x16& p1, int r32, int hi) {
    const LAS unsigned char* vb = vt + r32 * TP + hi * 16;
#pragma unroll
    for (int ks = 0; ks < 4; ++ks) { const bf16x8 pf = (ks < 2) ? pack_p(p0, ks) : pack_p(p1, ks - 2);
        const bf16x8 v0 = *(const LAS bf16x8*)(vb + ks * 32), v1 = *(const LAS bf16x8*)(vb + 32 * TP + ks * 32); o[0] = MFMA32(v0, pf, o[0]); o[1] = MFMA32(v1, pf, o[1]); }
}
DI void build_ovt(LAS unsigned char* lds, int tid) {
    for (int e = tid; e < 32 * 64; e += 512) { const int js = e >> 6, nl = e & 63; const int cs = 16 * nl, ss = 64 * js;
        int ov = (cs + 32 < ss + 64 ? cs + 32 : ss + 64) - (cs > ss ? cs : ss); ov = ov > 0 ? ov : 0; if (js > 16) ov = 0;
        *(LAS bf16_t*)(lds + L_OVT + js * TP + perm_kv(nl) * 2) = f2bf((float)ov * (1.0f / 32.0f)); }
}
DI void cmp_unit(LAS unsigned char* lds, int b, int kvh, int c, const bf16_t* Q, const bf16_t* KCMP, const bf16_t* VCMPT, bf16_t* OC, unsigned* SEL, const float* bnd, const int tid_) {
    int tid = tid_; asm volatile("" : "+v"(tid));
    const int lane = tid & 63, wid = __builtin_amdgcn_readfirstlane(tid >> 6), r32 = lane & 31, hi = lane >> 5;
    const int tl = 8 * wid + (r32 >> 2), g = r32 & 3, t = 64 * c + tl;
    const size_t plane = (size_t)(b * 2 + kvh);
    const bf16_t* Kp = KCMP + plane * NCMPP * 64; const bf16_t* Vp = VCMPT + plane * 64 * NCMPP;
    bf16x8 qf[4]; load_q(qf, Q + (((size_t)b * SEQ + t) * 8 + kvh * 4 + g) * 64, hi);
    const LAS float* btab = (const LAS float*)(lds + L_BIAS) + (kvh * 4 + g) * 132;
    const int nt = ((4 * c + 2) >> 6) + 1;
    f32x16 p0, p1; float l = 0.f; const float cval = -bnd[kvh * 4 + g];
    TileRegs tr;
    LAS bf16_t* raw = (LAS bf16_t*)(lds + L_IMP); LAS float* invl = (LAS float*)(lds + L_INVL);
    f32x16 o[2];
#pragma unroll
    for (int i = 0; i < 16; ++i) { o[0][i] = 0.f; o[1][i] = 0.f; }
    float carry = 0.f;
    tile_fetch(tr, Kp, 64, Vp, NCMPP, tid);
    __syncthreads();
    tile_put(tr, lds + L_K0, lds + L_V0, tid);
    __syncthreads();
    for (int k = 0; k < nt; ++k) {
        const int bsel = k & 1;
        if (k + 1 < nt) tile_fetch(tr, Kp + (size_t)(k + 1) * 64 * 64, 64, Vp + (k + 1) * 64, NCMPP, tid);
        qk_tile_c(p0, p1, lds + (bsel ? L_K1 : L_K0), qf, cval, r32, hi);
        if (64 * c < 1024 * k + 1167) cmp_bias_mask(p0, p1, btab, t, k, hi);
        float s = 0.f;
#pragma unroll
        for (int i = 0; i < 16; ++i) { p0[i] = __builtin_amdgcn_exp2f(p0[i]); p1[i] = __builtin_amdgcn_exp2f(p1[i]); s += p0[i] + p1[i]; }
        l += s;
        pv_tile_s(o, lds + (bsel ? L_V1 : L_V0), p0, p1, r32, hi);
        f32x16 im;
#pragma unroll
        for (int i = 0; i < 16; ++i) im[i] = 0.f;
        { const LAS unsigned char* ob = lds + L_OVT + r32 * TP + hi * 16;
#pragma unroll
          for (int ks = 0; ks < 4; ++ks) { const bf16x8 pf = (ks < 2) ? pack_p(p0, ks) : pack_p(p1, ks - 2); im = MFMA32(*(const LAS bf16x8*)(ob + ks * 32), pf, im); } }
        if (hi == 0) im[0] += carry;
        carry = im[8];
        { LAS bf16_t* rr_ = raw + (tl * 4 + g) * 132 + 16 * k + 4 * hi;
          u32x2 w0, w1; w0.x = cvtpk(im[0], im[1]); w0.y = cvtpk(im[2], im[3]); w1.x = cvtpk(im[4], im[5]); w1.y = cvtpk(im[6], im[7]);
          *(LAS u32x2*)rr_ = w0; *(LAS u32x2*)(rr_ + 8) = w1; }
        if (k + 1 < nt) tile_put(tr, lds + (bsel ? L_K0 : L_K1), lds + (bsel ? L_V0 : L_V1), tid);
        __syncthreads();
    }
    const float lt = l + __shfl_xor(l, 32);
    const float inv = lt > 0.f ? 1.f / lt : 0.f;
    if (hi == 0) invl[tl * 4 + g] = inv;
    store_o(o, inv, OC + (((size_t)b * SEQ + t) * 8 + kvh * 4 + g) * 64, hi);
    {
        const int ti = lane >> 3, sub = lane & 7, tk = 8 * wid + ti;
        unsigned sel16 = 0u;
        if (c < 16) { sel16 = sub == 0 ? ((2u << c) - 1u) : 0u; }
        else {
            int key[16];
            float kv[16];
#pragma unroll
            for (int k = 0; k < 16; ++k) kv[k] = 0.f;
#pragma unroll
            for (int h = 0; h < 4; ++h) { const float il = invl[tk * 4 + h]; const LAS u32x4* rp = (const LAS u32x4*)(raw + (tk * 4 + h) * 132 + 16 * sub); const u32x4 a = rp[0], b2 = rp[1];
                kv[0] += il * bflo(a.x); kv[1] += il * bfhi(a.x); kv[2] += il * bflo(a.y); kv[3] += il * bfhi(a.y); kv[4] += il * bflo(a.z); kv[5] += il * bfhi(a.z); kv[6] += il * bflo(a.w); kv[7] += il * bfhi(a.w);
                kv[8] += il * bflo(b2.x); kv[9] += il * bfhi(b2.x); kv[10] += il * bflo(b2.y); kv[11] += il * bfhi(b2.y); kv[12] += il * bflo(b2.z); kv[13] += il * bfhi(b2.z); kv[14] += il * bflo(b2.w); kv[15] += il * bfhi(b2.w); }
#pragma unroll
            for (int k = 0; k < 16; ++k) { const int j = 16 * sub + k; key[k] = (j >= 1 && j <= c - 2) ? __float_as_int(kv[k]) : -1; }
#define GRP8_SUM(v) { v += __builtin_amdgcn_mov_dpp(v, 0xB1, 0xF, 0xF, true); v += __builtin_amdgcn_mov_dpp(v, 0x4E, 0xF, 0xF, true); v += __builtin_amdgcn_mov_dpp(v, 0x141, 0xF, 0xF, true); }
            int T = 0;
#pragma unroll 1
            for (int bit = 30; bit >= 0; --bit) { const int T2 = T | (1 << bit); int cnt = 0;
#pragma unroll
                for (int k = 0; k < 16; ++k) cnt += (key[k] >= T2) ? 1 : 0;
                GRP8_SUM(cnt)
                T = cnt >= 13 ? T2 : T; }
            int ngt = 0, nt = 0;
#pragma unroll
            for (int k = 0; k < 16; ++k) { ngt += (key[k] > T) ? 1 : 0; nt += (key[k] == T) ? 1 : 0; }
            int pre = nt;
            { int s1 = __builtin_amdgcn_mov_dpp(pre, 0x111, 0xF, 0xF, true); if (sub >= 1) pre += s1;
              int s2 = __builtin_amdgcn_mov_dpp(pre, 0x112, 0xF, 0xF, true); if (sub >= 2) pre += s2;
              int s4 = __builtin_amdgcn_mov_dpp(pre, 0x114, 0xF, 0xF, true); if (sub >= 4) pre += s4; }
            GRP8_SUM(ngt)
            const int need = 13 - ngt; int run = pre - nt;
#pragma unroll
            for (int k = 0; k < 16; ++k) { const bool tie = key[k] == T; if (key[k] > T || (tie && run < need)) sel16 |= 1u << k; run += tie ? 1 : 0; }
#undef GRP8_SUM
            if (sub == 0) sel16 |= 1u;
            if (sub == ((c - 1) >> 4)) sel16 |= 1u << ((c - 1) & 15);
            if (sub == (c >> 4)) sel16 |= 1u << (c & 15);
        }
        ((unsigned short*)SEL)[((plane * SEQ + 64 * c + tk) * 8) + sub] = (unsigned short)sel16;
    }
}

DI void compress_task(int which, int plane, int n0, const bf16_t* src, const bf16_t* W1T, const float* cbias, const bf16_t* W2T, const float* kgain, bf16_t* KCMP, bf16_t* VCMPT, int lane) {
    const int r32 = lane & 31, hi = lane >> 5, n = n0 + r32;
    const bf16_t* arow = src + (size_t)plane * SEQ * 64 + (size_t)n * 16 * 64 + 8 * hi;
    const bf16_t* w0 = W1T + (size_t)r32 * 2048 + 8 * hi; const bf16_t* w1 = w0 + 32 * 2048;
    f32x16 p0, p1;
#pragma unroll
    for (int i = 0; i < 16; ++i) { p0[i] = 0.f; p1[i] = 0.f; }
#pragma unroll 1
    for (int ks = 0; ks < 128; ks += 8) {
        bf16x8 a[8], b0[8], b1[8];
#pragma unroll
        for (int j = 0; j < 8; ++j) { a[j] = *(const bf16x8*)(arow + 16 * (ks + j)); b0[j] = *(const bf16x8*)(w0 + 16 * (ks + j)); b1[j] = *(const bf16x8*)(w1 + 16 * (ks + j)); }
        __builtin_amdgcn_sched_barrier(0);
#pragma unroll
        for (int j = 0; j < 8; ++j) { p0 = MFMA32(b0[j], a[j], p0); p1 = MFMA32(b1[j], a[j], p1); }
    }
#pragma unroll
    for (int r = 0; r < 16; ++r) { p0[r] = gelu_tanh(p0[r] + cbias[crow(r, hi)]); p1[r] = gelu_tanh(p1[r] + cbias[32 + crow(r, hi)]); }
    f32x16 y[2];
#pragma unroll
    for (int i = 0; i < 16; ++i) { y[0][i] = 0.f; y[1][i] = 0.f; }
#pragma unroll
    for (int ks = 0; ks < 4; ++ks) {
        const bf16x8 pf = (ks < 2) ? pack_p(p0, ks) : pack_p(p1, ks - 2);
#pragma unroll
        for (int oh = 0; oh < 2; ++oh) {
            const bf16_t* wr_ = W2T + (size_t)(32 * oh + r32) * 64 + 16 * ks + 4 * hi;
            const u32x2 lo = *(const u32x2*)wr_, hi2 = *(const u32x2*)(wr_ + 8);
            u32x4 w; w.x = lo.x; w.y = lo.y; w.z = hi2.x; w.w = hi2.y;
            y[oh] = MFMA32(__builtin_bit_cast(bf16x8, w), pf, y[oh]);
        }
    }
    const bool dead = (n >= NCMP);
    if (which == 0) {
        float s = 0.f;
#pragma unroll
        for (int i = 0; i < 16; ++i) s += y[0][i] * y[0][i] + y[1][i] * y[1][i];
        s += __shfl_xor(s, 32);
        const float rr = dead ? 0.f : rsqrtf(s * (1.0f / 64.0f) + EPS);
        bf16_t* dst = KCMP + ((size_t)plane * NCMPP + n) * 64;
#pragma unroll
        for (int oh = 0; oh < 2; ++oh)
#pragma unroll
            for (int q = 0; q < 4; ++q) { const int d = 32 * oh + 8 * q + 4 * hi; const f32x4 gv = *(const f32x4*)(kgain + d);
                u32x2 w; w.x = cvtpk(dead ? 0.f : y[oh][4 * q] * rr * gv[0], dead ? 0.f : y[oh][4 * q + 1] * rr * gv[1]); w.y = cvtpk(dead ? 0.f : y[oh][4 * q + 2] * rr * gv[2], dead ? 0.f : y[oh][4 * q + 3] * rr * gv[3]);
                *(u32x2*)(dst + d) = w; }
    } else {
        bf16_t* dst = VCMPT + (size_t)plane * 64 * NCMPP + perm_kv(n);
#pragma unroll
        for (int oh = 0; oh < 2; ++oh)
#pragma unroll
            for (int r = 0; r < 16; ++r) dst[(size_t)(32 * oh + crow(r, hi)) * NCMPP] = dead ? (bf16_t)0 : f2bf(y[oh][r]);
    }
}
}
namespace thin {
enum { MAP_ID = 0, MAP_GLU = 1, MAP_HEAD = 2, MAP_WIN = 3 };
DI int colmap(int map, int N, int np) {
    if (map == MAP_ID) return np;
    const int pn = np >> 8, c = np & 255;
    if (map == MAP_GLU) { const int q = c >> 3, i8 = c & 7; return (i8 >> 2) * (N >> 1) + 128 * pn + 4 * q + (i8 & 3); }
    const int bj = c >> 7, wc = (c >> 5) & 3, w = c & 31, hd = 32 * bj + w;
    if (map == MAP_HEAD) return 256 * pn + 64 * wc + hd;
    if (pn == 0) return c;
    if (pn <= 2) { const int q = c >> 3, i8 = c & 7; return 256 + (i8 >> 2) * 256 + 128 * (pn - 1) + 4 * q + (i8 & 3); }
    if (pn <= 4) return 768 + (4 * (pn - 3) + wc) * 64 + hd;
    if (pn <= 7) return 1280 + 256 * (pn - 5) + (wc >> 1) * 128 + (wc & 1) * 64 + hd;
    return c < 24 ? 2048 + c : -1;
}
struct XDesc { const float* W; const float* gain; bf16_t* out; int K, N, Nout, map; int nbatch, f8; size_t wstride, ostride; };

DI void xload(const XDesc& D, int item, f32x4 (&v)[8], float (&gv)[8], int lane) {
    const int per = (D.K / 64) * (D.Nout / 32), bi = item / per, it = item % per, nblk = D.Nout / 32, kb = it / nblk, nb = it % nblk, k0 = 64 * kb, n0 = 32 * nb;
    const float* W = D.W + (size_t)bi * D.wstride;
    const int r8 = lane >> 3, q4 = (lane & 7) * 4, col = colmap(D.map, D.N, n0 + q4);
#pragma unroll
    for (int i = 0; i < 8; ++i) { const int kk = 8 * i + r8; v[i] = (f32x4){0.f, 0.f, 0.f, 0.f}; gv[i] = 1.f;
        if (col >= 0) { v[i] = *(const f32x4*)(W + (size_t)(k0 + kk) * D.N + col); if (D.gain) gv[i] = D.gain[k0 + kk]; } }
}
DI void xstore(const XDesc& D, int item, const f32x4 (&v)[8], const float (&gv)[8], LAS float* scr, int lane) {
    const int per = (D.K / 64) * (D.Nout / 32), bi = item / per, it = item % per, nblk = D.Nout / 32, kb = it / nblk, nb = it % nblk, k0 = 64 * kb, n0 = 32 * nb;
    bf16_t* O = D.out + (size_t)bi * D.ostride;
    unsigned char* O8 = (unsigned char*)D.out + (size_t)bi * D.ostride;
    const int r8 = lane >> 3, q4 = (lane & 7) * 4;
#pragma unroll
    for (int i = 0; i < 8; ++i) { const int kk = 8 * i + r8; LAS float* d = scr + kk * 33 + q4; d[0] = v[i][0] * gv[i]; d[1] = v[i][1] * gv[i]; d[2] = v[i][2] * gv[i]; d[3] = v[i][3] * gv[i]; }
    LDS_WAIT(); asm volatile("" ::: "memory");
    const int c = lane & 7;
#pragma unroll
    for (int j = 0; j < 4; ++j) { const int n = (lane >> 3) + 8 * j; const LAS float* s = scr + (8 * c) * 33 + n;
        if (D.f8) { u32x2 o; o.x = pack_fp8x4(s[0 * 33] * W8_SCALE, s[1 * 33] * W8_SCALE, s[2 * 33] * W8_SCALE, s[3 * 33] * W8_SCALE); o.y = pack_fp8x4(s[4 * 33] * W8_SCALE, s[5 * 33] * W8_SCALE, s[6 * 33] * W8_SCALE, s[7 * 33] * W8_SCALE);
            *(u32x2*)(O8 + (size_t)(n0 + n) * D.K + k0 + 8 * c) = o; }
        else { u32x4 o; o.x = cvtpk(s[0 * 33], s[1 * 33]); o.y = cvtpk(s[2 * 33], s[3 * 33]); o.z = cvtpk(s[4 * 33], s[5 * 33]); o.w = cvtpk(s[6 * 33], s[7 * 33]);
            *(u32x4*)(O + (size_t)(n0 + n) * D.K + k0 + 8 * c) = o; } }
    LDS_WAIT(); asm volatile("" ::: "memory");
}
DI void row_to_bf16_ss(const float* xrow, bf16_t* orow, u64* ss, int lane) {
    const f32x4* xr = (const f32x4*)xrow + lane; float s = 0.f; f32x4 v[4];
#pragma unroll
    for (int j = 0; j < 4; ++j) { v[j] = xr[64 * j]; s += (v[j][0] * v[j][0] + v[j][1] * v[j][1]) + (v[j][2] * v[j][2] + v[j][3] * v[j][3]); }
    s = wave_sum(s);
    u32x2* o8 = (u32x2*)orow + lane;
#pragma unroll
    for (int j = 0; j < 4; ++j) { u32x2 w; w.x = cvtpk(v[j][0], v[j][1]); w.y = cvtpk(v[j][2], v[j][3]); o8[64 * j] = w; }
    if (lane == 0) *ss = (u64)(s * SS_FIX + 0.5f);
}
DI void row2_to_bf16_ss(const float* xrow, bf16_t* orow, u64* ss, int lane) {
    const f32x4* xr = (const f32x4*)xrow + lane; float s0 = 0.f, s1 = 0.f; f32x4 v[8];
#pragma unroll
    for (int j = 0; j < 8; ++j) v[j] = xr[64 * j];
#pragma unroll
    for (int j = 0; j < 4; ++j) { s0 += (v[j][0] * v[j][0] + v[j][1] * v[j][1]) + (v[j][2] * v[j][2] + v[j][3] * v[j][3]);
        s1 += (v[4 + j][0] * v[4 + j][0] + v[4 + j][1] * v[4 + j][1]) + (v[4 + j][2] * v[4 + j][2] + v[4 + j][3] * v[4 + j][3]); }
    s0 = dpp_sum16(s0); s1 = dpp_sum16(s1);
#pragma unroll
    for (int o = 16; o < 64; o <<= 1) { s0 += __shfl_xor(s0, o); s1 += __shfl_xor(s1, o); }
    u32x2* o8 = (u32x2*)orow + lane;
#pragma unroll
    for (int j = 0; j < 8; ++j) { u32x2 w; w.x = cvtpk(v[j][0], v[j][1]); w.y = cvtpk(v[j][2], v[j][3]); o8[64 * j] = w; }
    if (lane == 0) { ss[0] = (u64)(s0 * SS_FIX + 0.5f); ss[1] = (u64)(s1 * SS_FIX + 0.5f); }
}
DI int t5_bucket(int n) {
    if (n < 16) return n;
    int large = 16 + (int)(logf((float)n / 16.0f) / 2.0794415416798357f * 16.0f);
    return large < 31 ? large : 31;
}
struct S5P { const float *lre, *lim, *ldt, *bre, *bim, *cre, *cim, *dsk; };
DI void lam_pow(const S5P& P, int g, int p, float tau, float& wr, float& wi) {
    const float dt = expf(P.ldt[g]), lr = P.lre[g * 64 + p], li = P.lim[g * 64 + p];
    const float mag = expf(lr * dt * tau); float sn, cs; sincosf(li * dt * tau, &sn, &cs); wr = mag * cs; wi = mag * sn;
}
DI void zoh_f(const S5P& P, int g, int p, float& fr, float& fi) {
    const float lr = P.lre[g * 64 + p], li = P.lim[g * 64 + p]; float ar, ai; lam_pow(P, g, p, 1.f, ar, ai);
    const float den = lr * lr + li * li; fr = ((ar - 1.f) * lr + ai * li) / den; fi = (ai * lr - (ar - 1.f) * li) / den;
}
DI void ktab_task(const S5P& P, float* ktab, int g, int tau, LAS float* scr, int lane) {
    LAS float* cs = scr + 2048;
#pragma unroll
    for (int i = 0; i < 4; ++i) { *(LAS f32x4*)(cs + 4 * lane + 256 * i) = *(const f32x4*)(P.cre + g * 1024 + 4 * lane + 256 * i); *(LAS f32x4*)(cs + 1024 + 4 * lane + 256 * i) = *(const f32x4*)(P.cim + g * 1024 + 4 * lane + 256 * i); }
    { const int p = lane; float wr, wi, fr, fi; lam_pow(P, g, p, (float)tau, wr, wi); zoh_f(P, g, p, fr, fi);
      const float gr = wr * fr - wi * fi, gi = wr * fi + wi * fr;
#pragma unroll
      for (int h = 0; h < 16; ++h) { const float br = P.bre[(g * 64 + p) * 16 + h], bi = P.bim[(g * 64 + p) * 16 + h];
          scr[(p * 16 + h) * 2] = gr * br - gi * bi; scr[(p * 16 + h) * 2 + 1] = gr * bi + gi * br; } }
    LDS_WAIT(); asm volatile("" ::: "memory");
#pragma unroll 1
    for (int k = 0; k < 4; ++k) { const int idx = lane + 64 * k, ho = idx >> 4, hi = idx & 15; float a = 0.f;
#pragma unroll 8
        for (int p = 0; p < 64; ++p) a += cs[ho * 64 + p] * scr[(p * 16 + hi) * 2] - cs[1024 + ho * 64 + p] * scr[(p * 16 + hi) * 2 + 1];
        ktab[((size_t)(g * 64 + tau) * 16 + ho) * 16 + hi] = a; }
    LDS_WAIT(); asm volatile("" ::: "memory");
}
DI void st_load8(const float* ktab, int g, int n, int k0, f32x4& a, f32x4& b) {
    const int to = n >> 4, ho = n & 15, ti = k0 >> 4, h0 = k0 & 15;
    a = (f32x4){0.f, 0.f, 0.f, 0.f}; b = a;
    if (to >= ti) { const float* kp = ktab + ((size_t)(g * 64 + (to - ti)) * 16 + ho) * 16 + h0; a = *(const f32x4*)kp; b = *(const f32x4*)(kp + 4); }
}
DI void st_store8(const S5P& P, bf16_t* ST, int g, int n, int k0, f32x4 a, f32x4 b) {
    const int to = n >> 4, ho = n & 15, ti = k0 >> 4, h0 = k0 & 15;
    if (to == ti && (ho >> 3) == (h0 >> 3)) { const float d = P.dsk[g * 16 + ho]; const int j = ho & 7;
        a[0] += (j == 0) ? d : 0.f; a[1] += (j == 1) ? d : 0.f; a[2] += (j == 2) ? d : 0.f; a[3] += (j == 3) ? d : 0.f;
        b[0] += (j == 4) ? d : 0.f; b[1] += (j == 5) ? d : 0.f; b[2] += (j == 6) ? d : 0.f; b[3] += (j == 7) ? d : 0.f; }
    u32x4 w; w.x = cvtpk(a[0], a[1]); w.y = cvtpk(a[2], a[3]); w.z = cvtpk(b[0], b[1]); w.w = cvtpk(b[2], b[3]);
    *(u32x4*)(ST + ((size_t)g * 1024 + n) * SKX + 128 + k0) = w;
}
DI void st_carry(const S5P& P, bf16_t* ST, int g, int to, int p) {
    float wr, wi; lam_pow(P, g, p, (float)(to + 1), wr, wi);
#pragma unroll 4
    for (int ho = 0; ho < 16; ++ho) { const float cr = P.cre[(g * 16 + ho) * 64 + p], ci = P.cim[(g * 16 + ho) * 64 + p];
        bf16_t* row = ST + ((size_t)g * 1024 + to * 16 + ho) * SKX;
        row[p] = f2bf(cr * wr - ci * wi); row[64 + p] = f2bf(-(cr * wi + ci * wr)); }
}
DI void sz_fill8(const S5P& P, bf16_t* SZ, int g, int n, int k0) {
    float v[8];
    if (n < 128) { const int p = n & 63, ti = k0 >> 4, h0 = k0 & 15; float wr, wi, fr, fi; lam_pow(P, g, p, (float)(63 - ti), wr, wi); zoh_f(P, g, p, fr, fi);
        const float gr = wr * fr - wi * fi, gi = wr * fi + wi * fr;
#pragma unroll
        for (int j = 0; j < 8; ++j) { const float br = P.bre[(g * 64 + p) * 16 + h0 + j], bi = P.bim[(g * 64 + p) * 16 + h0 + j]; v[j] = (n < 64) ? (gr * br - gi * bi) : (gr * bi + gi * br); }
    } else {
#pragma unroll
        for (int j = 0; j < 8; ++j) v[j] = 0.f;
    }
    u32x4 w; w.x = cvtpk(v[0], v[1]); w.y = cvtpk(v[2], v[3]); w.z = cvtpk(v[4], v[5]); w.w = cvtpk(v[6], v[7]);
    *(u32x4*)(SZ + ((size_t)g * 256 + n) * 1024 + k0) = w;
}

DI void conv_unit(LAS unsigned char* lds, int tile, const bf16_t* CVIN, const float* wdw, const float* bdw, const float* lng, const float* lnb, bf16_t* CV, const int tid) {
    const int c = tid & 255, half = tid >> 8, lane = tid & 63, wid = __builtin_amdgcn_readfirstlane(tid >> 6);
    const int row0 = tile * 64 + 32 * half, s0 = row0 & (SEQ - 1);
    LAS float* y = (LAS float*)lds;
    float w[31];
#pragma unroll
    for (int k = 0; k < 31; ++k) w[k] = wdw[k * 256 + c];
    const float bias = bdw[c];
    float v[62];
#pragma unroll
    for (int i = 0; i < 62; ++i) { const int sp = s0 - 30 + i; v[i] = sp >= 0 ? bf2f(CVIN[(size_t)(row0 - 30 + i) * 256 + c]) : 0.f; }
    __syncthreads();
#pragma unroll
    for (int tt = 0; tt < 32; ++tt) { float a = bias;
#pragma unroll
        for (int k = 0; k < 31; ++k) a += w[k] * v[tt + k];
        y[(32 * half + tt) * 256 + c] = a; }
    __syncthreads();
    const f32x4 gg = *(const f32x4*)(lng + 4 * lane), bb = *(const f32x4*)(lnb + 4 * lane);
#pragma unroll
    for (int i = 0; i < 8; ++i) { const int tk = 8 * wid + i; const f32x4 x = *(const LAS f32x4*)(y + tk * 256 + 4 * lane);
        const float mean = wave_sum((x[0] + x[1]) + (x[2] + x[3])) * (1.0f / 256.0f);
        const f32x4 d = x - mean; const float var = wave_sum((d[0] * d[0] + d[1] * d[1]) + (d[2] * d[2] + d[3] * d[3])) * (1.0f / 256.0f);
        const float rs = rsqrtf(var + EPS);
        f32x4 o = d * rs * gg + bb;
        u32x2 wv; wv.x = cvtpk(siluf_(o[0]), siluf_(o[1])); wv.y = cvtpk(siluf_(o[2]), siluf_(o[3]));
        *(u32x2*)(CV + (size_t)(tile * 64 + tk) * 256 + 4 * lane) = wv; }
}

DI void s5_combine(const float* __restrict__ a64, const float* __restrict__ ZC, bf16_t* __restrict__ UX, int gt) {
    const int p = gt & 63, g = (gt >> 6) & 15, b = gt >> 10;
    const float ar = a64[(g * 64 + p) * 2], ai = a64[(g * 64 + p) * 2 + 1];
    float xr = 0.f, xi = 0.f;
    const size_t ch0 = (size_t)g * NCHUNK + b * 128;
    float zr[2][16], zi[2][16];
#pragma unroll
    for (int j = 0; j < 16; ++j) { zr[0][j] = ZC[(ch0 + j) * 128 + p]; zi[0][j] = ZC[(ch0 + j) * 128 + 64 + p]; }
#pragma unroll
    for (int c8 = 0; c8 < 8; ++c8) {
        if (c8 < 7) {
#pragma unroll
            for (int j = 0; j < 16; ++j) { const size_t ch = ch0 + 16 * (c8 + 1) + j; zr[(c8 + 1) & 1][j] = ZC[ch * 128 + p]; zi[(c8 + 1) & 1][j] = ZC[ch * 128 + 64 + p]; }
        }
#pragma unroll
        for (int j = 0; j < 16; ++j) { const size_t ch = ch0 + 16 * c8 + j;
            UX[ch * SKX + p] = f2bf(xr); UX[ch * SKX + 64 + p] = f2bf(xi);
            const float nr = ar * xr - ai * xi + zr[c8 & 1][j], ni = ar * xi + ai * xr + zi[c8 & 1][j]; xr = nr; xi = ni; }
    }
}

template <bool F8OUT> DI void mixnorm_row2(int row, const bf16_t* YSSM, const bf16_t* YCONV, const bf16_t* OC, const bf16_t* OS, const bf16_t* OW, const float* GATE, bf16_t* AMIX, int lane) {
    u32x4 q[2][6]; float gt[2][3];
#pragma unroll
    for (int t = 0; t < 2; ++t) {
        if (lane < 32) { const bf16_t* src = (lane < 16 ? YSSM : YCONV) + (size_t)(row + t) * 256 + 16 * (lane & 15); q[t][0] = *(const u32x4*)src; q[t][1] = *(const u32x4*)(src + 8); }
        else { const int head = (lane - 32) >> 2; const size_t off = (size_t)(row + t) * 512 + 16 * (lane - 32);
            gt[t][0] = GATE[(size_t)(row + t) * 24 + head * 3]; gt[t][1] = GATE[(size_t)(row + t) * 24 + head * 3 + 1]; gt[t][2] = GATE[(size_t)(row + t) * 24 + head * 3 + 2];
            q[t][0] = *(const u32x4*)(OC + off); q[t][1] = *(const u32x4*)(OS + off); q[t][2] = *(const u32x4*)(OW + off);
            q[t][3] = *(const u32x4*)(OC + off + 8); q[t][4] = *(const u32x4*)(OS + off + 8); q[t][5] = *(const u32x4*)(OW + off + 8); }
    }
#pragma unroll
    for (int t = 0; t < 2; ++t) {
        float v[16];
        if (lane < 32) { const u32x4 a = q[t][0], b = q[t][1];
            v[0] = bflo(a.x); v[1] = bfhi(a.x); v[2] = bflo(a.y); v[3] = bfhi(a.y); v[4] = bflo(a.z); v[5] = bfhi(a.z); v[6] = bflo(a.w); v[7] = bfhi(a.w);
            v[8] = bflo(b.x); v[9] = bfhi(b.x); v[10] = bflo(b.y); v[11] = bfhi(b.y); v[12] = bflo(b.z); v[13] = bfhi(b.z); v[14] = bflo(b.w); v[15] = bfhi(b.w);
        } else { const float g0 = gt[t][0], g1 = gt[t][1], g2 = gt[t][2];
#pragma unroll
            for (int h8 = 0; h8 < 2; ++h8) { const u32x4 a = q[t][3 * h8], b = q[t][3 * h8 + 1], c = q[t][3 * h8 + 2];
                v[8 * h8 + 0] = g0 * bflo(a.x) + g1 * bflo(b.x) + g2 * bflo(c.x); v[8 * h8 + 1] = g0 * bfhi(a.x) + g1 * bfhi(b.x) + g2 * bfhi(c.x);
                v[8 * h8 + 2] = g0 * bflo(a.y) + g1 * bflo(b.y) + g2 * bflo(c.y); v[8 * h8 + 3] = g0 * bfhi(a.y) + g1 * bfhi(b.y) + g2 * bfhi(c.y);
                v[8 * h8 + 4] = g0 * bflo(a.z) + g1 * bflo(b.z) + g2 * bflo(c.z); v[8 * h8 + 5] = g0 * bfhi(a.z) + g1 * bfhi(b.z) + g2 * bfhi(c.z);
                v[8 * h8 + 6] = g0 * bflo(a.w) + g1 * bflo(b.w) + g2 * bflo(c.w); v[8 * h8 + 7] = g0 * bfhi(a.w) + g1 * bfhi(b.w) + g2 * bfhi(c.w); }
        }
        float s = 0.f;
#pragma unroll
        for (int i = 0; i < 16; ++i) s += v[i] * v[i];
        s = dpp_sum16(s);
        const float s16 = __shfl_xor(s, 16);
        const float tot = lane < 32 ? s : s + s16;
        const float rs = rsqrtf(tot * (lane < 32 ? 1.0f / 256.0f : 1.0f / 512.0f) + EPS);
        if constexpr (F8OUT) {
        u32x4 w8; w8.x = pack_fp8x4(v[0] * rs, v[1] * rs, v[2] * rs, v[3] * rs); w8.y = pack_fp8x4(v[4] * rs, v[5] * rs, v[6] * rs, v[7] * rs);
        w8.z = pack_fp8x4(v[8] * rs, v[9] * rs, v[10] * rs, v[11] * rs); w8.w = pack_fp8x4(v[12] * rs, v[13] * rs, v[14] * rs, v[15] * rs);
        *(u32x4*)((unsigned char*)AMIX + (size_t)(row + t) * 1024 + 16 * lane) = w8;
        } else {
        u32x4 w0, w1; w0.x = cvtpk(v[0] * rs, v[1] * rs); w0.y = cvtpk(v[2] * rs, v[3] * rs); w0.z = cvtpk(v[4] * rs, v[5] * rs); w0.w = cvtpk(v[6] * rs, v[7] * rs);
        w1.x = cvtpk(v[8] * rs, v[9] * rs); w1.y = cvtpk(v[10] * rs, v[11] * rs); w1.z = cvtpk(v[12] * rs, v[13] * rs); w1.w = cvtpk(v[14] * rs, v[15] * rs);
        bf16_t* dst = AMIX + (size_t)(row + t) * 1024 + 16 * lane; *(u32x4*)dst = w0; *(u32x4*)(dst + 8) = w1; }
    }
}
}
namespace moe {
using pg8::Unit;
constexpr int NCHK = 256, CHKT = 256;
struct Route { int* counts; int* startp; int* tok_e; int* tok_rank; float* tok_g; int* row_tok; float* row_gate; };
constexpr int L_WRT = 0  , L_LE = 32768  , L_CNT = 0  , L_SP = 16384  , L_TOT = 16384 + 128  ;

DI void load_router(LAS unsigned char* lds, const float* wr, const float* gain, int tid) {
    LAS float* wrt = (LAS float*)(lds + L_WRT);
    float wv[16], gv[16];
#pragma unroll
    for (int q = 0; q < 16; ++q) { const int i = tid + 512 * q; wv[q] = wr[i]; gv[q] = gain[i >> 3]; }
#pragma unroll
    for (int q = 0; q < 16; ++q) { const int i = tid + 512 * q, k = i >> 3, e = i & 7; wrt[e * 1024 + k] = wv[q] * gv[q]; }
}
DI void route1_chunk(LAS unsigned char* lds, int chunk, const bf16_t* H, const u64* ss, const Route& R, const int tid) {
    const int lane = tid & 63, wid = __builtin_amdgcn_readfirstlane(tid >> 6);
    const LAS float* wrt = (const LAS float*)(lds + L_WRT); LAS int* le = (LAS int*)(lds + L_LE);
    u32x2 qa[4], qb[4];
    { const int tok0 = chunk * CHKT + 32 * wid;
#pragma unroll
      for (int j = 0; j < 4; ++j) { qa[j] = *(const u32x2*)(H + (size_t)tok0 * DM + 4 * lane + 256 * j); qb[j] = *(const u32x2*)(H + (size_t)(tok0 + 1) * DM + 4 * lane + 256 * j); } }
    for (int i = 0; i < 32; i += 2) {
        const int tok = chunk * CHKT + 32 * wid + i;
        f32x4 ha[4], hb[4];
#pragma unroll
        for (int j = 0; j < 4; ++j) { ha[j] = (f32x4){bflo(qa[j].x), bfhi(qa[j].x), bflo(qa[j].y), bfhi(qa[j].y)}; hb[j] = (f32x4){bflo(qb[j].x), bfhi(qb[j].x), bflo(qb[j].y), bfhi(qb[j].y)}; }
        { const int tn = (i + 2 < 32) ? tok + 2 : tok;
#pragma unroll
          for (int j = 0; j < 4; ++j) { qa[j] = *(const u32x2*)(H + (size_t)tn * DM + 4 * lane + 256 * j); qb[j] = *(const u32x2*)(H + (size_t)(tn + 1) * DM + 4 * lane + 256 * j); } }
        const float rsa = rsqrtf((float)ss[tok] * (1.0f / (SS_FIX * 1024.0f)) + EPS), rsb = rsqrtf((float)ss[tok + 1] * (1.0f / (SS_FIX * 1024.0f)) + EPS);
        float la[8], lb[8];
#pragma unroll
        for (int e = 0; e < 8; ++e) { la[e] = 0.f; lb[e] = 0.f; }
#pragma unroll
        for (int j = 0; j < 4; ++j)
#pragma unroll
            for (int e = 0; e < 8; ++e) { const f32x4 wv = *(const LAS f32x4*)(wrt + e * 1024 + 4 * lane + 256 * j);
                la[e] += (ha[j][0] * wv[0] + ha[j][1] * wv[1]) + (ha[j][2] * wv[2] + ha[j][3] * wv[3]); lb[e] += (hb[j][0] * wv[0] + hb[j][1] * wv[1]) + (hb[j][2] * wv[2] + hb[j][3] * wv[3]); }
#pragma unroll
        for (int e = 0; e < 8; ++e) { la[e] = dpp_sum16(la[e]); lb[e] = dpp_sum16(lb[e]); }
#pragma unroll
        for (int o_ = 16; o_ < 64; o_ <<= 1)
#pragma unroll
            for (int e = 0; e < 8; ++e) { la[e] += __shfl_xor(la[e], o_); lb[e] += __shfl_xor(lb[e], o_); }
#pragma unroll
        for (int tt = 0; tt < 2; ++tt) {
            float lg[8];
#pragma unroll
            for (int e = 0; e < 8; ++e) lg[e] = tt ? lb[e] * rsb : la[e] * rsa;
            int e0 = 0; float v0 = lg[0];
#pragma unroll
            for (int e = 1; e < 8; ++e) if (lg[e] > v0) { v0 = lg[e]; e0 = e; }
            int e1 = -1; float v1 = -INFINITY;
#pragma unroll
            for (int e = 0; e < 8; ++e) if (e != e0 && (e1 < 0 || lg[e] > v1)) { v1 = lg[e]; e1 = e; }
            const float g0 = 1.f / (1.f + __expf(v1 - v0));
            if (lane == 0) { le[32 * wid + i + tt] = e0 | (e1 << 8); R.tok_g[(size_t)(tok + tt) * 2] = g0; R.tok_g[(size_t)(tok + tt) * 2 + 1] = 1.f - g0; }
        }
    }
    __syncthreads();
    if (wid == 0) {
#pragma unroll
        for (int s = 0; s < 2; ++s) {
            int run = 0;
            for (int rd = 0; rd < 4; ++rd) { const int tl = 64 * rd + lane, es = (le[tl] >> (8 * s)) & 0xff; int rank = 0;
#pragma unroll
                for (int e = 0; e < 8; ++e) { const u64 mk = __ballot(es == e); const int before = __popcll(mk & ((1ull << lane) - 1ull)), tot = __popcll(mk);
                    const int re = __shfl(run, e); if (es == e) rank = re + before; if (lane == e) run += tot; }
                const int tok = chunk * CHKT + tl; R.tok_e[(size_t)s * MTOK + tok] = es; R.tok_rank[(size_t)s * MTOK + tok] = rank; }
            if (lane < 8) R.counts[(chunk * 2 + s) * 8 + lane] = run;
        }
    }
    __syncthreads();
}
DI void route2(LAS unsigned char* lds, const Route& R, int G, const int tid) {
    LAS int* cnt = (LAS int*)(lds + L_CNT); LAS int* sp = (LAS int*)(lds + L_SP); LAS int* tot = (LAS int*)(lds + L_TOT);
    __syncthreads();
    { int cv[8];
#pragma unroll
      for (int q = 0; q < 8; ++q) cv[q] = R.counts[tid + 512 * q];
#pragma unroll
      for (int q = 0; q < 8; ++q) cnt[tid + 512 * q] = cv[q]; }
    __syncthreads();
    LAS int* seg = (LAS int*)(lds + L_SP + 256);
    { const int col = tid & 15, sg = tid >> 4; int run = 0;
#pragma unroll
      for (int k = 0; k < 8; ++k) { const int ix = (8 * sg + k) * 16 + col; const int v = cnt[ix]; cnt[ix] = run; run += v; }
      seg[sg * 16 + col] = run; }
    __syncthreads();
    if (tid < 16) { int a = 0; for (int sg = 0; sg < 32; ++sg) { const int v = seg[sg * 16 + tid]; seg[sg * 16 + tid] = a; a += v; } tot[tid] = a; }
    __syncthreads();
    if (tid < 2) { int a = 0; for (int e = 0; e < 8; ++e) { sp[tid * 16 + e] = a; a += (tot[tid * 8 + e] + 255) & ~255; } sp[tid * 16 + 8] = a;
        if (blockIdx.x == 0) for (int e = 0; e < 9; ++e) R.startp[tid * 16 + e] = sp[tid * 16 + e]; }
    __syncthreads();
    for (int chunk = blockIdx.x; chunk < NCHK; chunk += G) {
        if (tid < CHKT) { const int tok = chunk * CHKT + tid;
#pragma unroll
            for (int s = 0; s < 2; ++s) { const int e = R.tok_e[(size_t)s * MTOK + tok]; const int dest = sp[s * 16 + e] + seg[(chunk >> 3) * 16 + s * 8 + e] + cnt[chunk * 16 + s * 8 + e] + R.tok_rank[(size_t)s * MTOK + tok];
                R.row_tok[(size_t)s * MOEROWS + dest] = tok; R.row_gate[(size_t)s * MOEROWS + dest] = R.tok_g[(size_t)tok * 2 + s]; } }
    }
    if (blockIdx.x < 16) { const int s = blockIdx.x >> 3, e = blockIdx.x & 7; const int lo = sp[s * 16 + e] + tot[s * 8 + e], hi = sp[s * 16 + e + 1];
        for (int r = lo + tid; r < hi; r += 512) { R.row_tok[(size_t)s * MOEROWS + r] = -1; R.row_gate[(size_t)s * MOEROWS + r] = 0.f; } }
}
DI void gather_rows(const Route& R, int s, const unsigned char* H8, unsigned char* XB8, int gw, int NGW, int lane) {
    const int nrows = R.startp[s * 16 + 8], per = (nrows + NGW - 1) / NGW, lo = gw * per, hi = (lo + per < nrows) ? lo + per : nrows;
    for (int r0 = lo; r0 < hi; r0 += 11) {
        const int tv = (lane < 11 && r0 + lane < hi) ? R.row_tok[(size_t)s * MOEROWS + r0 + lane] : -1;
        u32x4 a[11];
#pragma unroll
        for (int j = 0; j < 11; ++j) { const int tok = __builtin_amdgcn_readlane(tv, j); a[j] = ((const u32x4*)(H8 + (size_t)(tok < 0 ? 0 : tok) * DM))[lane];
            if (tok < 0) a[j] = (u32x4){0u, 0u, 0u, 0u}; }
#pragma unroll
        for (int j = 0; j < 11; ++j) if (r0 + j < hi) ((u32x4*)(XB8 + (size_t)(r0 + j) * DM))[lane] = a[j];
    }
}
struct MoeOrder {
    int nN, G, c, T; int s1, s2, s3, s4, s5, s6, s7; const char* A; const char* B; size_t tA, tB, eB;
    DI void init(const int* startp, int nN_, int G_, int c_, const void* A_, size_t tA_, const void* B_, size_t tB_, size_t eB_) {
        nN = nN_; G = G_; c = c_; A = (const char*)A_; B = (const char*)B_; tA = tA_; tB = tB_; eB = eB_;
        s1 = startp[1]; s2 = startp[2]; s3 = startp[3]; s4 = startp[4]; s5 = startp[5]; s6 = startp[6]; s7 = startp[7]; T = startp[8] >> 8; }
    DI bool next(int i, Unit& u) const {
        if ((G & 7) == 0) {
            const int x = c & 7, lc = c >> 3, GL = G >> 3;
            const int r0 = (x * T) >> 3, r1 = ((x + 1) * T) >> 3, nr = r1 - r0;
            const int Lx = i * GL + lc; if (Lx >= nr * nN) return false;
            const int nig = 8 * nN, gid = Lx / nig, fm = gid * 8, gsz = (nr - fm) < 8 ? (nr - fm) : 8, w = Lx - gid * nig;
            u.pm = r0 + fm + (w % gsz); u.pn = w / gsz;
        } else {
            const long L = (long)i * G + c; if (L >= (long)T * nN) return false;
            u.pm = (int)(L / nN); u.pn = (int)(L % nN);
        }
        const int r = u.pm << 8;
        const int e = (r >= s1) + (r >= s2) + (r >= s3) + (r >= s4) + (r >= s5) + (r >= s6) + (r >= s7);
        u.g = e; u.A = A + (size_t)u.pm * tA; u.B = B + (size_t)e * eB + (size_t)u.pn * tB; return true;
    }
};
}
#ifndef MK_N_LAUNCHES
#define MK_N_LAUNCHES 1
#endif
#ifndef REP_SEL
#define REP_SEL 1
#endif
#ifndef REP_ATT
#define REP_ATT 1
#endif
#ifndef REP_GEMM
#define REP_GEMM 1
#endif
#ifndef REP_UP
#define REP_UP 1
#endif
#ifndef REP_PRO
#define REP_PRO 1
#endif
#ifndef REP_WIN
#define REP_WIN 1
#endif
#ifndef REP_CMP
#define REP_CMP 1
#endif
#ifndef REP_MIX
#define REP_MIX 1
#endif
#ifndef REP_GA
#define REP_GA 1
#endif
#ifndef REP_X
#define REP_X 1
#endif
#ifndef REP_FILL
#define REP_FILL 1
#endif
#ifndef REP_KT
#define REP_KT 1
#endif
#ifndef TAIL_R
#define TAIL_R 2
#endif
#ifndef REP_THIN
#define REP_THIN 1
#endif
constexpr int NWAVES = 8, NTHR = 512;
constexpr int LDS_MISC = 131072, LDS_BYTES = 147456;
constexpr int PH_PER_LAYER = 17, N_PHASES = 2 + NLAYER * PH_PER_LAYER;
enum { I_X = 0, I_MEM, I_NORM_MIX, I_W_IN, I_LRE, I_LIM, I_LDT, I_BRE, I_BIM, I_CRE, I_CIM, I_DSK, I_WGLU, I_CWDW, I_CBDW, I_CLNG, I_CLNB, I_CWPW, I_QNORM, I_KNORM, I_CPE, I_CW1, I_CW2,
       I_MIXNORM, I_WOUT, I_T5, I_NCROSS, I_NMEM, I_XWQ, I_XWKV, I_XQN, I_XKN, I_XWO, I_NFFN, I_FUP, I_FDN, I_ROUTER, I_MUP, I_MDN, N_IN };
constexpr int xt_cnt(int nb, int K, int Nout) { return nb * (K / 64) * (Nout / 32); }
constexpr int XT_LAYER = xt_cnt(1, DM, PROJP) + xt_cnt(1, 256, 512) + xt_cnt(1, 256, 256) + xt_cnt(1, DM, DM) + xt_cnt(1, DM, XW) + xt_cnt(1, DM, 2 * XW) + xt_cnt(1, XW, DM) + xt_cnt(2, 2048, 64) + xt_cnt(2, 64, 64);
constexpr int XT_TOTAL = NLAYER * XT_LAYER + xt_cnt(1, DM, 2 * DFF) + xt_cnt(1, DFF, DM) + xt_cnt(NEXP, DM, 2 * DFF) + xt_cnt(NEXP, DFF, DM);
struct Args { const float* in[N_IN]; float* out; unsigned char* ws; int ph_lo, ph_hi; };
typedef const Args __attribute__((address_space(4)))* ArgsP;

#define UX ((bf16_t*)(ws + A_UX))
#define CVIN ((bf16_t*)(ws + A_CVIN))
#define Q ((bf16_t*)(ws + A_Q))
#define KC ((bf16_t*)(ws + A_KC))
#define VC ((bf16_t*)(ws + A_VC))
#define KS ((bf16_t*)(ws + A_KS))
#define KW ((bf16_t*)(ws + A_KW))
#define VST ((bf16_t*)(ws + A_VST))
#define VWT ((bf16_t*)(ws + A_VWT))
#define OC ((bf16_t*)(ws + A_OC))
#define OS ((bf16_t*)(ws + A_OS))
#define OW ((bf16_t*)(ws + A_OW))
#define YG ((bf16_t*)(ws + A_YG))
#define YSSM ((bf16_t*)(ws + A_YSSM))
#define CV ((bf16_t*)(ws + A_CV))
#define YCONV ((bf16_t*)(ws + A_YCONV))
#define KCMP ((bf16_t*)(ws + A_KCMP))
#define VCMPT ((bf16_t*)(ws + A_VCMPT))
#define AMIX ((bf16_t*)(ws + A_AMIX))
#define QX ((bf16_t*)(ws + A_QX))
#define OX ((bf16_t*)(ws + A_OX))
#define FFA ((bf16_t*)(ws + A_FFA))
#define XB ((bf16_t*)(ws + A_XB))
#define GATE ((float*)(ws + A_GATE))
#define ZC ((float*)(ws + A_ZC))
#define SEL ((unsigned*)(ws + A_SEL))
#define HB ((bf16_t*)(ws + WS_HB))
#define SS ((u64*)(ws + CTL_SS))
#define SSMEM ((u64*)(ws + CTL_SSMEM))
__global__ void __launch_bounds__(NTHR, 2) trunk_fwd(Args args) {
    extern __shared__ __attribute__((aligned(16))) unsigned char lds_raw[];
    LAS unsigned char* lds = (LAS unsigned char*)lds_raw;
    volatile LAS unsigned* MISC = (volatile LAS unsigned*)(lds + LDS_MISC);
    const int tid0 = threadIdx.x; const int wid0 = __builtin_amdgcn_readfirstlane(tid0 >> 6);
#define PHASE_IDS int bid = blockIdx.x, G = gridDim.x; asm volatile("" : "+s"(bid), "+s"(G)); const int NGW = G * NWAVES; (void)NGW; int lane; asm volatile("v_mbcnt_lo_u32_b32 %0, -1, 0\n\tv_mbcnt_hi_u32_b32 %0, -1, %0" : "=v"(lane)); const int wid = wid0, tid = wid * 64 + lane, gw = bid * NWAVES + wid; (void)gw; ArgsP ap = (ArgsP)__builtin_amdgcn_kernarg_segment_ptr(); asm volatile("" : "+s"(ap)); unsigned char* const ws = ap->ws; float* const out = ap->out; (void)out;
    if (tid0 < 64) MISC[tid0] = 0u;
    __syncthreads();
    XcdBarrier bar; bar.bar = (unsigned*)(args.ws + CTL_BAR); bar.x = 0; bar.st = nullptr;
    if (MK_N_LAUNCHES == 1) bar = xcd_barrier_post((unsigned*)(args.ws + CTL_BAR), MISC + 8);
    const int lo = args.ph_lo, hi = args.ph_hi;
#ifndef ONLY
#define ONLY -1
#endif
#define PHON(k) (ONLY < 0 || ONLY == (k))
#define IN(k) (lo <= (k) && (k) < hi)
#define SEAM(k) do { if (IN(k) && IN((k) + 1)) xcd_barrier(bar); } while (0)

    for (int rep0 = 0; rep0 < REP_PRO; ++rep0) if (IN(0) && PHON(100)) { PHASE_IDS
        LAS float* scr = (LAS float*)(lds + wid * 16384);
#define XD(W_, gain_, out_, K_, N_, Nout_, map_, nb_, wst_, ost_) { constexpr int cnt_ = (nb_) * ((K_) / 64) * ((Nout_) / 32); \
            if (!found_) { if (r < cnt_) { dsel = thin::XDesc{(W_), (gain_), (bf16_t*)(out_), (K_), (N_), (Nout_), (map_), (nb_), XF8, (size_t)(wst_), (size_t)(ost_)}; found_ = true; } else r -= cnt_; } }
        auto pick = [&](int it_, thin::XDesc& dsel, int& r) { r = it_; bool found_ = false;
#define XF8 0
#pragma unroll
            for (int L = 0; L < NLAYER; ++L) {
                XD(ap->in[I_W_IN] + (size_t)L * DM * PROJW, ap->in[I_NORM_MIX] + L * DM, ws + W_IN + (size_t)L * PROJP * DM * 2, DM, PROJW, PROJP, thin::MAP_WIN, 1, 0, 0)
                XD(ap->in[I_WGLU] + (size_t)L * 256 * 512, nullptr, ws + W_GLU + (size_t)L * 512 * 256 * 2, 256, 512, 512, thin::MAP_GLU, 1, 0, 0)
                XD(ap->in[I_CWPW] + (size_t)L * 256 * 256, nullptr, ws + W_PW + (size_t)L * 256 * 256 * 2, 256, 256, 256, thin::MAP_ID, 1, 0, 0)
                if ((WOUT_F8 >> L) & 1) {
#undef XF8
#define XF8 1
                XD(ap->in[I_WOUT] + (size_t)L * DM * DM, ap->in[I_MIXNORM] + L * DM, ws + W_OUT + (size_t)L * DM * DM * 2, DM, DM, DM, thin::MAP_ID, 1, 0, 0)
#undef XF8
#define XF8 0
                } else {
                XD(ap->in[I_WOUT] + (size_t)L * DM * DM, ap->in[I_MIXNORM] + L * DM, ws + W_OUT + (size_t)L * DM * DM * 2, DM, DM, DM, thin::MAP_ID, 1, 0, 0)
                }
                XD(ap->in[I_XWQ] + (size_t)L * DM * XW, ap->in[I_NCROSS] + L * DM, ws + W_XQ + (size_t)L * XW * DM * 2, DM, XW, XW, thin::MAP_HEAD, 1, 0, 0)
                XD(ap->in[I_XWKV] + (size_t)L * DM * 2 * XW, ap->in[I_NMEM] + L * DM, ws + W_XKV + (size_t)L * 2 * XW * DM * 2, DM, 2 * XW, 2 * XW, thin::MAP_HEAD, 1, 0, 0)
                XD(ap->in[I_XWO] + (size_t)L * XW * DM, nullptr, ws + W_XO + (size_t)L * DM * XW * 2, XW, DM, DM, thin::MAP_ID, 1, 0, 0)
                XD(ap->in[I_CW1] + (size_t)L * 2 * 2048 * 64, nullptr, ws + W_C1 + (size_t)L * 2 * 64 * 2048 * 2, 2048, 64, 64, thin::MAP_ID, 2, 2048 * 64, 64 * 2048)
                XD(ap->in[I_CW2] + (size_t)L * 2 * 64 * 64, nullptr, ws + W_C2 + (size_t)L * 2 * 64 * 64 * 2, 64, 64, 64, thin::MAP_ID, 2, 64 * 64, 64 * 64)
            }
#undef XF8
#define XF8 1
            XD(ap->in[I_FUP], ap->in[I_NFFN], ws + W_UP, DM, 2 * DFF, 2 * DFF, thin::MAP_GLU, 1, 0, 0)
            XD(ap->in[I_FDN], nullptr, ws + W_DN, DFF, DM, DM, thin::MAP_ID, 1, 0, 0)
            XD(ap->in[I_MUP], ap->in[I_NFFN] + DM, ws + W_MUP, DM, 2 * DFF, 2 * DFF, thin::MAP_GLU, NEXP, (size_t)DM * 2 * DFF, (size_t)2 * DFF * DM)
            XD(ap->in[I_MDN], nullptr, ws + W_MDN, DFF, DM, DM, thin::MAP_ID, NEXP, (size_t)DFF * DM, (size_t)DM * DFF)
#undef XF8
        };
        for (int it = gw; it < XT_TOTAL; it += 2 * NGW) {
            thin::XDesc dA{}, dB{}; int rA, rB; const bool hasB = it + NGW < XT_TOTAL;
            pick(it, dA, rA); pick(hasB ? it + NGW : it, dB, rB);
            f32x4 vA[8], vB[8]; float gA[8], gB[8];
            thin::xload(dA, rA, vA, gA, lane); thin::xload(dB, rB, vB, gB, lane);
            thin::xstore(dA, rA, vA, gA, scr, lane);
            if (hasB) thin::xstore(dB, rB, vB, gB, scr, lane);
        }
#undef XD
        for (int repx = 0; repx < REP_X; ++repx) for (int r = 2 * gw; r < MTOK; r += 2 * NGW) thin::row2_to_bf16_ss(ap->in[I_X] + (size_t)r * DM, HB + (size_t)r * DM, SS + r, lane);
        for (int r = gw; r < MMEM; r += NGW) thin::row_to_bf16_ss(ap->in[I_MEM] + (size_t)r * DM, (bf16_t*)(ws + T_MEMB) + (size_t)r * DM, SSMEM + r, lane);
        for (int o = gw; o < 256; o += NGW) {
            const int lk = o >> 6, u = o & 63; const float* pe = ap->in[I_CPE] + (size_t)lk * 2048; const float* w1 = ap->in[I_CW1] + (size_t)lk * 2048 * 64; float a = 0.f;
#pragma unroll 1
            for (int k0 = 0; k0 < 2048; k0 += 1024) {
                float pv[16], wv[16];
#pragma unroll
                for (int i = 0; i < 16; ++i) { const int k = k0 + lane + 64 * i; pv[i] = pe[k]; wv[i] = w1[(size_t)k * 64 + u]; }
#pragma unroll
                for (int i = 0; i < 16; ++i) a += pv[i] * wv[i]; }
            a = wave_sum(a); if (lane == 0) ((float*)(ws + T_CB))[o] = a; }
        if (bid == 1 && tid < 64) {
            const int L = tid >> 5, br = (tid >> 3) & 3, h = tid & 7; float G = 0.f, bmax = 0.f;
            if (br < 3) { for (int d = 0; d < 64; ++d) G = fmaxf(G, fabsf(ap->in[I_QNORM][L * 64 + d] * ap->in[I_KNORM][L * 192 + br * 64 + d]));
                for (int d = 0; d <= 128; ++d) bmax = fmaxf(bmax, (ap->in[I_T5][thin::t5_bucket(d) * 8 + h] - ap->in[I_T5][31 * 8 + h]) * LOG2E); }
            else { for (int d = 0; d < 64; ++d) G = fmaxf(G, fabsf(ap->in[I_XQN][L * 64 + d] * ap->in[I_XKN][L * 64 + d])); }
            ((float*)(ws + T_BND))[tid] = QSCALE * 64.0f * G * 1.001f + bmax; }
        if (bid == 0) for (int i = tid; i < 8 * 132; i += NTHR) { const int h = i / 132, d = i % 132; ((float*)(ws + T_BIAS))[i] = (ap->in[I_T5][thin::t5_bucket(d < 128 ? d : 128) * 8 + h] - ap->in[I_T5][31 * 8 + h]) * LOG2E; }
        for (int repk = 0; repk < REP_KT; ++repk) for (int tk = gw; tk < 2 * 16 * 64; tk += NGW) { const int L = tk >> 10, g = (tk >> 6) & 15, tau = tk & 63;
            const thin::S5P P{ap->in[I_LRE] + L * 1024, ap->in[I_LIM] + L * 1024, ap->in[I_LDT] + L * 16, ap->in[I_BRE] + L * 16384, ap->in[I_BIM] + L * 16384, ap->in[I_CRE] + L * 16384, ap->in[I_CIM] + L * 16384, ap->in[I_DSK] + L * 256};
            thin::ktab_task(P, (float*)(ws + T_KTAB) + (size_t)L * 16 * 64 * 256, g, tau, scr, lane); }
        for (int i = bid * NTHR + tid; i < 2 * 1024; i += G * NTHR) { const int L = i >> 10, g = (i >> 6) & 15, p = i & 63;
            const thin::S5P P{ap->in[I_LRE] + L * 1024, ap->in[I_LIM] + L * 1024, ap->in[I_LDT] + L * 16, nullptr, nullptr, nullptr, nullptr, nullptr};
            float wr, wi; thin::lam_pow(P, g, p, 64.f, wr, wi); ((float*)(ws + T_A64))[i * 2] = wr; ((float*)(ws + T_A64))[i * 2 + 1] = wi; }
    }
    SEAM(0);
    if (IN(1) && PHON(101)) { PHASE_IDS
        for (int i0 = bid * NTHR + tid; i0 < 2 * 16 * 1024 * 128; i0 += 4 * G * NTHR) {
            f32x4 fa[4], fb[4];
#pragma unroll
            for (int q = 0; q < 4; ++q) { const int i = i0 + q * G * NTHR; fa[q] = (f32x4){0.f, 0.f, 0.f, 0.f}; fb[q] = fa[q];
                if (i < 2 * 16 * 1024 * 128) { const int k8 = i & 127, r = i >> 7, n = r & 1023, g = (r >> 10) & 15, L = r >> 14; thin::st_load8((const float*)(ws + T_KTAB) + (size_t)L * 16 * 64 * 256, g, n, 8 * k8, fa[q], fb[q]); } }
#pragma unroll
            for (int q = 0; q < 4; ++q) { const int i = i0 + q * G * NTHR;
                if (i < 2 * 16 * 1024 * 128) { const int k8 = i & 127, r = i >> 7, n = r & 1023, g = (r >> 10) & 15, L = r >> 14;
                    const thin::S5P P{nullptr, nullptr, nullptr, nullptr, nullptr, nullptr, nullptr, ap->in[I_DSK] + L * 256};
                    thin::st_store8(P, (bf16_t*)(ws + W_ST) + (size_t)L * 16 * 1024 * SKX, g, n, 8 * k8, fa[q], fb[q]); } } }
        for (int rep = 0; rep < REP_FILL; ++rep) for (int i = bid * NTHR + tid; i < 2 * 16 * 64 * 64; i += G * NTHR) { const int p = i & 63, to = (i >> 6) & 63, g = (i >> 12) & 15, L = i >> 16;
            const thin::S5P P{ap->in[I_LRE] + L * 1024, ap->in[I_LIM] + L * 1024, ap->in[I_LDT] + L * 16, nullptr, nullptr, ap->in[I_CRE] + L * 16384, ap->in[I_CIM] + L * 16384, nullptr};
            thin::st_carry(P, (bf16_t*)(ws + W_ST) + (size_t)L * 16 * 1024 * SKX, g, to, p); }
        for (int rep = 0; rep < REP_FILL; ++rep) for (long i = (long)bid * NTHR + tid; i < 2L * 16 * 256 * 128; i += (long)G * NTHR) { const int k8 = (int)(i & 127); const long r = i >> 7; const int n = (int)(r & 255), g = (int)((r >> 8) & 15), L = (int)(r >> 12);
            const thin::S5P P{ap->in[I_LRE] + L * 1024, ap->in[I_LIM] + L * 1024, ap->in[I_LDT] + L * 16, ap->in[I_BRE] + L * 16384, ap->in[I_BIM] + L * 16384, nullptr, nullptr, nullptr};
            thin::sz_fill8(P, (bf16_t*)(ws + W_SZ) + (size_t)L * 16 * 256 * 1024, g, n, 8 * k8); }
    }

    for (int layer = 0; layer < NLAYER; ++layer) {
        const int pb = 2 + layer * PH_PER_LAYER;
        if (hi <= pb || lo >= pb + PH_PER_LAYER) continue;
        if (IN(pb + 0) && PHON(0)) { PHASE_IDS
            pg8::TileOrder S; S.init(MTOK / 256, PROJP / 256, 1, G, bid, HB, (size_t)256 * DM * 2, 0, ws + W_IN + (size_t)layer * PROJP * DM * 2, (size_t)256 * DM * 2, 0);
            epi::EpiWin E{SS + (size_t)(3 * layer) * MTOK, UX, CVIN, Q, KC, VC, KS, KW, VST, VWT, GATE, ap->in[I_QNORM] + layer * 64, ap->in[I_KNORM] + layer * 192};
            for (int rep = 0; rep < REP_WIN; ++rep) pg8::gemm_phase<epi::EpiWin, pg8::TileOrder, true>(lds, pg8::Gemm{DM, DM, DM}, S, E, tid);
        }
        SEAM(pb + 0);
        if (IN(pb + 1) && PHON(1)) { PHASE_IDS
            { pg8::TileOrder S; S.init(4, 1, 16, G, bid, UX + 128, (size_t)256 * SKX * 2, (size_t)NCHUNK * SKX * 2, ws + W_SZ + (size_t)layer * 16 * 256 * 1024 * 2, (size_t)256 * 1024 * 2, (size_t)256 * 1024 * 2);
              epi::EpiS5State E{ZC};
              for (int rep = 0; rep < REP_GEMM; ++rep) pg8::gemm_phase<epi::EpiS5State, pg8::TileOrder, false>(lds, pg8::Gemm{1024, SKX, 1024}, S, E, tid); }
            if (layer == 0) {
              pg8::TileOrder S; S.init(8, 2, 2, G, (bid + G - 128 % G) % G, ws + T_MEMB, (size_t)256 * DM * 2, 0, ws + W_XKV, (size_t)256 * DM * 2, (size_t)512 * DM * 2);
              epi::EpiMemKV E{SSMEM, (bf16_t*)(ws + T_KM), (bf16_t*)(ws + T_VMT), ap->in[I_XKN]};
              pg8::gemm_phase<epi::EpiMemKV, pg8::TileOrder, false>(lds, pg8::Gemm{DM, DM, DM}, S, E, tid); }
            __syncthreads();
            for (int rep = 0; rep < REP_THIN; ++rep) for (int tk = (gw + NGW - 512 % NGW) % NGW; tk < 512; tk += NGW) { const int which = tk >> 8, plane = (tk >> 4) & 15, n0 = (tk & 15) * 32; const int lk = layer * 2 + which;
                att::compress_task(which, plane, n0, which ? VC : KC, (const bf16_t*)(ws + W_C1) + (size_t)lk * 64 * 2048, (const float*)(ws + T_CB) + lk * 64, (const bf16_t*)(ws + W_C2) + (size_t)lk * 64 * 64,
                                   ap->in[I_KNORM] + layer * 192, KCMP, VCMPT, lane); }
            { const int nu = MTOK / 64, rstat = (nu / G > 2) ? nu / G - 2 : 0;
              unsigned* ctr = (unsigned*)(ws + CTL_MOE + 524288) + layer * 64 + 32;
              volatile LAS unsigned* dq = (volatile LAS unsigned*)(lds + LDS_MISC + 128);
#pragma unroll 1
              for (int round = 0;; ++round) { int u;
                if (round < rstat) u = bid + round * G;
                else { __syncthreads(); if (tid == 0) *dq = (unsigned)(rstat * G) + __hip_atomic_fetch_add(ctr, 1u, __ATOMIC_RELAXED, __HIP_MEMORY_SCOPE_AGENT); __syncthreads(); u = (int)*dq; }
                if (u >= nu) break;
                thin::conv_unit(lds, u, CVIN, ap->in[I_CWDW] + layer * 31 * 256, ap->in[I_CBDW] + layer * 256, ap->in[I_CLNG] + layer * 256, ap->in[I_CLNB] + layer * 256, CV, tid); } }
        }
        SEAM(pb + 1);
        if (IN(pb + 2) && PHON(2)) { PHASE_IDS
            for (int rep = 0; rep < REP_THIN; ++rep) if (bid < 16) thin::s5_combine((const float*)(ws + T_A64) + layer * 2048, ZC, UX, bid * NTHR + tid);
            { pg8::TileOrder S; S.init(MTOK / 256, 1, 1, G, bid, CV, (size_t)256 * 256 * 2, 0, ws + W_PW + (size_t)layer * 256 * 256 * 2, (size_t)256 * 256 * 2, 0);
              epi::EpiPlain E{YCONV, 256};
              for (int rep = 0; rep < REP_GEMM; ++rep) pg8::gemm_phase<epi::EpiPlain, pg8::TileOrder, false>(lds, pg8::Gemm{256, 256, 256}, S, E, tid); }
            for (int i = tid; i < 8 * 132; i += NTHR) ((LAS float*)(lds + att::L_BIAS))[i] = ((const float*)(ws + T_BIAS))[i];
            att::build_ovt(lds, tid);
            __syncthreads();
            for (int rep = 0; rep < REP_CMP; ++rep) for (int u = bid; u < 2048; u += G) { const int c = 127 - (u >> 4), pl = u & 15; int lf_; asm volatile("v_mbcnt_lo_u32_b32 %0, -1, 0\n\tv_mbcnt_hi_u32_b32 %0, -1, %0" : "=v"(lf_)); att::cmp_unit(lds, pl >> 1, pl & 1, c, Q, KCMP, VCMPT, OC, SEL, (const float*)(ws + T_BND) + layer * 32 + 0, wid * 64 + lf_); }
            __syncthreads();
            att::fill_xt((LAS float*)(lds + att::L_IMP), (const LAS float*)(lds + att::L_BIAS), att::XT_WIN, 512, tid);
            __syncthreads();
            for (int rep = 0; rep < REP_ATT; ++rep) for (int u = bid; u < 2048; u += G) { const int c = 127 - (u >> 4), pl = u & 15; int lf_; asm volatile("v_mbcnt_lo_u32_b32 %0, -1, 0\n\tv_mbcnt_hi_u32_b32 %0, -1, %0" : "=v"(lf_)); att::window_unit(lds, pl >> 1, pl & 1, c, Q, KW, VWT, OW, (const float*)(ws + T_BND) + layer * 32 + 16, wid * 64 + lf_); }
        }
        SEAM(pb + 2);
        if (IN(pb + 3) && PHON(3)) { PHASE_IDS
            { pg8::TileOrder S; S.init(4, 4, 16, G, bid, UX, (size_t)256 * SKX * 2, (size_t)NCHUNK * SKX * 2, ws + W_ST + (size_t)layer * 16 * 1024 * SKX * 2, (size_t)256 * SKX * 2, (size_t)1024 * SKX * 2);
              epi::EpiS5Out E{YG};
              for (int rep = 0; rep < REP_GEMM; ++rep) pg8::gemm_phase<epi::EpiS5Out, pg8::TileOrder, false>(lds, pg8::Gemm{SKX, SKX, SKX}, S, E, tid); }
            __syncthreads();
            { float tbv[3];
#pragma unroll
              for (int q = 0; q < 3; ++q) { const int i = tid + 512 * q; tbv[q] = i < 8 * 132 ? ((const float*)(ws + T_BIAS))[i] : 0.f; }
#pragma unroll
              for (int q = 0; q < 3; ++q) { const int i = tid + 512 * q; if (i < 8 * 132) ((LAS float*)(lds + att::SP_BIAS))[i] = tbv[q]; } }
            __syncthreads();
            att::fill_xt((LAS float*)(lds + att::SP_END), (const LAS float*)(lds + att::SP_BIAS), att::XT_SEL, 1 << 30, tid);
            __syncthreads();
            { const int nstat = (2048 / G > TAIL_R) ? (2048 / G - TAIL_R) * G : 0;
              for (int u = bid; u < nstat; u += G) { const int c = 127 - (u >> 4), pl = u & 15; int lf_; asm volatile("v_mbcnt_lo_u32_b32 %0, -1, 0\n\tv_mbcnt_hi_u32_b32 %0, -1, %0" : "=v"(lf_));
                att::sel_sparse_unit(lds, pl >> 1, pl & 1, c, Q, KS, VST, SEL, OS, (const float*)(ws + T_BND) + layer * 32 + 8, wid * 64 + lf_); }
              unsigned* ctr = (unsigned*)(ws + CTL_MOE + 524288) + layer * 64;
              volatile LAS unsigned* dq = (volatile LAS unsigned*)(lds + LDS_MISC + 128);
              for (;;) {
                __syncthreads();
                if (tid == 0) *dq = (unsigned)nstat + __hip_atomic_fetch_add(ctr, 1u, __ATOMIC_RELAXED, __HIP_MEMORY_SCOPE_AGENT);
                __syncthreads();
                const int u = (int)*dq; if (u >= 2048) break;
                const int c = 127 - (u >> 4), pl = u & 15; int lf_; asm volatile("v_mbcnt_lo_u32_b32 %0, -1, 0\n\tv_mbcnt_hi_u32_b32 %0, -1, %0" : "=v"(lf_));
                att::sel_sparse_unit(lds, pl >> 1, pl & 1, c, Q, KS, VST, SEL, OS, (const float*)(ws + T_BND) + layer * 32 + 8, wid * 64 + lf_); } }
        }
        SEAM(pb + 3);
        if (IN(pb + 4) && PHON(4)) { PHASE_IDS
            pg8::TileOrder S; S.init(MTOK / 256, 2, 1, G, bid, YG, (size_t)256 * 256 * 2, 0, ws + W_GLU + (size_t)layer * 512 * 256 * 2, (size_t)256 * 256 * 2, 0);
            epi::EpiGate<0> E{YSSM, 256, nullptr, nullptr};
            for (int rep = 0; rep < REP_GEMM; ++rep) pg8::gemm_phase<epi::EpiGate<0>, pg8::TileOrder, true>(lds, pg8::Gemm{256, 256, 256}, S, E, tid);
        }
        SEAM(pb + 4);
        if (IN(pb + 5) && PHON(5)) { PHASE_IDS if ((WOUT_F8 >> layer) & 1) { for (int r = 2 * gw; r < MTOK; r += 2 * NGW) thin::mixnorm_row2<true>(r, YSSM, YCONV, OC, OS, OW, GATE, AMIX, lane); }
            else for (int rep = 0; rep < REP_MIX; ++rep) for (int r = 2 * gw; r < MTOK; r += 2 * NGW) thin::mixnorm_row2<false>(r, YSSM, YCONV, OC, OS, OW, GATE, AMIX, lane); }
        SEAM(pb + 5);
        if (IN(pb + 6) && PHON(6)) { PHASE_IDS
            if ((WOUT_F8 >> layer) & 1) {
            pg8::TileOrder S; S.init(MTOK / 256, 4, 1, G, bid, AMIX, (size_t)256 * DM, 0, ws + W_OUT + (size_t)layer * DM * DM * 2, (size_t)256 * DM, 0);
            epi::EpiRes<false, true> E{HB, nullptr, HB, SS + (size_t)(3 * layer + 1) * MTOK, nullptr, nullptr, 1.0f / W8_SCALE, nullptr};
            pg8::gemm_phase<epi::EpiRes<false, true>, pg8::TileOrder, true, true>(lds, pg8::Gemm{DM / 2, DM / 2, DM / 2}, S, E, tid);
            } else {
            pg8::TileOrder S; S.init(MTOK / 256, 4, 1, G, bid, AMIX, (size_t)256 * DM * 2, 0, ws + W_OUT + (size_t)layer * DM * DM * 2, (size_t)256 * DM * 2, 0);
            epi::EpiRes<false, true> E{HB, nullptr, HB, SS + (size_t)(3 * layer + 1) * MTOK, nullptr, nullptr, 1.f, nullptr};
            pg8::gemm_phase<epi::EpiRes<false, true>, pg8::TileOrder, true>(lds, pg8::Gemm{DM, DM, DM}, S, E, tid);
            }
        }
        SEAM(pb + 6);
        if (IN(pb + 7) && PHON(7)) { PHASE_IDS
            pg8::TileOrder S; S.init(MTOK / 256, 1, 1, G, bid, HB, (size_t)256 * DM * 2, 0, ws + W_XQ + (size_t)layer * XW * DM * 2, (size_t)256 * DM * 2, 0);
            epi::EpiXQ E{SS + (size_t)(3 * layer + 1) * MTOK, QX, ap->in[I_XQN] + layer * 64};
            for (int rep = 0; rep < REP_GEMM; ++rep) pg8::gemm_phase<epi::EpiXQ, pg8::TileOrder, false>(lds, pg8::Gemm{DM, DM, DM}, S, E, tid);
        }
        SEAM(pb + 7);
        if (IN(pb + 8) && PHON(8)) { PHASE_IDS
            __syncthreads();
            for (int rep = 0; rep < REP_ATT; ++rep) for (int u = bid; u < 1024; u += G) { const int qt = u & 31, h = (u >> 5) & 3, b = u >> 7;
                att::cross_unit(lds, b, h, qt, QX, (const bf16_t*)(ws + T_KM) + (size_t)layer * 8 * 4 * 256 * 64, (const bf16_t*)(ws + T_VMT) + (size_t)layer * 8 * 4 * 64 * 256, OX, (const float*)(ws + T_BND) + layer * 32 + 24, tid); }
        }
        SEAM(pb + 8);
        if (IN(pb + 9) && PHON(9)) { PHASE_IDS
            pg8::TileOrder S; S.init(MTOK / 256, 4, 1, G, bid, OX, (size_t)256 * XW * 2, 0, ws + W_XO + (size_t)layer * DM * XW * 2, (size_t)256 * XW * 2, 0);
            epi::EpiRes<false, true> E{HB, nullptr, HB, SS + (size_t)(3 * layer + 2) * MTOK, nullptr, nullptr, 1.f, ws + A_H8};
            pg8::gemm_phase<epi::EpiRes<false, true>, pg8::TileOrder, true>(lds, pg8::Gemm{XW, XW, XW}, S, E, tid);
        }
        SEAM(pb + 9);
        if (layer == 0) {
            if (IN(pb + 10) && PHON(10)) { PHASE_IDS
                pg8::TileOrder S; S.init(MTOK / 256, 2 * DFF / 256, 1, G, bid, ws + A_H8, (size_t)256 * DM, 0, ws + W_UP, (size_t)256 * DM, 0);
                epi::EpiGate<1, true> E{FFA, DFF, SS + (size_t)2 * MTOK, nullptr};
                pg8::gemm_phase<epi::EpiGate<1, true>, pg8::TileOrder, true, true>(lds, pg8::Gemm{DM / 2, DM / 2, DM / 2}, S, E, tid);
            }
            SEAM(pb + 10);
            if (IN(pb + 11) && PHON(11)) { PHASE_IDS
                pg8::TileOrder S; S.init(MTOK / 256, 4, 1, G, bid, FFA, (size_t)256 * DFF, 0, ws + W_DN, (size_t)256 * DFF, 0);
                epi::EpiRes<false, true> E{HB, nullptr, HB, SS + (size_t)3 * MTOK, nullptr, nullptr, 1.0f / W8_SCALE, nullptr};
                pg8::gemm_phase<epi::EpiRes<false, true>, pg8::TileOrder, true, true>(lds, pg8::Gemm{DFF / 2, DFF / 2, DFF / 2}, S, E, tid);
            }
            if (IN(pb + 11) && IN(pb + PH_PER_LAYER)) xcd_barrier(bar);
        } else {
#define MK_ROUTE int* mi = (int*)(ws + T_ROUTE); const moe::Route R{(int*)(ws + CTL_MOE), (int*)(ws + CTL_MOE + 65536), mi, mi + 2 * MTOK, (float*)(mi + 4 * MTOK), mi + 6 * MTOK, (float*)(mi + 6 * MTOK + 2 * MOEROWS)};
            if (IN(pb + 10) && PHON(10)) { PHASE_IDS MK_ROUTE
                __syncthreads();
                moe::load_router(lds, ap->in[I_ROUTER], ap->in[I_NFFN] + DM, tid);
                __syncthreads();
                for (int rep = 0; rep < REP_THIN; ++rep) for (int ch = bid; ch < moe::NCHK; ch += G) moe::route1_chunk(lds, ch, HB, SS + (size_t)5 * MTOK, R, tid);
            }
            SEAM(pb + 10);
            if (IN(pb + 11) && PHON(11)) { PHASE_IDS MK_ROUTE for (int rep = 0; rep < REP_THIN; ++rep) moe::route2(lds, R, G, tid); }
            SEAM(pb + 11);
            if (IN(pb + 12) && PHON(12)) { PHASE_IDS MK_ROUTE for (int rep = 0; rep < REP_GA; ++rep) moe::gather_rows(R, 0, ws + A_H8, ws + A_XB, gw, NGW, lane); }
            SEAM(pb + 12);
#pragma unroll 1
            for (int s = 0; s < 2; ++s) {
                if (IN(pb + 13 + 2 * s) && PHON(13)) { PHASE_IDS MK_ROUTE
                    moe::MoeOrder S; S.init(R.startp + s * 16, 2 * DFF / 256, G, bid, XB, (size_t)256 * DM, ws + W_MUP, (size_t)256 * DM, (size_t)2 * DFF * DM);
                    epi::EpiGate<2, true> E{FFA, DFF, SS + (size_t)5 * MTOK, R.row_tok + (size_t)s * MOEROWS};
                    pg8::gemm_phase<epi::EpiGate<2, true>, moe::MoeOrder, true, true>(lds, pg8::Gemm{DM / 2, DM / 2, DM / 2}, S, E, tid);
                }
                SEAM(pb + 13 + 2 * s);
                if (IN(pb + 14 + 2 * s) && PHON(14)) { PHASE_IDS MK_ROUTE
                    moe::MoeOrder S; S.init(R.startp + s * 16, 4, G, bid, FFA, (size_t)256 * DFF, ws + W_MDN, (size_t)256 * DFF, (size_t)DM * DFF);
                    epi::EpiRes<true, false> E{HB, s == 1 ? out : nullptr, s == 0 ? HB : nullptr, nullptr, R.row_tok + (size_t)s * MOEROWS, R.row_gate + (size_t)s * MOEROWS, 1.0f / W8_SCALE, nullptr};
                    pg8::gemm_phase<epi::EpiRes<true, false>, moe::MoeOrder, true, true>(lds, pg8::Gemm{DFF / 2, DFF / 2, DFF / 2}, S, E, tid);
                    if (s == 0) for (int rep = 0; rep < REP_GA; ++rep) moe::gather_rows(R, 1, ws + A_H8, ws + A_XB, gw, NGW, lane);
                }
                if (s == 0) SEAM(pb + 14);
            }
        }
    }
#undef IN
#undef SEAM
}

extern "C" void kernel_launch(void* const* d_in, const int* in_sizes, int n_in, void* d_out, int out_size, void* d_ws, size_t ws_size, hipStream_t stream) {
    static int grid = 0;
    if (grid == 0) {
        if (n_in != N_IN || in_sizes[0] != MTOK * DM || out_size != MTOK * DM || ws_size < WS_END) {
            fprintf(stderr, "kernel_launch: built for %d inputs, x/out of %d floats and >= %zu bytes of workspace; got n_in %d, in0 %d, out %d, ws %zu; nothing launched\n", N_IN, MTOK * DM, (size_t)WS_END, n_in, n_in > 0 ? in_sizes[0] : -1, out_size, ws_size);
            grid = -1; return; }
        int dev = 0, cus = 0, per_cu = 0;
        if (hipGetDevice(&dev) != hipSuccess || hipDeviceGetAttribute(&cus, hipDeviceAttributeMultiprocessorCount, dev) != hipSuccess) { grid = -1; return; }
        if (hipFuncSetAttribute((const void*)trunk_fwd, hipFuncAttributeMaxDynamicSharedMemorySize, LDS_BYTES) != hipSuccess) { fprintf(stderr, "kernel_launch: hipFuncSetAttribute failed\n"); grid = -1; return; }
        if (hipOccupancyMaxActiveBlocksPerMultiprocessor(&per_cu, (const void*)trunk_fwd, NTHR, LDS_BYTES) != hipSuccess || per_cu < 1) { fprintf(stderr, "kernel_launch: occupancy query says %d workgroups per CU\n", per_cu); (void)hipGetLastError(); grid = -1; return; }
        grid = cus;
        if (grid > 256) grid = 256;
    }
    if (grid < 0) return;
    unsigned char* ws = (unsigned char*)d_ws;
    (void)hipMemsetAsync(ws + WS_CTL, 0, CTL_ZERO_BYTES, stream);
    Args a{};
    for (int i = 0; i < N_IN; ++i) a.in[i] = (const float*)d_in[i];
    a.out = (float*)d_out; a.ws = ws;
#if MK_N_LAUNCHES == 1
    a.ph_lo = 0; a.ph_hi = N_PHASES;
    hipLaunchKernelGGL(trunk_fwd, dim3(grid), dim3(NTHR), LDS_BYTES, stream, a);
#else
    for (int p = 0; p < N_PHASES; ++p) {
        if (p >= 2 && p < 2 + PH_PER_LAYER && (p - 2) >= 12) continue;
        a.ph_lo = p; a.ph_hi = p + 1;
        hipLaunchKernelGGL(trunk_fwd, dim3(grid), dim3(NTHR), LDS_BYTES, stream, a);
    }
#endif
    const hipError_t le = hipPeekAtLastError();
    if (le != hipSuccess) fprintf(stderr, "kernel_launch: launch failed: %s (grid %d x %d threads, %d B LDS)\n", hipGetErrorName(le), grid, NTHR, LDS_BYTES);
}
```

```cpp
#include <hip/hip_runtime.h>
#include <cstdio>
#include <cstdint>
#include <cmath>

#define LAS __attribute__((address_space(3)))
#define GAS __attribute__((address_space(1)))
#define DI __device__ __forceinline__
typedef unsigned short bf16_t;
typedef short bf16x8 __attribute__((ext_vector_type(8)));
typedef float f32x2 __attribute__((ext_vector_type(2)));
typedef float f32x4 __attribute__((ext_vector_type(4)));
typedef float f32x16 __attribute__((ext_vector_type(16)));
typedef unsigned u32x2 __attribute__((ext_vector_type(2)));
typedef unsigned u32x4 __attribute__((ext_vector_type(4)));
typedef __bf16 bf16x2_t __attribute__((ext_vector_type(2)));
typedef unsigned long long u64;

#ifndef WOUT_F8
#define WOUT_F8 2
#endif
constexpr int NB = 8, SEQ = 8192, DM = 1024, MTOK = NB * SEQ;
constexpr int MEMLEN = 256, MMEM = NB * MEMLEN;
constexpr int NLAYER = 2;
constexpr int SSMW = 256, SSMG = 16, SSMH = 16, SSMP = 64;
constexpr int CHL = 64, NCHUNK = MTOK / CHL;
constexpr int SKX = CHL * SSMH + 2 * SSMP;
constexpr int CONVW = 256, CONVK = 31;
constexpr int NSAW = 512, NQH = 8, NKVH = 2, HD = 64;
constexpr int NCMP = 511, NCMPP = 512, NSEL = 128;
constexpr int PROJW = 2072, PROJP = 2304;
constexpr int XW = 256, DFF = 2816, NEXP = 8;
constexpr int MOEROWS = MTOK + NEXP * 256;
constexpr float EPS = 1e-6f;
constexpr float LOG2E = 1.4426950408889634f;
constexpr float QSCALE = 0.125f * LOG2E;
constexpr float SS_FIX = 16777216.0f;

constexpr size_t MiB = 1u << 20;
constexpr size_t WS_CTL = 0, CTL_ZERO_BYTES = 8 * MiB;
constexpr size_t CTL_BAR = 64 * 1024;
constexpr size_t CTL_SS = 1 * MiB;
constexpr size_t CTL_SSMEM = 5 * MiB;
constexpr size_t CTL_MOE = 6 * MiB;
constexpr size_t WS_W = 8 * MiB;
constexpr size_t W_IN = WS_W;
constexpr size_t W_GLU = W_IN + (size_t)NLAYER * PROJP * DM * 2;
constexpr size_t W_PW = W_GLU + (size_t)NLAYER * 512 * 256 * 2;
constexpr size_t W_OUT = W_PW + (size_t)NLAYER * 256 * 256 * 2;
constexpr size_t W_XQ = W_OUT + (size_t)NLAYER * DM * DM * 2;
constexpr size_t W_XKV = W_XQ + (size_t)NLAYER * XW * DM * 2;
constexpr size_t W_XO = W_XKV + (size_t)NLAYER * 2 * XW * DM * 2;
constexpr size_t W_UP = W_XO + (size_t)NLAYER * DM * XW * 2;
constexpr size_t W_DN = W_UP + (size_t)2 * DFF * DM * 2;
constexpr size_t W_MUP = W_DN + (size_t)DM * DFF * 2;
constexpr size_t W_MDN = W_MUP + (size_t)NEXP * 2 * DFF * DM * 2;
constexpr size_t W_ST = W_MDN + (size_t)NEXP * DM * DFF * 2;
constexpr size_t W_SZ = W_ST + (size_t)NLAYER * SSMG * 1024 * SKX * 2;
constexpr size_t W_C1 = W_SZ + (size_t)NLAYER * SSMG * 256 * 1024 * 2;
constexpr size_t W_C2 = W_C1 + (size_t)NLAYER * 2 * 64 * 2048 * 2;
constexpr size_t W_END = W_C2 + (size_t)NLAYER * 2 * 64 * 64 * 2;
constexpr size_t WS_TAB = (W_END + MiB - 1) / MiB * MiB;
constexpr size_t T_KTAB = WS_TAB;
constexpr size_t T_CB = T_KTAB + 2 * MiB;
constexpr size_t T_BIAS = T_CB + 4096;
constexpr size_t T_BND = T_BIAS + 6144;
constexpr size_t T_A64 = T_BIAS + 8192;
constexpr size_t T_KM = T_A64 + 32768;
constexpr size_t T_VMT = T_KM + 2 * MiB;
constexpr size_t T_MEMB = T_VMT + 2 * MiB;
constexpr size_t T_ROUTE = T_MEMB + 4 * MiB;
constexpr size_t T_END = T_ROUTE + 4 * MiB;
constexpr size_t WS_HB = (T_END + MiB - 1) / MiB * MiB;
constexpr size_t WS_ACT = WS_HB + (size_t)MTOK * DM * 2;
constexpr size_t A_UX = WS_ACT;
constexpr size_t A_CVIN = A_UX + (size_t)SSMG * NCHUNK * SKX * 2;
constexpr size_t A_Q = A_CVIN + (size_t)MTOK * 256 * 2;
constexpr size_t A_KC = A_Q + (size_t)MTOK * 512 * 2;
constexpr size_t A_VC = A_KC + (size_t)MTOK * 128 * 2 + 4096;
constexpr size_t A_KS = A_VC + (size_t)MTOK * 128 * 2 + 4096;
constexpr size_t A_KW = A_KS + (size_t)MTOK * 128 * 2;
constexpr size_t A_VST = A_KW + (size_t)MTOK * 128 * 2;
constexpr size_t A_VWT = A_VST + (size_t)MTOK * 128 * 2;
constexpr size_t A_GATE = A_VWT + (size_t)MTOK * 128 * 2;
constexpr size_t A_OC = A_GATE + (size_t)MTOK * 24 * 4;
constexpr size_t A_OS = A_OC + (size_t)MTOK * 512 * 2;
constexpr size_t A_OW = A_OS + (size_t)MTOK * 512 * 2;
constexpr size_t A_ZC = A_OW + (size_t)MTOK * 512 * 2;
constexpr size_t A_YG = A_ZC + (size_t)SSMG * NCHUNK * 128 * 4;
constexpr size_t A_YSSM = A_YG + (size_t)MTOK * 256 * 2;
constexpr size_t A_CV = A_YSSM + (size_t)MTOK * 256 * 2;
constexpr size_t A_YCONV = A_CV + (size_t)MTOK * 256 * 2;
constexpr size_t A_KCMP = A_YCONV + (size_t)MTOK * 256 * 2;
constexpr size_t A_VCMPT = A_KCMP + 1 * MiB;
constexpr size_t A_SEL = A_VCMPT + 1 * MiB;
constexpr size_t A_MIXEND = A_SEL + 2 * MiB;
constexpr size_t A_AMIX = A_Q;
static_assert(A_AMIX + (size_t)MTOK * DM * 2 <= A_VST, "AMIX overlay");
constexpr size_t A_QX = WS_ACT;
constexpr size_t A_OX = A_QX + (size_t)MTOK * 256 * 2;
constexpr size_t A_FFA = A_OX + (size_t)MTOK * 256 * 2;
constexpr size_t A_XB = A_FFA + (size_t)MOEROWS * DFF;
constexpr size_t A_H8 = A_XB + (size_t)MOEROWS * DM;
constexpr size_t A_FFEND = A_H8 + (size_t)MTOK * DM;
constexpr size_t WS_END = (A_MIXEND > A_FFEND ? A_MIXEND : A_FFEND);
static_assert(WS_END <= (size_t)1024 * MiB, "d_ws map must fit 1 GiB");

DI unsigned cvtpk(float lo, float hi) { f32x2 v = {lo, hi}; bf16x2_t b = __builtin_convertvector(v, bf16x2_t); return __builtin_bit_cast(unsigned, b); }
DI bf16_t f2bf(float f) { return (bf16_t)(cvtpk(f, 0.f) & 0xffffu); }
DI float bf2f(bf16_t h) { return __uint_as_float((unsigned)h << 16); }
DI float bflo(unsigned w) { return __uint_as_float(w << 16); }
DI float bfhi(unsigned w) { return __uint_as_float(w & 0xffff0000u); }
#define DPPF(v, ctrl) __builtin_bit_cast(float, __builtin_amdgcn_mov_dpp(__builtin_bit_cast(int, (v)), (ctrl), 0xF, 0xF, true))
DI float dpp_sum16(float v) {
    v += DPPF(v, 0xB1); v += DPPF(v, 0x4E); v += DPPF(v, 0x141); v += DPPF(v, 0x140); return v;
}
DI float wave_sum(float v) { v = dpp_sum16(v); v += __shfl_xor(v, 16); v += __shfl_xor(v, 32); return v; }
DI float rcpf_(float x) { return __builtin_amdgcn_rcpf(x); }
DI float gelu_tanh(float x) { const float u = 0.7978845608028654f * (x + 0.044715f * x * x * x); const float e = __expf(-2.f * u); return x * rcpf_(1.f + e); }
DI float sigmoidf_(float x) { return rcpf_(1.f + __expf(-x)); }
DI float siluf_(float x) { return x * rcpf_(1.f + __expf(-x)); }
constexpr float W8_SCALE = 32.0f;
typedef int v8i_t __attribute__((ext_vector_type(8)));
DI unsigned pack_fp8x4(float a, float b, float c, float d) { unsigned w = 0u; w = __builtin_amdgcn_cvt_pk_fp8_f32(a, b, w, false); w = __builtin_amdgcn_cvt_pk_fp8_f32(c, d, w, true); return w; }
DI int perm_kv(int s) { return (s & ~12) | ((s & 4) << 1) | ((s & 8) >> 1); }
#define LDS_WAIT() asm volatile("s_waitcnt lgkmcnt(0)" ::: "memory")
#define VM_WAIT() asm volatile("s_waitcnt vmcnt(0)" ::: "memory")
#define XB_TMO      128
#define XB_XCNT(j)  (256  + 64 * (j))
#define XB_XSUB(j)  (1280 + 64 * (j))
#define XB_XGEN(j)  (2304 + 64 * (j))
#define XB_TOP      3328
#define XB_TOPGEN   3392
#define XCD_BAR_WORDS 3456
#define XB_SPIN_CAP (1u << 18)

__device__ __forceinline__ unsigned xb_ld(unsigned* p)              { return __hip_atomic_load(p, __ATOMIC_RELAXED, __HIP_MEMORY_SCOPE_AGENT); }
__device__ __forceinline__ unsigned xb_add(unsigned* p, unsigned v) { return __hip_atomic_fetch_add(p, v, __ATOMIC_RELAXED, __HIP_MEMORY_SCOPE_AGENT); }
__device__ __forceinline__ unsigned xb_xcc_id() { return (unsigned)__builtin_amdgcn_s_getreg((3 << 11) | 20) & 0xFu; }
#define XB_SPIN(cond, bar) do { unsigned _sp = 0; while (cond) { __builtin_amdgcn_s_sleep(1); \
    if ((++_sp & 255u) == 0u) { if (xb_ld(&(bar)[XB_TMO])) break; if (_sp > XB_SPIN_CAP) { atomicAdd(&(bar)[XB_TMO], 1u); break; } } } } while (0)

struct XcdBarrier {
    unsigned* bar; unsigned x;
    volatile LAS unsigned* st;
};

__device__ __forceinline__ XcdBarrier xcd_barrier_post(unsigned* bar, volatile LAS unsigned* st) {
    XcdBarrier b; b.bar = bar; b.x = xb_xcc_id(); b.st = st;
    if (threadIdx.x == 0) (void)xb_add(&bar[XB_XCNT(b.x)], 1u);
    return b;
}
__device__ __forceinline__ void xcd_barrier_complete(unsigned* bar, unsigned x, unsigned& nloc, unsigned& nx) {
    const unsigned G = gridDim.x * gridDim.y * gridDim.z;
    unsigned sum, cnt, mine, sp = 0u;
    for (;;) {
        sum = 0u; cnt = 0u; mine = 0u;
#pragma unroll
        for (unsigned j = 0; j < 16; ++j) { const unsigned c = xb_ld(&bar[XB_XCNT(j)]); sum += c; cnt += (c > 0u) ? 1u : 0u; mine = (j == x) ? c : mine; }
        if (sum == G) break;
        __builtin_amdgcn_s_sleep(1);
        if ((++sp & 255u) == 0u) { if (xb_ld(&bar[XB_TMO])) break; if (sp > XB_SPIN_CAP) { atomicAdd(&bar[XB_TMO], 1u); break; } }
    }
    nloc = mine > 0u ? mine : 1u; nx = cnt > 0u ? cnt : 1u;
}

__device__ __forceinline__ void xcd_barrier(const XcdBarrier& b) {
    asm volatile("s_waitcnt vmcnt(0)" ::: "memory");
    __syncthreads();
    if (threadIdx.x == 0) {
        unsigned* bar = b.bar;
        __builtin_amdgcn_s_waitcnt(0);
        unsigned nloc = b.st[0], nx = b.st[1];
        if (nloc == 0u) { xcd_barrier_complete(bar, b.x, nloc, nx); b.st[0] = nloc; b.st[1] = nx; }
        const unsigned old = xb_add(&bar[XB_XSUB(b.x)], 1u);
        const unsigned gen = old / nloc;
        if (old + 1u == (gen + 1u) * nloc) {
            __builtin_amdgcn_fence(__ATOMIC_RELEASE, "agent");
            asm volatile("s_waitcnt vmcnt(0)" ::: "memory");
            const unsigned og = xb_add(&bar[XB_TOP], 1u);
            const unsigned tg = og / nx;
            if (og + 1u == (tg + 1u) * nx) xb_add(&bar[XB_TOPGEN], 1u);
            else XB_SPIN(xb_ld(&bar[XB_TOPGEN]) == tg, bar);
            __builtin_amdgcn_fence(__ATOMIC_ACQUIRE, "agent");
            xb_add(&bar[XB_XGEN(b.x)], 1u);
            asm volatile("s_waitcnt vmcnt(0)" ::: "memory");
        } else {
            XB_SPIN(xb_ld(&bar[XB_XGEN(b.x)]) == gen, bar);
            __builtin_amdgcn_fence(__ATOMIC_ACQUIRE, "agent");
            asm volatile("s_waitcnt vmcnt(0)" ::: "memory");
        }
    }
    __syncthreads();
}
namespace pg8 {
constexpr int BM = 256, BK = 64, HALF = 128, HTB = HALF * BK * 2  , STAGE_BYTES = 8 * HTB, NXCD = 8, WGM = 8;

DI int lds_byte(int r, int c) { const int st = (r >> 4) * 2 + (c >> 5), rr = r & 15, cc = c & 31, ob = rr * 64 + cc * 2; return st * 1024 + (ob ^ (((ob >> 9) & 1) << 5)); }
DI void stage_rc(int b, int& R, int& C) { const int st = b / 1024, sb = b % 1024, swz = sb ^ (((sb >> 9) & 1) << 5); R = (st >> 1) * 16 + swz / 64; C = (st & 1) * 32 + (swz % 64) / 2; }
DI int perm32(int rho) { const int n = rho >> 4, i = rho & 15; return 8 * (i >> 2) + 4 * n + (i & 3); }

struct Unit { int pm, pn, g; const char* A; const char* B; };
template <class T, class = void> struct KSkipOf { static constexpr bool v = false; };
template <class T> struct KSkipOf<T, decltype((void)&T::ktiles)> { static constexpr bool v = true; };
struct Gemm { int K, lda, ldb; };

struct TileOrder {
    int nM, nN, ngrp, nwg, G, c; const char* A; const char* B; size_t tA, tB, gA, gB;
    DI void init(int nM_, int nN_, int ngrp_, int G_, int c_, const void* A_, size_t tA_, size_t gA_, const void* B_, size_t tB_, size_t gB_) {
        nM = nM_; nN = nN_; ngrp = ngrp_; nwg = nM * nN; G = G_; c = c_; A = (const char*)A_; B = (const char*)B_; tA = tA_; tB = tB_; gA = gA_; gB = gB_; }
    DI bool next(int i, Unit& u) const {
        const long L = (long)i * G + c; if (L >= (long)nwg * ngrp) return false;
        const int grp = (int)(L / nwg); int wgid = (int)(L % nwg);
        if ((nwg % NXCD) == 0 && (G % NXCD) == 0) { const int q = nwg / NXCD, xcd = wgid % NXCD, off = wgid / NXCD; wgid = xcd * q + off; }
        const int nig = WGM * nN, gid = wgid / nig, fm = gid * WGM, gsz = (nM - fm) < WGM ? (nM - fm) : WGM;
        u.pm = fm + ((wgid % nig) % gsz); u.pn = (wgid % nig) / gsz; u.g = grp;
        u.A = A + (size_t)grp * gA + (size_t)u.pm * tA; u.B = B + (size_t)grp * gB + (size_t)u.pn * tB; return true;
    }
};

template <class Epi, class Sched, bool ALIGN_EPI, bool F8 = false>
DI void gemm_phase(LAS unsigned char* lds, const Gemm g, const Sched& S, const Epi& E, const int tid) {
    const int wid = __builtin_amdgcn_readfirstlane(tid >> 6), lane = tid & 63, wr = wid >> 2, wc = wid & 3, fr = lane & 15, fq = lane >> 4;
    const int K = g.K, nt = K / BK;
    unsigned voffA[2], voffB[2];
#pragma unroll
    for (int i = 0; i < 2; ++i) { int R, C; stage_rc(tid * 16 + i * 8192, R, C); const int Rb = Epi::PERM ? ((R & ~31) + perm32(R & 31)) : R;
        voffA[i] = (unsigned)(R * g.lda + C) * 2u; voffB[i] = (unsigned)(Rb * g.ldb + C) * 2u; }
    const size_t kstep = (size_t)(BK * 2);
    const size_t hstepA = (size_t)HALF * g.lda * 2, hstepB = (size_t)HALF * g.ldb * 2;
    const unsigned ldsw = (unsigned)wid * 1024u;
    const int aoff = lds_byte(wr * 64 + fr, fq * 8), boff = lds_byte(wc * 32 + fr, fq * 8);
#define PG8_SA(b, h) (((b) * 2 + (h)) * HTB)
#define PG8_SB(b, h) ((4 + (b) * 2 + (h)) * HTB)
#define PG8_STAGE(bufoff, gbase, voff) do { _Pragma("unroll") for (int _i = 0; _i < 2; ++_i) \
        __builtin_amdgcn_global_load_lds((const unsigned*)((const char*)(gbase) + (voff)[_i]), (LAS unsigned*)(lds + (bufoff) + ldsw + _i * 8192), 16, 0, 0); } while (0)
#define PG8_LD8(addr) __builtin_bit_cast(v8i_t, __builtin_shufflevector(*(const LAS u32x4*)(addr), *(const LAS u32x4*)((addr) + 1024), 0, 1, 2, 3, 4, 5, 6, 7))
#define PG8_LDA(dst, b, h) do { _Pragma("unroll") for (int m = 0; m < 4; ++m) { if constexpr (F8) dst##8[m] = PG8_LD8(lds + PG8_SA(b, h) + aoff + m * 2048); \
        else { _Pragma("unroll") for (int k = 0; k < 2; ++k) dst[m][k] = *(const LAS bf16x8*)(lds + PG8_SA(b, h) + aoff + m * 2048 + k * 1024); } } } while (0)
#define PG8_LDB(dst, b, h) do { _Pragma("unroll") for (int n = 0; n < 2; ++n) { if constexpr (F8) dst##8[n] = PG8_LD8(lds + PG8_SB(b, h) + boff + n * 2048); \
        else { _Pragma("unroll") for (int k = 0; k < 2; ++k) dst[n][k] = *(const LAS bf16x8*)(lds + PG8_SB(b, h) + boff + n * 2048 + k * 1024); } } } while (0)
#define PG8_MMA(ai, bj, At, Bt) do { __builtin_amdgcn_s_setprio(1); _Pragma("unroll") for (int m = 0; m < 4; ++m) _Pragma("unroll") for (int n = 0; n < 2; ++n) { \
        if constexpr (F8) asm volatile("v_mfma_scale_f32_16x16x128_f8f6f4 %0, %1, %2, %0, %3, %3 op_sel_hi:[0,0,0]" : "+v"(acc[ai][bj][m][n]) : "v"(Bt##8[n]), "v"(At##8[m]), "v"(sc8)); \
        else { _Pragma("unroll") for (int k = 0; k < 2; ++k) acc[ai][bj][m][n] = __builtin_amdgcn_mfma_f32_16x16x32_bf16(Bt[n][k], At[m][k], acc[ai][bj][m][n], 0, 0, 0); } } \
        __builtin_amdgcn_s_setprio(0); } while (0)
#define PG8_WAIT_V(n) asm volatile("s_waitcnt vmcnt(" #n ")" ::: "memory")
#define PG8_WAIT_L(n) asm volatile("s_waitcnt lgkmcnt(" #n ")" ::: "memory")
#define PG8_BAR __builtin_amdgcn_s_barrier()
#define PG8_SCHED __builtin_amdgcn_sched_barrier(0)
    unsigned sc8 = 0x7F7F7F7Fu; asm volatile("" : "+v"(sc8));
    Unit cur, nxt; int ui = 0;
    if (!S.next(0, cur)) return;
    f32x4 acc[2][2][4][2];
#pragma unroll
    for (int a = 0; a < 2; ++a)
#pragma unroll
        for (int b = 0; b < 2; ++b)
#pragma unroll
            for (int m = 0; m < 4; ++m)
#pragma unroll
                for (int n = 0; n < 2; ++n) acc[a][b][m][n] = (f32x4){0.f, 0.f, 0.f, 0.f};
    bf16x8 At[F8 ? 1 : 4][2], B0[2][2], B1[2][2]; v8i_t At8[F8 ? 4 : 1], B08[2], B18[2];
    const char* cA = cur.A; const char* cB = cur.B;
    PG8_STAGE(PG8_SB(0, 0), cB, voffB); PG8_STAGE(PG8_SB(0, 1), cB + hstepB, voffB); PG8_STAGE(PG8_SA(0, 0), cA, voffA); PG8_STAGE(PG8_SA(0, 1), cA + hstepA, voffA);
    if (wr == 1) PG8_BAR;
    PG8_WAIT_V(2); PG8_BAR;
    PG8_STAGE(PG8_SB(1, 0), cB + kstep, voffB); PG8_STAGE(PG8_SA(1, 0), cA + kstep, voffA); PG8_STAGE(PG8_SB(1, 1), cB + hstepB + kstep, voffB);
    PG8_WAIT_V(6); PG8_BAR;
    for (;;) {
        const bool has_next = S.next(ui + 1, nxt);
        const char* nA = has_next ? nxt.A : cA; const char* nB = has_next ? nxt.B : cB;
        int ntu = nt; if constexpr (KSkipOf<Epi>::v) ntu = Epi::ktiles(cur, nt);
#pragma unroll 1
        for (int t = 0; t < ntu; t += 2) {
            const bool last = (t == ntu - 2);
            asm volatile("" : "+v"(voffA[0]), "+v"(voffA[1]), "+v"(voffB[0]), "+v"(voffB[1]));
            const char* a1 = cA + (size_t)(t + 1) * kstep;
            const char* a2 = last ? nA : cA + (size_t)(t + 2) * kstep; const char* b2 = last ? nB : cB + (size_t)(t + 2) * kstep;
            const char* a3 = a2 + kstep; const char* b3 = b2 + kstep;
            PG8_LDB(B0, 0, 0); PG8_LDB(B1, 0, 1); PG8_SCHED; PG8_LDA(At, 0, 0); PG8_STAGE(PG8_SA(1, 1), a1 + hstepA, voffA);
            PG8_WAIT_V(8); PG8_WAIT_L(0); PG8_BAR; PG8_MMA(0, 0, At, B0); PG8_MMA(0, 1, At, B1); PG8_BAR; PG8_SCHED;
            PG8_LDA(At, 0, 1); PG8_STAGE(PG8_SB(0, 0), b2, voffB); PG8_STAGE(PG8_SB(0, 1), b2 + hstepB, voffB); PG8_STAGE(PG8_SA(0, 0), a2, voffA);
            PG8_WAIT_V(8); PG8_WAIT_L(0); PG8_BAR; PG8_MMA(1, 0, At, B0); PG8_MMA(1, 1, At, B1); PG8_BAR; PG8_SCHED;
            PG8_LDB(B0, 1, 0); PG8_LDB(B1, 1, 1); PG8_SCHED; PG8_LDA(At, 1, 0); PG8_STAGE(PG8_SA(0, 1), a2 + hstepA, voffA);
            PG8_WAIT_V(8); PG8_WAIT_L(0); PG8_BAR; PG8_MMA(0, 0, At, B0); PG8_MMA(0, 1, At, B1); PG8_BAR; PG8_SCHED;
            PG8_LDA(At, 1, 1); PG8_STAGE(PG8_SB(1, 0), b3, voffB); PG8_STAGE(PG8_SB(1, 1), b3 + hstepB, voffB); PG8_STAGE(PG8_SA(1, 0), a3, voffA);
            PG8_WAIT_V(8); PG8_WAIT_L(0); PG8_BAR; PG8_MMA(1, 0, At, B0); PG8_MMA(1, 1, At, B1); PG8_BAR; PG8_SCHED;
        }
        if constexpr (F8) asm volatile("s_nop 15\n\ts_nop 15\n\ts_nop 15\n\ts_nop 15" ::: "memory");
        if constexpr (ALIGN_EPI) { if (wr == 0) PG8_BAR; }
        if constexpr (!Epi::AFTER_DRAIN) { int fr2 = fr, fq2 = fq; asm volatile("" : "+v"(fr2), "+v"(fq2)); E(acc, cur, wr, wc, fr2, fq2); }
        if (!has_next) break;
#pragma unroll
        for (int a = 0; a < 2; ++a)
#pragma unroll
            for (int b = 0; b < 2; ++b)
#pragma unroll
                for (int m = 0; m < 4; ++m)
#pragma unroll
                    for (int n = 0; n < 2; ++n) acc[a][b][m][n] = (f32x4){0.f, 0.f, 0.f, 0.f};
        cur = nxt; cA = nA; cB = nB; ++ui;
        if constexpr (ALIGN_EPI) { if (wr == 1) PG8_BAR; }
    }
    PG8_WAIT_V(0);
    if constexpr (!ALIGN_EPI) { if (wr == 0) PG8_BAR; }
    PG8_BAR;
    if constexpr (Epi::AFTER_DRAIN) { E.fused(acc, cur, wr, wc, fr, fq, lds, wid, lane); }
#undef PG8_SA
#undef PG8_SB
#undef PG8_STAGE
#undef PG8_LDA
#undef PG8_LDB
#undef PG8_MMA
#undef PG8_LD8
#undef PG8_WAIT_V
#undef PG8_WAIT_L
#undef PG8_BAR
#undef PG8_SCHED
}
}
namespace epi {
using pg8::Unit;
typedef f32x4 Acc[2][2][4][2];
DI float rstd_of(const u64* ss, int row) { return rsqrtf((float)ss[row] * (1.0f / (SS_FIX * 1024.0f)) + EPS); }
DI void rstd8(const u64* ss, int row0, float (&rs)[8]) {
    u64 t[8];
#pragma unroll
    for (int q = 0; q < 8; ++q) t[q] = ss[row0 + (q >> 2) * 128 + (q & 3) * 16];
#pragma unroll
    for (int q = 0; q < 8; ++q) rs[q] = rsqrtf((float)t[q] * (1.0f / (SS_FIX * 1024.0f)) + EPS);
}
DI u32x4 pack8(const f32x4 a, const f32x4 b) { u32x4 w; w.x = cvtpk(a[0], a[1]); w.y = cvtpk(a[2], a[3]); w.z = cvtpk(b[0], b[1]); w.w = cvtpk(b[2], b[3]); return w; }

DI void gains4(const float* gain, int fq, f32x4 (&gvv)[4]) {
#pragma unroll
    for (int bj = 0; bj < 2; ++bj)
#pragma unroll
        for (int n = 0; n < 2; ++n) gvv[2 * bj + n] = *(const f32x4*)(gain + 32 * bj + 8 * fq + 4 * n);
}
template <int MODE>
DI void head_store(const Acc& acc, int ai, int m, float rs, const f32x4 (&gvv)[4], float scale, bf16_t* dst, int fq, int tpitch, int spos) {
    f32x4 v[2][2];
#pragma unroll
    for (int bj = 0; bj < 2; ++bj)
#pragma unroll
        for (int n = 0; n < 2; ++n) v[bj][n] = acc[ai][bj][m][n] * rs;
    if (MODE == 0 || MODE == 3) {
        float s = 0.f;
#pragma unroll
        for (int bj = 0; bj < 2; ++bj)
#pragma unroll
            for (int n = 0; n < 2; ++n) s += (v[bj][n][0] * v[bj][n][0] + v[bj][n][1] * v[bj][n][1]) + (v[bj][n][2] * v[bj][n][2] + v[bj][n][3] * v[bj][n][3]);
        s += __shfl_xor(s, 16); s += __shfl_xor(s, 32);
        const float r2 = rsqrtf(s * (1.0f / 64.0f) + EPS) * scale;
#pragma unroll
        for (int bj = 0; bj < 2; ++bj)
#pragma unroll
            for (int n = 0; n < 2; ++n) v[bj][n] = v[bj][n] * gvv[2 * bj + n] * r2;
    }
    if (MODE == 0 || MODE == 1) {
#pragma unroll
        for (int bj = 0; bj < 2; ++bj) *(u32x4*)(dst + 32 * bj + 8 * fq) = pack8(v[bj][0], v[bj][1]);
    } else if (MODE == 3) {
#pragma unroll
        for (int bj = 0; bj < 2; ++bj) { const int d8 = 32 * bj + 8 * fq, f = 2 * (d8 >> 4) + (spos >> 5), ln = (spos & 31) + 32 * ((d8 >> 3) & 1);
            *(u32x4*)(dst + (f * 64 + ln) * 8) = pack8(v[bj][0], v[bj][1]); }
    } else if (MODE == 4) {
        const int ks = spos >> 4, w = spos & 15, hi_ = (w >> 2) & 1, el = 4 * (w >> 3) + (w & 3);
#pragma unroll
        for (int bj = 0; bj < 2; ++bj)
#pragma unroll
            for (int n = 0; n < 2; ++n)
#pragma unroll
                for (int i = 0; i < 4; ++i) { const int d = 32 * bj + 8 * fq + 4 * n + i; dst[((2 * ks + (d >> 5)) * 64 + (d & 31) + 32 * hi_) * 8 + el] = f2bf(v[bj][n][i]); }
    } else {
        bf16_t* p = dst + (size_t)(8 * fq) * tpitch + perm_kv(spos);
#pragma unroll
        for (int bj = 0; bj < 2; ++bj) {
#pragma unroll
            for (int n = 0; n < 2; ++n)
#pragma unroll
                for (int i = 0; i < 4; ++i) p[(size_t)(4 * n + i) * tpitch] = f2bf(v[bj][n][i]);
            p += (size_t)32 * tpitch; asm volatile("" : "+v"(p) :: "memory");
        }
    }
}

struct EpiWin {
    static constexpr bool PERM = true, AFTER_DRAIN = false;
    const u64* ss; bf16_t *UX, *CVIN, *Q, *KC, *VC, *KS, *KW, *VST, *VWT; float* GATE; const float *qg, *kg;
    DI void operator()(const Acc& acc, const Unit& u, int wr, int wc, int fr, int fq) const {
        const int row0 = u.pm * 256 + wr * 64 + fr;
        float rsv[8]; rstd8(ss, row0, rsv);
        f32x4 gvv[4]; gains4(u.pn == 6 ? kg + 64 : (u.pn == 7 ? kg + 128 : qg), fq, gvv);
#pragma unroll
        for (int ai = 0; ai < 2; ++ai)
#pragma unroll
            for (int m = 0; m < 4; ++m) {
                const int row = row0 + ai * 128 + m * 16; const float rs = rsv[ai * 4 + m];
                const int b = row >> 13, s = row & (SEQ - 1);
                if (u.pn == 0) {
                    const int chunk = row >> 6, tau = row & 63;
#pragma unroll
                    for (int bj = 0; bj < 2; ++bj) { const int ch = 128 * bj + 32 * wc + 8 * fq, g = ch >> 4, h = ch & 15;
                        *(u32x4*)(UX + ((size_t)g * NCHUNK + chunk) * SKX + 128 + tau * 16 + h) = pack8(acc[ai][bj][m][0] * rs, acc[ai][bj][m][1] * rs); }
                } else if (u.pn <= 2) {
#pragma unroll
                    for (int bj = 0; bj < 2; ++bj) { const int ch = 128 * (u.pn - 1) + 4 * (16 * bj + 4 * wc + fq);
                        const f32x4 a = acc[ai][bj][m][0] * rs, g = acc[ai][bj][m][1] * rs;
                        u32x2 w; w.x = cvtpk(a[0] * sigmoidf_(g[0]), a[1] * sigmoidf_(g[1])); w.y = cvtpk(a[2] * sigmoidf_(g[2]), a[3] * sigmoidf_(g[3]));
                        *(u32x2*)(CVIN + (size_t)row * 256 + ch) = w; }
                } else if (u.pn <= 4) {
                    const int head = 4 * (u.pn - 3) + wc;
                    head_store<0>(acc, ai, m, rs, gvv, QSCALE, Q + ((size_t)row * 8 + head) * 64, fq, 0, 0);
                } else if (u.pn == 5) {
                    bf16_t* base = (wc >> 1) ? VC : KC;
                    head_store<1>(acc, ai, m, rs, gvv, 1.f, base + ((size_t)(b * 2 + (wc & 1)) * SEQ + s) * 64, fq, 0, 0);
                } else if (u.pn == 6) {
                    const int kvh = wc & 1; const size_t tileb = ((size_t)(b * 2 + kvh) * 128 + (s >> 6)) * 4096;
                    if (wc < 2) head_store<3>(acc, ai, m, rs, gvv, 1.f, KS + tileb, fq, 0, s & 63);
                    else head_store<4>(acc, ai, m, rs, gvv, 1.f, VST + tileb, fq, 0, s & 63);
                } else if (u.pn <= 7) {
                    const int kvh = wc & 1; const size_t plane = (size_t)(b * 2 + kvh) * SEQ * 64;
                    if (wc < 2) head_store<0>(acc, ai, m, rs, gvv, 1.f, KW + plane + (size_t)s * 64, fq, 0, 0);
                    else head_store<2>(acc, ai, m, rs, gvv, 1.f, VWT + plane + (size_t)(s >> 6) * 4096, fq, 64, s & 63);
                } else {
                    if (wc == 0 && fq < 3) {
#pragma unroll
                        for (int n = 0; n < 2; ++n) { const f32x4 v = acc[ai][0][m][n] * rs; f32x4 o; o[0] = sigmoidf_(v[0]); o[1] = sigmoidf_(v[1]); o[2] = sigmoidf_(v[2]); o[3] = sigmoidf_(v[3]);
                            *(f32x4*)(GATE + (size_t)row * 24 + 8 * fq + 4 * n) = o; }
                    }
                }
                asm volatile("" ::: "memory");
            }
    }
};

struct EpiXQ {
    static constexpr bool PERM = true, AFTER_DRAIN = false;
    const u64* ss; bf16_t* QX; const float* qg;
    DI void operator()(const Acc& acc, const Unit& u, int wr, int wc, int fr, int fq) const {
        const int row0 = u.pm * 256 + wr * 64 + fr;
        float rsv[8]; rstd8(ss, row0, rsv);
        f32x4 gvv[4]; gains4(qg, fq, gvv);
#pragma unroll
        for (int ai = 0; ai < 2; ++ai)
#pragma unroll
            for (int m = 0; m < 4; ++m) { const int row = row0 + ai * 128 + m * 16;
                head_store<0>(acc, ai, m, rsv[ai * 4 + m], gvv, QSCALE, QX + ((size_t)row * 4 + wc) * 64, fq, 0, 0); }
    }
};
struct EpiMemKV {
    static constexpr bool PERM = true, AFTER_DRAIN = false;
    const u64* ss; bf16_t *KM, *VMT; const float* kg;
    DI void operator()(const Acc& acc, const Unit& u, int wr, int wc, int fr, int fq) const {
        const int row0 = u.pm * 256 + wr * 64 + fr;
        float rsv[8]; rstd8(ss, row0, rsv);
        f32x4 gvv[4]; gains4(kg + u.g * 64, fq, gvv);
#pragma unroll
        for (int ai = 0; ai < 2; ++ai)
#pragma unroll
            for (int m = 0; m < 4; ++m) { const int row = row0 + ai * 128 + m * 16, b = row >> 8, mm = row & 255; const float rs = rsv[ai * 4 + m];
                const size_t plane = ((size_t)u.g * 32 + b * 4 + wc) * 256 * 64;
                if (u.pn == 0) head_store<0>(acc, ai, m, rs, gvv, 1.f, KM + plane + (size_t)mm * 64, fq, 0, 0);
                else head_store<2>(acc, ai, m, rs, gvv, 1.f, VMT + plane, fq, 256, mm);
                asm volatile("" ::: "memory"); }
    }
};

template <int MODE, bool F8OUT = false> struct EpiGate {
    static constexpr bool PERM = true, AFTER_DRAIN = false;
    bf16_t* O; int ldo; const u64* ss; const int* row_tok;
    DI void operator()(const Acc& acc, const Unit& u, int wr, int wc, int fr, int fq) const {
        const int row0 = u.pm * 256 + wr * 64 + fr;
        float rsv[8];
        if (MODE == 1) rstd8(ss, row0, rsv);
        if (MODE == 2) { int tk[8]; u64 t[8];
#pragma unroll
            for (int q = 0; q < 8; ++q) tk[q] = row_tok[row0 + (q >> 2) * 128 + (q & 3) * 16];
#pragma unroll
            for (int q = 0; q < 8; ++q) t[q] = ss[tk[q] < 0 ? 0 : tk[q]];
#pragma unroll
            for (int q = 0; q < 8; ++q) rsv[q] = tk[q] >= 0 ? rsqrtf((float)t[q] * (1.0f / (SS_FIX * 1024.0f)) + EPS) : 0.f; }
#pragma unroll
        for (int ai = 0; ai < 2; ++ai)
#pragma unroll
            for (int m = 0; m < 4; ++m) { const int row = row0 + ai * 128 + m * 16; float rs = 1.f;
                if (MODE == 1 || MODE == 2) rs = rsv[ai * 4 + m];
                if (F8OUT) rs *= (1.0f / W8_SCALE);
#pragma unroll
                for (int bj = 0; bj < 2; ++bj) { const int ch = 128 * u.pn + 4 * (16 * bj + 4 * wc + fq);
                    const f32x4 a = acc[ai][bj][m][0] * rs, g = acc[ai][bj][m][1] * rs; f32x4 o;
#pragma unroll
                    for (int i = 0; i < 4; ++i) { o[i] = (MODE == 0) ? a[i] * sigmoidf_(g[i]) : siluf_(a[i]) * g[i]; }
                    if (F8OUT) *(unsigned*)((unsigned char*)O + (size_t)row * ldo + ch) = pack_fp8x4(o[0], o[1], o[2], o[3]);
                    else { u32x2 w; w.x = cvtpk(o[0], o[1]); w.y = cvtpk(o[2], o[3]); *(u32x2*)(O + (size_t)row * ldo + ch) = w; } } }
    }
};
struct EpiPlain {
    static constexpr bool PERM = true, AFTER_DRAIN = false;
    bf16_t* O; int ldo;
    DI void operator()(const Acc& acc, const Unit& u, int wr, int wc, int fr, int fq) const {
        const int row0 = u.pm * 256 + wr * 64 + fr;
#pragma unroll
        for (int ai = 0; ai < 2; ++ai)
#pragma unroll
            for (int m = 0; m < 4; ++m) { bf16_t* rp = O + (size_t)(row0 + ai * 128 + m * 16) * ldo + u.pn * 256 + wc * 32 + 8 * fq;
#pragma unroll
                for (int bj = 0; bj < 2; ++bj) *(u32x4*)(rp + bj * 128) = pack8(acc[ai][bj][m][0], acc[ai][bj][m][1]); }
    }
};
template <bool MOE, bool STATS> struct EpiRes {
    static_assert(!(MOE && STATS), "row statistics are only kept for the dense residual epilogue");
    static constexpr bool PERM = true, AFTER_DRAIN = false;
    const bf16_t* hbase; float* out; bf16_t* hb; u64* ssout; const int* row_tok; const float* row_gate; float ascale; unsigned char* h8;
    DI void operator()(const Acc& acc, const Unit& u, int wr, int wc, int fr, int fq) const {
        const int row0 = u.pm * 256 + wr * 64 + fr, col0 = u.pn * 256 + wc * 32 + 8 * fq;
        int rowv[8]; float gtv[8];
#pragma unroll
        for (int q = 0; q < 8; ++q) { rowv[q] = row0 + (q >> 2) * 128 + (q & 3) * 16; gtv[q] = ascale; }
        if (MOE) {
#pragma unroll
            for (int q = 0; q < 8; ++q) { const int r = rowv[q]; rowv[q] = row_tok[r]; gtv[q] = row_gate[r]; }
#pragma unroll
            for (int q = 0; q < 8; ++q) gtv[q] *= ascale;
        }
#pragma unroll
        for (int ai = 0; ai < 2; ++ai) {
            u32x4 bb[4][2];
#pragma unroll
            for (int m = 0; m < 4; ++m) { const int rr = rowv[ai * 4 + m] < 0 ? 0 : rowv[ai * 4 + m];
#pragma unroll
                for (int bj = 0; bj < 2; ++bj) bb[m][bj] = *(const u32x4*)(hbase + (size_t)rr * DM + col0 + bj * 128); }
#pragma unroll
            for (int m = 0; m < 4; ++m) { const int row = rowv[ai * 4 + m]; const float gt = gtv[ai * 4 + m];
                float s = 0.f;
                if (!MOE || row >= 0) {
#pragma unroll
                    for (int bj = 0; bj < 2; ++bj) { const size_t off = (size_t)row * DM + col0 + bj * 128;
                        const u32x4 b4 = bb[m][bj];
                        const f32x4 b0 = (f32x4){bflo(b4.x), bfhi(b4.x), bflo(b4.y), bfhi(b4.y)}, b1 = (f32x4){bflo(b4.z), bfhi(b4.z), bflo(b4.w), bfhi(b4.w)};
                        const f32x4 v0 = b0 + acc[ai][bj][m][0] * gt, v1 = b1 + acc[ai][bj][m][1] * gt;
                        if (out) { *(f32x4*)(out + off) = v0; *(f32x4*)(out + off + 4) = v1; }
                        if (hb) *(u32x4*)(hb + off) = pack8(v0, v1);
                        if (STATS && h8) { u32x2 w8; w8.x = pack_fp8x4(v0[0], v0[1], v0[2], v0[3]); w8.y = pack_fp8x4(v1[0], v1[1], v1[2], v1[3]); *(u32x2*)(h8 + off) = w8; }
                        if (STATS) s += (v0[0] * v0[0] + v0[1] * v0[1]) + (v0[2] * v0[2] + v0[3] * v0[3]) + (v1[0] * v1[0] + v1[1] * v1[1]) + (v1[2] * v1[2] + v1[3] * v1[3]); }
                }
                if (STATS) { s += __shfl_xor(s, 16); s += __shfl_xor(s, 32);
                    if (fq == 0) atomicAdd((unsigned long long*)(ssout + row), (unsigned long long)(s * SS_FIX + 0.5f)); }
                asm volatile("" ::: "memory");
            }
        }
    }
};
struct EpiS5State {
    static constexpr bool PERM = true, AFTER_DRAIN = false;
    float* ZC;
    DI void operator()(const Acc& acc, const Unit& u, int wr, int wc, int fr, int fq) const {
        const int row0 = u.pm * 256 + wr * 64 + fr;
#pragma unroll
        for (int ai = 0; ai < 2; ++ai)
#pragma unroll
            for (int m = 0; m < 4; ++m) { float* rp = ZC + ((size_t)u.g * NCHUNK + row0 + ai * 128 + m * 16) * 128 + wc * 32 + 8 * fq;
                *(f32x4*)rp = acc[ai][0][m][0]; *(f32x4*)(rp + 4) = acc[ai][0][m][1]; }
    }
};
struct EpiS5Out {
    static constexpr bool PERM = true, AFTER_DRAIN = false;
    static DI int ktiles(const Unit& u, int nt) { const int k = 4 * u.pn + 6; return k < nt ? k : nt; }
    bf16_t* YG;
    DI void operator()(const Acc& acc, const Unit& u, int wr, int wc, int fr, int fq) const {
        const int row0 = u.pm * 256 + wr * 64 + fr;
#pragma unroll
        for (int ai = 0; ai < 2; ++ai)
#pragma unroll
            for (int m = 0; m < 4; ++m) { const int chunk = row0 + ai * 128 + m * 16;
#pragma unroll
                for (int bj = 0; bj < 2; ++bj) { const int c = u.pn * 256 + bj * 128 + wc * 32 + 8 * fq, tau = c >> 4, h = c & 15;
                    f32x4 a = acc[ai][bj][m][0], b = acc[ai][bj][m][1];
#pragma unroll
                    for (int i = 0; i < 4; ++i) { a[i] = gelu_tanh(a[i]); b[i] = gelu_tanh(b[i]); }
                    *(u32x4*)(YG + ((size_t)chunk * 64 + tau) * 256 + u.g * 16 + h) = pack8(a, b); } }
    }
};
}
namespace att {
constexpr int TP = 144;
constexpr int TILEB = 64 * TP;
constexpr int L_K0 = 0, L_K1 = TILEB, L_V0 = 2 * TILEB, L_V1 = 3 * TILEB, L_BIAS = 4 * TILEB  , L_UNI = L_BIAS + 8 * 132 * 4  ,
              L_IMP = L_UNI + 64  , L_OVT = L_IMP + 256 * 132 * 2  , L_INVL = L_OVT + 32 * TP  , L_END = L_INVL + 1024;
static_assert(L_END <= 131072, "attention LDS");
DI int crow(int r, int hi) { return (r & 3) + 8 * (r >> 2) + 4 * hi; }
#define MFMA32(a, b, c) __builtin_amdgcn_mfma_f32_32x32x16_bf16((a), (b), (c), 0, 0, 0)

struct TileRegs { u32x4 k, v; };
DI void tile_fetch(TileRegs& t, const bf16_t* ksrc, int kp, const bf16_t* vsrc, int vp, int tid) {
    const int row = tid >> 3, ch = (tid & 7) * 8;
    t.k = *(const u32x4*)(ksrc + (size_t)row * kp + ch);
    t.v = *(const u32x4*)(vsrc + (size_t)row * vp + ch);
}
DI void tile_fetch_k(TileRegs& t, const bf16_t* ksrc, int kp, int tid) { const int row = tid >> 3, ch = (tid & 7) * 8; t.k = *(const u32x4*)(ksrc + (size_t)row * kp + ch); }
DI void tile_put(const TileRegs& t, LAS unsigned char* kd, LAS unsigned char* vd, int tid) {
    const int off = (tid >> 3) * TP + (tid & 7) * 16;
    *(LAS u32x4*)(kd + off) = t.k; *(LAS u32x4*)(vd + off) = t.v;
}
DI void tile_fetch_v(TileRegs& t, const bf16_t* vsrc, int vp, int tid) { const int row = tid >> 3, ch = (tid & 7) * 8; t.v = *(const u32x4*)(vsrc + (size_t)row * vp + ch); }
DI void tile_put_v(const TileRegs& t, LAS unsigned char* vd, int tid) { *(LAS u32x4*)(vd + (tid >> 3) * TP + (tid & 7) * 16) = t.v; }
DI void tile_put_k(const TileRegs& t, LAS unsigned char* kd, int tid) { *(LAS u32x4*)(kd + (tid >> 3) * TP + (tid & 7) * 16) = t.k; }

DI void load_kfrag(bf16x8 (&kf)[8], const LAS unsigned char* kt, int r32, int hi) {
    const LAS unsigned char* kb = kt + r32 * TP + hi * 16;
#pragma unroll
    for (int d0 = 0; d0 < 4; ++d0) { kf[2 * d0] = *(const LAS bf16x8*)(kb + d0 * 32); kf[2 * d0 + 1] = *(const LAS bf16x8*)(kb + 32 * TP + d0 * 32); }
}
DI void load_vfrag(bf16x8 (&vf)[8], const LAS unsigned char* vt, int r32, int hi) {
    const LAS unsigned char* vb = vt + r32 * TP + hi * 16;
#pragma unroll
    for (int ks = 0; ks < 4; ++ks) { vf[2 * ks] = *(const LAS bf16x8*)(vb + ks * 32); vf[2 * ks + 1] = *(const LAS bf16x8*)(vb + 32 * TP + ks * 32); }
}
DI void qk_mma(f32x16& p0, f32x16& p1, const bf16x8 (&kf)[8], const bf16x8 (&qf)[4]) {
#pragma unroll
    for (int i = 0; i < 16; ++i) { p0[i] = 0.f; p1[i] = 0.f; }
#pragma unroll
    for (int d0 = 0; d0 < 4; ++d0) { p0 = MFMA32(kf[2 * d0], qf[d0], p0); p1 = MFMA32(kf[2 * d0 + 1], qf[d0], p1); }
}
DI void qk_tile(f32x16& p0, f32x16& p1, const LAS unsigned char* kt, const bf16x8 (&qf)[4], int r32, int hi) {
    bf16x8 kf[8]; load_kfrag(kf, kt, r32, hi); __builtin_amdgcn_sched_barrier(0); qk_mma(p0, p1, kf, qf);
}
DI bf16x8 pack_p(const f32x16& p, int s) {
    u32x4 w; w.x = cvtpk(p[8 * s], p[8 * s + 1]); w.y = cvtpk(p[8 * s + 2], p[8 * s + 3]); w.z = cvtpk(p[8 * s + 4], p[8 * s + 5]); w.w = cvtpk(p[8 * s + 6], p[8 * s + 7]);
    return __builtin_bit_cast(bf16x8, w);
}
DI void pv_mma(f32x16 (&o)[2], const bf16x8 (&vf)[8], const f32x16& p0, const f32x16& p1) {
#pragma unroll
    for (int ks = 0; ks < 4; ++ks) { const bf16x8 pf = (ks < 2) ? pack_p(p0, ks) : pack_p(p1, ks - 2); o[0] = MFMA32(vf[2 * ks], pf, o[0]); o[1] = MFMA32(vf[2 * ks + 1], pf, o[1]); }
}
DI void pv_tile(f32x16 (&o)[2], const LAS unsigned char* vt, const f32x16& p0, const f32x16& p1, int r32, int hi) {
    bf16x8 vf[8]; load_vfrag(vf, vt, r32, hi); __builtin_amdgcn_sched_barrier(0); pv_mma(o, vf, p0, p1);
}
DI void softmax_step(f32x16& p0, f32x16& p1, float& m, float& l, f32x16 (&o)[2]) {
    float mx = __builtin_fmaxf(p0[0], p1[0]), my = __builtin_fmaxf(p0[1], p1[1]);
#pragma unroll
    for (int i = 2; i < 16; i += 2) { mx = __builtin_fmaxf(__builtin_fmaxf(mx, p0[i]), p1[i]); my = __builtin_fmaxf(__builtin_fmaxf(my, p0[i + 1]), p1[i + 1]); }
    mx = __builtin_fmaxf(mx, my);
    mx = __builtin_fmaxf(mx, __shfl_xor(mx, 32));
    const float mn = __builtin_fmaxf(m, mx), mu = (mn == -INFINITY) ? 0.f : mn;
    const float al = __builtin_amdgcn_exp2f(m - mu);
    float s = 0.f;
#pragma unroll
    for (int i = 0; i < 16; ++i) { p0[i] = __builtin_amdgcn_exp2f(p0[i] - mu); p1[i] = __builtin_amdgcn_exp2f(p1[i] - mu); s += p0[i] + p1[i]; }
    l = l * al + s; m = mn;
    if (__any(al != 1.f)) {
#pragma unroll
        for (int i = 0; i < 16; ++i) { o[0][i] *= al; o[1][i] *= al; }
    }
}
DI void exp_tile(f32x16& p0, f32x16& p1) {
#pragma unroll
    for (int i = 0; i < 16; ++i) { p0[i] = __builtin_amdgcn_exp2f(p0[i]); p1[i] = __builtin_amdgcn_exp2f(p1[i]); }
}
DI void qk_tile_c(f32x16& p0, f32x16& p1, const LAS unsigned char* kt, const bf16x8 (&qf)[4], float cval, int r32, int hi) {
    const LAS unsigned char* kb = kt + r32 * TP + hi * 16;
    f32x16 cv;
#pragma unroll
    for (int i = 0; i < 16; ++i) cv[i] = cval;
    bf16x8 ka[4], kc[4];
    ka[0] = *(const LAS bf16x8*)(kb); ka[1] = *(const LAS bf16x8*)(kb + 32 * TP); ka[2] = *(const LAS bf16x8*)(kb + 32); ka[3] = *(const LAS bf16x8*)(kb + 32 * TP + 32);
    __builtin_amdgcn_sched_barrier(0);
    p0 = MFMA32(ka[0], qf[0], cv); p1 = MFMA32(ka[1], qf[0], cv);
    kc[0] = *(const LAS bf16x8*)(kb + 64); kc[1] = *(const LAS bf16x8*)(kb + 32 * TP + 64); kc[2] = *(const LAS bf16x8*)(kb + 96); kc[3] = *(const LAS bf16x8*)(kb + 32 * TP + 96);
    p0 = MFMA32(ka[2], qf[1], p0); p1 = MFMA32(ka[3], qf[1], p1);
    __builtin_amdgcn_sched_barrier(0);
    p0 = MFMA32(kc[0], qf[2], p0); p1 = MFMA32(kc[1], qf[2], p1); p0 = MFMA32(kc[2], qf[3], p0); p1 = MFMA32(kc[3], qf[3], p1);
}
DI void pv_tile_sum(f32x16 (&o)[2], f32x16& lacc, const LAS unsigned char* vt, const f32x16& p0, const f32x16& p1, int r32, int hi) {
    const bf16x8 ones = (bf16x8){0x3F80, 0x3F80, 0x3F80, 0x3F80, 0x3F80, 0x3F80, 0x3F80, 0x3F80};
    const LAS unsigned char* vb = vt + r32 * TP + hi * 16;
    bf16x8 va[4], vc[4];
    va[0] = *(const LAS bf16x8*)(vb); va[1] = *(const LAS bf16x8*)(vb + 32 * TP); va[2] = *(const LAS bf16x8*)(vb + 32); va[3] = *(const LAS bf16x8*)(vb + 32 * TP + 32);
    const bf16x8 pf0 = pack_p(p0, 0), pf1 = pack_p(p0, 1);
    __builtin_amdgcn_sched_barrier(0);
    o[0] = MFMA32(va[0], pf0, o[0]); o[1] = MFMA32(va[1], pf0, o[1]); lacc = MFMA32(ones, pf0, lacc);
    vc[0] = *(const LAS bf16x8*)(vb + 64); vc[1] = *(const LAS bf16x8*)(vb + 32 * TP + 64); vc[2] = *(const LAS bf16x8*)(vb + 96); vc[3] = *(const LAS bf16x8*)(vb + 32 * TP + 96);
    o[0] = MFMA32(va[2], pf1, o[0]); o[1] = MFMA32(va[3], pf1, o[1]); lacc = MFMA32(ones, pf1, lacc);
    const bf16x8 pf2 = pack_p(p1, 0), pf3 = pack_p(p1, 1);
    __builtin_amdgcn_sched_barrier(0);
    o[0] = MFMA32(vc[0], pf2, o[0]); o[1] = MFMA32(vc[1], pf2, o[1]); lacc = MFMA32(ones, pf2, lacc);
    o[0] = MFMA32(vc[2], pf3, o[0]); o[1] = MFMA32(vc[3], pf3, o[1]); lacc = MFMA32(ones, pf3, lacc);
}
DI void store_o(const f32x16 (&o)[2], float inv, bf16_t* dst, int hi) {
#pragma unroll
    for (int dh = 0; dh < 2; ++dh)
#pragma unroll
        for (int g = 0; g < 4; ++g) { u32x2 w; w.x = cvtpk(o[dh][4 * g] * inv, o[dh][4 * g + 1] * inv); w.y = cvtpk(o[dh][4 * g + 2] * inv, o[dh][4 * g + 3] * inv);
            *(u32x2*)(dst + 32 * dh + 8 * g + 4 * hi) = w; }
}
DI void load_q(bf16x8 (&qf)[4], const bf16_t* qrow, int hi) {
#pragma unroll
    for (int d0 = 0; d0 < 4; ++d0) qf[d0] = *(const bf16x8*)(qrow + 16 * d0 + 8 * hi);
}

DI void bias_mask_half(f32x16& p, const LAS float* btab, int dbase, int hi, int hiD) {
#pragma unroll
    for (int h8 = 0; h8 < 2; ++h8) {
        float bv[8];
#pragma unroll
        for (int r = 0; r < 8; ++r) { const int d = dbase - crow(8 * h8 + r, hi); bv[r] = btab[d < 0 ? 0 : (d < 128 ? d : 128)]; }
#pragma unroll
        for (int r = 0; r < 8; ++r) { const int d = dbase - crow(8 * h8 + r, hi); p[8 * h8 + r] = (d >= 0 && d < hiD) ? p[8 * h8 + r] + bv[r] : -INFINITY; }
        asm volatile("" ::: "memory");
    }
}
DI void bias_mask(f32x16& p0, f32x16& p1, const LAS float* btab  , int t, int s0, int hi, int hiD) {
    bias_mask_half(p0, btab, t - s0, hi, hiD); bias_mask_half(p1, btab, t - s0 - 32, hi, hiD);
}
DI void bias_mask_x(f32x16& p0, f32x16& p1, const LAS float* xt  , int t, int s0, int hi) {
    const LAS float* b0 = xt + (t - s0 + 128 - 4 * hi - 27); const LAS float* b1 = b0 - 32;
#pragma unroll
    for (int h8 = 0; h8 < 2; ++h8) {
        float v0[8], v1[8];
#pragma unroll
        for (int r = 0; r < 8; ++r) { const int rr = 8 * h8 + r, cr = (rr & 3) + 8 * (rr >> 2); v0[r] = b0[27 - cr]; v1[r] = b1[27 - cr]; }
#pragma unroll
        for (int r = 0; r < 8; ++r) { p0[8 * h8 + r] += v0[r]; p1[8 * h8 + r] += v1[r]; }
        asm volatile("" ::: "memory");
    }
}
constexpr int XT_WIN = 704, XT_SEL = 320;
DI void fill_xt(LAS float* xt, const LAS float* tb  , int len, int hiD, int tid) {
    for (int i = tid; i < 8 * len; i += 512) { const int h = i / len, d = i % len - 128; float v = -INFINITY; if (d >= 0 && d < hiD) v = tb[h * 132 + (d < 128 ? d : 128)]; xt[i] = v; }
}
DI void bias_const(f32x16& p0, f32x16& p1, float c) {
#pragma unroll
    for (int r = 0; r < 16; ++r) { p0[r] += c; p1[r] += c; }
}
DI void fill_ninf(f32x16& p0, f32x16& p1) {
#pragma unroll
    for (int r = 0; r < 16; ++r) { p0[r] = -INFINITY; p1[r] = -INFINITY; }
}

DI int next_bit(u64 lo, u64 hi_, int from, int c) {
    if (from < 64) { const u64 x = lo & (~0ull << from); if (x) { const int j = __ffsll((unsigned long long)x) - 1; return j <= c ? j : -1; } from = 64; }
    if (from < 128) { const u64 x = hi_ & (~0ull << (from - 64)); if (x) { const int j = 64 + __ffsll((unsigned long long)x) - 1; return j <= c ? j : -1; } }
    return -1;
}
template <class POL>
DI float flash_loop(LAS unsigned char* lds, const POL& P, const bf16x8 (&qf)[4], f32x16 (&o)[2], float cval_on, int tid, int r32, int hi) {
    int jc = P.first(), jn = P.next(jc);
    TileRegs tr;
    tile_fetch_k(tr, P.kptr(jc), P.kp, tid);
    __syncthreads();
    tile_put_k(tr, lds + L_K0, tid);
    tile_fetch_v(tr, P.vptr(jc), P.vp, tid); if (jn >= 0) tile_fetch_k(tr, P.kptr(jn), P.kp, tid);
    tile_put_v(tr, lds + L_V0, tid); if (jn >= 0) tile_put_k(tr, lds + L_K1, tid);
    __syncthreads();
    f32x16 lacc;
#pragma unroll
    for (int i = 0; i < 16; ++i) lacc[i] = 0.f;
    f32x16 sA0, sA1, sB0, sB1;
    if (P.active(jc)) qk_tile_c(sA0, sA1, lds + L_K0, qf, P.lane_on(jc) ? cval_on : -INFINITY, r32, hi);
    __syncthreads();
    int kb = 1, vb = 0;
#define FL_STEP(C0, C1, N0, N1) { const int jn2 = jn >= 0 ? P.next(jn) : -1; \
        const bool actn = jn >= 0 && P.active(jn), actc = P.active(jc); \
        if (jn >= 0) tile_fetch_v(tr, P.vptr(jn), P.vp, tid); if (jn2 >= 0) tile_fetch_k(tr, P.kptr(jn2), P.kp, tid); \
        if (actn) qk_tile_c(N0, N1, lds + (kb ? L_K1 : L_K0), qf, P.lane_on(jn) ? cval_on : -INFINITY, r32, hi); \
        if (actc) { P.adjust(C0, C1, jc); exp_tile(C0, C1); pv_tile_sum(o, lacc, lds + (vb ? L_V1 : L_V0), C0, C1, r32, hi); } \
        if (jn >= 0) tile_put_v(tr, lds + (vb ? L_V0 : L_V1), tid); if (jn2 >= 0) tile_put_k(tr, lds + (kb ? L_K0 : L_K1), tid); \
        __syncthreads(); kb ^= 1; vb ^= 1; jc = jn; jn = jn2; }
    for (;;) { FL_STEP(sA0, sA1, sB0, sB1) if (jc < 0) break; FL_STEP(sB0, sB1, sA0, sA1) if (jc < 0) break; }
#undef FL_STEP
    return lacc[0];
}

struct WindowPol {
    const bf16_t* Kp; const bf16_t* Vp; int kp, vp, c, j0, t, hi; const LAS float* btab;
    DI int first() const { return j0; }
    DI int next(int j) const { return j < c ? j + 1 : -1; }
    DI const bf16_t* kptr(int j) const { return Kp + (size_t)j * 64 * 64; }
    DI const bf16_t* vptr(int j) const { return Vp + (size_t)j * 4096; }
    DI bool active(int) const { int one = 1; asm volatile("" : "+s"(one)); return one != 0; }
    DI bool lane_on(int) const { return true; }
    DI void adjust(f32x16& p0, f32x16& p1, int j) const { if (j == c - 8 || j + 2 >= c) bias_mask_x(p0, p1, btab, t, 64 * j, hi); }
};
DI void window_unit(LAS unsigned char* lds, int b, int kvh, int c, const bf16_t* Q, const bf16_t* KW, const bf16_t* VWT, bf16_t* OW, const float* bnd, const int tid_) {
    int tid = tid_; asm volatile("" : "+v"(tid));
    const int lane = tid & 63, wid = __builtin_amdgcn_readfirstlane(tid >> 6), r32 = lane & 31, hi = lane >> 5;
    const int tl = 8 * wid + (r32 >> 2), g = r32 & 3, t = 64 * c + tl;
    const size_t plane = (size_t)(b * 2 + kvh);
    bf16x8 qf[4]; load_q(qf, Q + (((size_t)b * SEQ + t) * 8 + kvh * 4 + g) * 64, hi);
    const WindowPol P{KW + plane * SEQ * 64, VWT + plane * 64 * SEQ, 64, 64, c, c >= 8 ? c - 8 : 0, t, hi, (const LAS float*)(lds + L_IMP) + (kvh * 4 + g) * XT_WIN};
    f32x16 o[2];
#pragma unroll
    for (int i = 0; i < 16; ++i) { o[0][i] = 0.f; o[1][i] = 0.f; }
    const float lt = flash_loop(lds, P, qf, o, -bnd[kvh * 4 + g], tid, r32, hi);
    int t2 = tid; asm volatile("" : "+v"(t2));
    { const int l2 = t2 & 63, r2 = l2 & 31, tl2 = 8 * (t2 >> 6) + (r2 >> 2), g2 = r2 & 3; store_o(o, lt > 0.f ? 1.f / lt : 0.f, OW + (((size_t)b * SEQ + 64 * c + tl2) * 8 + kvh * 4 + g2) * 64, l2 >> 5); }
}

struct SelPol {
    const bf16_t* Kp; const bf16_t* Vp; int kp, vp, c, t, hi; const LAS float* btab; u64 ulo, uhi, wlo, whi, mlo, mhi;
    DI int first() const { return next_bit(ulo, uhi, 0, c); }
    DI int next(int j) const { return next_bit(ulo, uhi, j + 1, c); }
    DI const bf16_t* kptr(int j) const { return Kp + (size_t)j * 64 * 64; }
    DI const bf16_t* vptr(int j) const { return Vp + (size_t)j * 4096; }
    DI bool active(int j) const { return ((j < 64 ? wlo >> j : whi >> (j - 64)) & 1ull) != 0ull; }
    DI bool lane_on(int j) const { return ((j < 64 ? mlo >> j : mhi >> (j - 64)) & 1ull) != 0ull; }
    DI void adjust(f32x16& p0, f32x16& p1, int j) const { if (j + 2 >= c) bias_mask(p0, p1, btab, t, 64 * j, hi, 1 << 30); }
};
DI void selected_unit(LAS unsigned char* lds, int b, int kvh, int c, const bf16_t* Q, const bf16_t* KS, const bf16_t* VST, const unsigned* SEL, bf16_t* OS, const float* bnd, const int tid_) {
    int tid = tid_; asm volatile("" : "+v"(tid));
    const int lane = tid & 63, wid = __builtin_amdgcn_readfirstlane(tid >> 6), r32 = lane & 31, hi = lane >> 5;
    const int tl = 8 * wid + (r32 >> 2), g = r32 & 3, t = 64 * c + tl;
    const size_t plane = (size_t)(b * 2 + kvh);
    LAS unsigned* uni = (LAS unsigned*)(lds + L_UNI);
    __syncthreads();
    if (tid < 4) uni[tid] = 0u;
    __syncthreads();
    const u32x4 mk = *(const u32x4*)(SEL + (plane * SEQ + t) * 4);
    unsigned w0 = mk.x, w1 = mk.y, w2 = mk.z, w3 = mk.w;
#pragma unroll
    for (int o_ = 4; o_ < 64; o_ <<= 1) { w0 |= __shfl_xor(w0, o_); w1 |= __shfl_xor(w1, o_); w2 |= __shfl_xor(w2, o_); w3 |= __shfl_xor(w3, o_); }
    w0 = __builtin_amdgcn_readfirstlane(w0); w1 = __builtin_amdgcn_readfirstlane(w1); w2 = __builtin_amdgcn_readfirstlane(w2); w3 = __builtin_amdgcn_readfirstlane(w3);
    if (lane == 0) { __hip_atomic_fetch_or(uni + 0, w0, __ATOMIC_RELAXED, __HIP_MEMORY_SCOPE_WORKGROUP); __hip_atomic_fetch_or(uni + 1, w1, __ATOMIC_RELAXED, __HIP_MEMORY_SCOPE_WORKGROUP);
                     __hip_atomic_fetch_or(uni + 2, w2, __ATOMIC_RELAXED, __HIP_MEMORY_SCOPE_WORKGROUP); __hip_atomic_fetch_or(uni + 3, w3, __ATOMIC_RELAXED, __HIP_MEMORY_SCOPE_WORKGROUP); }
    __syncthreads();
    const u64 ulo = (u64)__builtin_amdgcn_readfirstlane(uni[0]) | ((u64)__builtin_amdgcn_readfirstlane(uni[1]) << 32), uhi = (u64)__builtin_amdgcn_readfirstlane(uni[2]) | ((u64)__builtin_amdgcn_readfirstlane(uni[3]) << 32);
    bf16x8 qf[4]; load_q(qf, Q + (((size_t)b * SEQ + t) * 8 + kvh * 4 + g) * 64, hi);
    const SelPol P{KS + plane * SEQ * 64, VST + plane * 64 * SEQ, 64, 64, c, t, hi, (const LAS float*)(lds + L_BIAS) + (kvh * 4 + g) * 132, ulo, uhi,
                   (u64)w0 | ((u64)w1 << 32), (u64)w2 | ((u64)w3 << 32), (u64)mk.x | ((u64)mk.y << 32), (u64)mk.z | ((u64)mk.w << 32)};
    f32x16 o[2];
#pragma unroll
    for (int i = 0; i < 16; ++i) { o[0][i] = 0.f; o[1][i] = 0.f; }
    const float lt = flash_loop(lds, P, qf, o, -bnd[kvh * 4 + g], tid, r32, hi);
    int t2 = tid; asm volatile("" : "+v"(t2));
    { const int l2 = t2 & 63, r2 = l2 & 31, tl2 = 8 * (t2 >> 6) + (r2 >> 2), g2 = r2 & 3; store_o(o, lt > 0.f ? 1.f / lt : 0.f, OS + (((size_t)b * SEQ + 64 * c + tl2) * 8 + kvh * 4 + g2) * 64, l2 >> 5); }
}

struct CrossPol {
    const bf16_t* Kp; const bf16_t* Vp; int kp, vp;
    DI int first() const { return 0; }
    DI int next(int j) const { return j < 3 ? j + 1 : -1; }
    DI const bf16_t* kptr(int j) const { return Kp + (size_t)j * 64 * 64; }
    DI const bf16_t* vptr(int j) const { return Vp + j * 64; }
    DI bool active(int) const { return true; }
    DI bool lane_on(int) const { return true; }
    DI void adjust(f32x16&, f32x16&, int) const {}
};
DI void cross_unit(LAS unsigned char* lds, int b, int h, int qt, const bf16_t* QX, const bf16_t* KM, const bf16_t* VMT, bf16_t* OX, const float* bnd, const int tid_) {
    int tid = tid_; asm volatile("" : "+v"(tid));
    const int lane = tid & 63, wid = __builtin_amdgcn_readfirstlane(tid >> 6), r32 = lane & 31, hi = lane >> 5;
    const size_t row = (size_t)b * SEQ + 256 * qt + 32 * wid + r32;
    bf16x8 qf[4]; load_q(qf, QX + (row * 4 + h) * 64, hi);
    const CrossPol P{KM + (size_t)(b * 4 + h) * 256 * 64, VMT + (size_t)(b * 4 + h) * 64 * 256, 64, 256};
    f32x16 o[2];
#pragma unroll
    for (int i = 0; i < 16; ++i) { o[0][i] = 0.f; o[1][i] = 0.f; }
    const float lt = flash_loop(lds, P, qf, o, -bnd[h], tid, r32, hi);
    store_o(o, 1.f / lt, OX + row * 256 + h * 64, hi);
}
constexpr int SP_OACC = 0, SP_LACC = 256 * 65 * 4, SP_BIAS = 69632, SP_SCR = SP_BIAS + 8 * 132 * 4, SP_Q = SP_SCR + 8 * 64  , SP_END = SP_Q + 256 * TP;
DI int cvt_rpi(float x) { int i; asm("v_cvt_rpi_i32_f32 %0, %1" : "=v"(i) : "v"(x)); return i; }
constexpr float SP_FS = 131072.0f;
static_assert(SP_END + 8 * 320 * 4 <= 131072, "sparse selected LDS");
DI void sel_sparse_unit(LAS unsigned char* lds, int b, int kvh, int c, const bf16_t* Q, const bf16_t* KS, const bf16_t* VSB, const unsigned* SEL, bf16_t* OS, const float* bnd, const int tid_) {
    int tid = tid_; asm volatile("" : "+v"(tid));
    const int lane = tid & 63, wid = __builtin_amdgcn_readfirstlane(tid >> 6), r32 = lane & 31, hi = lane >> 5, slot = r32 >> 2, g4 = r32 & 3;
    const size_t plane = (size_t)(b * 2 + kvh);
    const bf16_t* Kp = KS + plane * SEQ * 64; const bf16_t* Vp = VSB + plane * 64 * SEQ;
    LAS int* OACC = (LAS int*)(lds + SP_OACC); LAS int* LACC = (LAS int*)(lds + SP_LACC);
    __syncthreads();
    for (int i = tid; i < (256 * 65 + 256) / 4; i += 512) ((LAS u32x4*)lds)[i] = (u32x4){0u, 0u, 0u, 0u};
    { const int tk_ = tid >> 3, ch_ = tid & 7; const u32x4* src = (const u32x4*)(Q + (((size_t)b * SEQ + 64 * c + tk_) * 8 + kvh * 4) * 64 + ch_ * 32);
      LAS u32x4* dq = (LAS u32x4*)(lds + SP_Q + (tk_ * 4 + (ch_ >> 1)) * TP + (ch_ & 1) * 64);
      const u32x4 q0 = src[0], q1 = src[1], q2 = src[2], q3 = src[3]; dq[0] = q0; dq[1] = q1; dq[2] = q2; dq[3] = q3; }
    const u32x4 mk = *(const u32x4*)(SEL + (plane * SEQ + 64 * c + lane) * 4);
    const u64 mlo = (u64)mk.x | ((u64)mk.y << 32), mhi = (u64)mk.z | ((u64)mk.w << 32);
    LAS unsigned char* scr = lds + SP_SCR + wid * 64;
    const float cval = 17.0f - bnd[kvh * 4 + g4];
    const LAS float* btab = (const LAS float*)(lds + SP_END) + (kvh * 4 + g4) * XT_SEL;
    __syncthreads();
    int jn = -1, tokN0 = 0, tokN1 = 0; bool validN0 = false, validN1 = false;
#define SP_FIND(from) { jn = -1; for (int j_ = (from); j_ <= c; ++j_) { const bool bit_ = ((j_ < 64 ? mlo >> j_ : mhi >> (j_ - 64)) & 1ull) != 0ull; const u64 M_ = __ballot(bit_); \
        const int n_ = __popcll(M_), g_ = (wid - j_) & 7; \
        if (16 * g_ < n_) { const int rank_ = __builtin_amdgcn_mbcnt_hi((unsigned)(M_ >> 32), __builtin_amdgcn_mbcnt_lo((unsigned)M_, 0u)); if (bit_) scr[rank_] = (unsigned char)lane; \
            const int idx_ = 16 * g_ + slot; validN0 = idx_ < n_; validN1 = idx_ + 8 < n_; tokN0 = validN0 ? (int)scr[idx_] : 0; tokN1 = validN1 ? (int)scr[idx_ + 8] : 0; jn = j_; break; } } }
#define SP_LOAD_K() { const bf16_t* kb_ = Kp + (size_t)jn * 4096 + lane * 8; _Pragma("unroll") for (int f = 0; f < 8; ++f) kf[f] = *(const bf16x8*)(kb_ + f * 512); }
#define SP_LOAD_V() { const bf16_t* vb_ = Vp + (size_t)jn * 4096 + lane * 8; _Pragma("unroll") for (int f = 0; f < 8; ++f) vf[f] = *(const bf16x8*)(vb_ + f * 512); }
#define SP_SUB(TOK, VALID, LAST) { const int tok = (TOK); const bool valid = (VALID); const int t = 64 * c + tok; bf16x8 qf[4]; \
        { const LAS unsigned char* qr_ = lds + SP_Q + (tok * 4 + g4) * TP + hi * 16; _Pragma("unroll") for (int d0 = 0; d0 < 4; ++d0) qf[d0] = *(const LAS bf16x8*)(qr_ + d0 * 32); } \
        f32x16 p0, p1, cv; { const float cvl = valid ? cval : -INFINITY; _Pragma("unroll") for (int i = 0; i < 16; ++i) cv[i] = cvl; } \
        p0 = MFMA32(kf[0], qf[0], cv); p1 = MFMA32(kf[1], qf[0], cv); \
        _Pragma("unroll") for (int d0 = 1; d0 < 4; ++d0) { p0 = MFMA32(kf[2 * d0], qf[d0], p0); p1 = MFMA32(kf[2 * d0 + 1], qf[d0], p1); } \
        if (LAST) { __builtin_amdgcn_sched_barrier(0); SP_FIND(j + 1) if (jn >= 0) SP_LOAD_K() __builtin_amdgcn_sched_barrier(0); } \
        if (j + 2 >= c) bias_mask_x(p0, p1, btab, t, 64 * j, hi); \
        exp_tile(p0, p1); \
        f32x16 o[2], lacc; _Pragma("unroll") for (int i = 0; i < 16; ++i) { o[0][i] = 0.f; o[1][i] = 0.f; lacc[i] = 0.f; } \
        { const bf16x8 ones = (bf16x8){0x3F80, 0x3F80, 0x3F80, 0x3F80, 0x3F80, 0x3F80, 0x3F80, 0x3F80}; \
          _Pragma("unroll") for (int ks = 0; ks < 4; ++ks) { const bf16x8 pf = (ks < 2) ? pack_p(p0, ks) : pack_p(p1, ks - 2); \
              o[0] = MFMA32(vf[2 * ks], pf, o[0]); o[1] = MFMA32(vf[2 * ks + 1], pf, o[1]); lacc = MFMA32(ones, pf, lacc); } } \
        if (LAST) { __builtin_amdgcn_sched_barrier(0); if (jn >= 0) SP_LOAD_V() __builtin_amdgcn_sched_barrier(0); } \
        if (valid) { LAS int* orow = OACC + (tok * 4 + g4) * 65; \
            _Pragma("unroll") for (int dh = 0; dh < 2; ++dh) _Pragma("unroll") for (int r = 0; r < 16; ++r) \
                __hip_atomic_fetch_add(orow + 32 * dh + crow(r, hi), cvt_rpi(o[dh][r]), __ATOMIC_RELAXED, __HIP_MEMORY_SCOPE_WORKGROUP); \
            if (hi == 0) __hip_atomic_fetch_add(LACC + tok * 4 + g4, cvt_rpi(lacc[0]), __ATOMIC_RELAXED, __HIP_MEMORY_SCOPE_WORKGROUP); } }
    bf16x8 kf[8], vf[8];
    SP_FIND(0)
    if (jn >= 0) { SP_LOAD_K() SP_LOAD_V() }
    while (jn >= 0) {
        const int j = jn, t1_ = tokN1; const bool v1_ = validN1; int tcur = tokN0; bool vcur = validN0;
        const int nsub = __any(v1_) ? 2 : 1;
#pragma unroll 1
        for (int sg = 0; sg < nsub; ++sg) { const bool last = (sg == nsub - 1); SP_SUB(tcur, vcur, last) tcur = t1_; vcur = v1_; }
    }
#undef SP_FIND
#undef SP_LOAD_K
#undef SP_LOAD_V
#undef SP_SUB
    __syncthreads();
    { const int row = 32 * wid + r32; const LAS int* orow = OACC + row * 65; const int li = LACC[row];
      const float inv = li > 0 ? 1.0f / (float)li : 0.f;
      bf16_t* dst = OS + (((size_t)b * SEQ + 64 * c + (row >> 2)) * 8 + kvh * 4 + (row & 3)) * 64;
#pragma unroll
      for (int dh = 0; dh < 2; ++dh)
#pragma unroll
          for (int g = 0; g < 4; ++g) { const int d = 32 * dh + 8 * g + 4 * hi;
              u32x2 w; w.x = cvtpk((float)orow[d] * inv, (float)orow[d + 1] * inv); w.y = cvtpk((float)orow[d + 2] * inv, (float)orow[d + 3] * inv);
              *(u32x2*)(dst + d) = w; } }
}
}
namespace att {
DI void cmp_bias_half(f32x16& p, const LAS float* btab, int dbase, int hi) {
    float bv[16];
#pragma unroll
    for (int r = 0; r < 16; ++r) { const int d = dbase - 16 * crow(r, hi); bv[r] = btab[d < 0 ? 0 : (d < 128 ? d : 128)]; }
#pragma unroll
    for (int r = 0; r < 16; ++r) { const int d = dbase - 16 * crow(r, hi); p[r] = d >= 0 ? p[r] + bv[r] : -INFINITY; }
}
DI void cmp_bias_mask(f32x16& p0, f32x16& p1, const LAS float* btab, int t, int k, int hi) {
    const int base = t - 31 - 16 * 64 * k;
    cmp_bias_half(p0, btab, base, hi); asm volatile("" ::: "memory"); cmp_bias_half(p1, btab, base - 16 * 32, hi);
}
DI void qk_tile_s(f32x16& p0, f32x16& p1, const LAS unsigned char* kt, const bf16x8 (&qf)[4], float cval, int r32, int hi) {
    const LAS unsigned char* kb = kt + r32 * TP + hi * 16;
#pragma unroll
    for (int i = 0; i < 16; ++i) { p0[i] = cval; p1[i] = cval; }
#pragma unroll
    for (int d0 = 0; d0 < 4; ++d0) { const bf16x8 k0 = *(const LAS bf16x8*)(kb + d0 * 32), k1 = *(const LAS bf16x8*)(kb + 32 * TP + d0 * 32); p0 = MFMA32(k0, qf[d0], p0); p1 = MFMA32(k1, qf[d0], p1); }
}
DI void pv_tile_s(f32x16 (&o)[2], const LAS unsigned char* vt, const f32x16& p0, const f32x16& p1, int r32, int hi) {
    const LAS unsigned char* vb = vt + r32 * TP + hi * 16;
#pragma unroll
    for (int ks = 0; ks < 4; ++ks) { const bf16x8 pf = (ks < 2) ? pack_p(p0, ks) : pack_p(p1, ks - 2);
        const bf16x8 v0 = *(const LAS bf16x8*)(vb + ks * 32), v1 = *(const LAS bf16x8*)(vb + 32 * TP + ks * 32); o[0] = MFMA32(v0, pf, o[0]); o[1] = MFMA32(v1, pf, o[1]); }
}
DI void build_ovt(LAS unsigned char* lds, int tid) {
    for (int e = tid; e < 32 * 64; e += 512) { const int js = e >> 6, nl = e & 63; const int cs = 16 * nl, ss = 64 * js;
        int ov = (cs + 32 < ss + 64 ? cs + 32 : ss + 64) - (cs > ss ? cs : ss); ov = ov > 0 ? ov : 0; if (js > 16) ov = 0;
        *(LAS bf16_t*)(lds + L_OVT + js * TP + perm_kv(nl) * 2) = f2bf((float)ov * (1.0f / 32.0f)); }
}
DI void cmp_unit(LAS unsigned char* lds, int b, int kvh, int c, const bf16_t* Q, const bf16_t* KCMP, const bf16_t* VCMPT, bf16_t* OC, unsigned* SEL, const float* bnd, const int tid_) {
    int tid = tid_; asm volatile("" : "+v"(tid));
    const int lane = tid & 63, wid = __builtin_amdgcn_readfirstlane(tid >> 6), r32 = lane & 31, hi = lane >> 5;
    const int tl = 8 * wid + (r32 >> 2), g = r32 & 3, t = 64 * c + tl;
    const size_t plane = (size_t)(b * 2 + kvh);
    const bf16_t* Kp = KCMP + plane * NCMPP * 64; const bf16_t* Vp = VCMPT + plane * 64 * NCMPP;
    bf16x8 qf[4]; load_q(qf, Q + (((size_t)b * SEQ + t) * 8 + kvh * 4 + g) * 64, hi);
    const LAS float* btab = (const LAS float*)(lds + L_BIAS) + (kvh * 4 + g) * 132;
    const int nt = ((4 * c + 2) >> 6) + 1;
    f32x16 p0, p1; float l = 0.f; const float cval = -bnd[kvh * 4 + g];
    TileRegs tr;
    LAS bf16_t* raw = (LAS bf16_t*)(lds + L_IMP); LAS float* invl = (LAS float*)(lds + L_INVL);
    f32x16 o[2];
#pragma unroll
    for (int i = 0; i < 16; ++i) { o[0][i] = 0.f; o[1][i] = 0.f; }
    float carry = 0.f;
    tile_fetch(tr, Kp, 64, Vp, NCMPP, tid);
    __syncthreads();
    tile_put(tr, lds + L_K0, lds + L_V0, tid);
    __syncthreads();
    for (int k = 0; k < nt; ++k) {
        const int bsel = k & 1;
        if (k + 1 < nt) tile_fetch(tr, Kp + (size_t)(k + 1) * 64 * 64, 64, Vp + (k + 1) * 64, NCMPP, tid);
        qk_tile_c(p0, p1, lds + (bsel ? L_K1 : L_K0), qf, cval, r32, hi);
        if (64 * c < 1024 * k + 1167) cmp_bias_mask(p0, p1, btab, t, k, hi);
        float s = 0.f;
#pragma unroll
        for (int i = 0; i < 16; ++i) { p0[i] = __builtin_amdgcn_exp2f(p0[i]); p1[i] = __builtin_amdgcn_exp2f(p1[i]); s += p0[i] + p1[i]; }
        l += s;
        pv_tile_s(o, lds + (bsel ? L_V1 : L_V0), p0, p1, r32, hi);
        f32x16 im;
#pragma unroll
        for (int i = 0; i < 16; ++i) im[i] = 0.f;
        { const LAS unsigned char* ob = lds + L_OVT + r32 * TP + hi * 16;
#pragma unroll
          for (int ks = 0; ks < 4; ++ks) { const bf16x8 pf = (ks < 2) ? pack_p(p0, ks) : pack_p(p1, ks - 2); im = MFMA32(*(const LAS bf16x8*)(ob + ks * 32), pf, im); } }
        if (hi == 0) im[0] += carry;
        carry = im[8];
        { LAS bf16_t* rr_ = raw + (tl * 4 + g) * 132 + 16 * k + 4 * hi;
          u32x2 w0, w1; w0.x = cvtpk(im[0], im[1]); w0.y = cvtpk(im[2], im[3]); w1.x = cvtpk(im[4], im[5]); w1.y = cvtpk(im[6], im[7]);
          *(LAS u32x2*)rr_ = w0; *(LAS u32x2*)(rr_ + 8) = w1; }
        if (k + 1 < nt) tile_put(tr, lds + (bsel ? L_K0 : L_K1), lds + (bsel ? L_V0 : L_V1), tid);
        __syncthreads();
    }
    const float lt = l + __shfl_xor(l, 32);
    const float inv = lt > 0.f ? 1.f / lt : 0.f;
    if (hi == 0) invl[tl * 4 + g] = inv;
    store_o(o, inv, OC + (((size_t)b * SEQ + t) * 8 + kvh * 4 + g) * 64, hi);
    {
        const int ti = lane >> 3, sub = lane & 7, tk = 8 * wid + ti;
        unsigned sel16 = 0u;
        if (c < 16) { sel16 = sub == 0 ? ((2u << c) - 1u) : 0u; }
        else {
            int key[16];
            float kv[16];
#pragma unroll
            for (int k = 0; k < 16; ++k) kv[k] = 0.f;
#pragma unroll
            for (int h = 0; h < 4; ++h) { const float il = invl[tk * 4 + h]; const LAS u32x4* rp = (const LAS u32x4*)(raw + (tk * 4 + h) * 132 + 16 * sub); const u32x4 a = rp[0], b2 = rp[1];
                kv[0] += il * bflo(a.x); kv[1] += il * bfhi(a.x); kv[2] += il * bflo(a.y); kv[3] += il * bfhi(a.y); kv[4] += il * bflo(a.z); kv[5] += il * bfhi(a.z); kv[6] += il * bflo(a.w); kv[7] += il * bfhi(a.w);
                kv[8] += il * bflo(b2.x); kv[9] += il * bfhi(b2.x); kv[10] += il * bflo(b2.y); kv[11] += il * bfhi(b2.y); kv[12] += il * bflo(b2.z); kv[13] += il * bfhi(b2.z); kv[14] += il * bflo(b2.w); kv[15] += il * bfhi(b2.w); }
#pragma unroll
            for (int k = 0; k < 16; ++k) { const int j = 16 * sub + k; key[k] = (j >= 1 && j <= c - 2) ? __float_as_int(kv[k]) : -1; }
#define GRP8_SUM(v) { v += __builtin_amdgcn_mov_dpp(v, 0xB1, 0xF, 0xF, true); v += __builtin_amdgcn_mov_dpp(v, 0x4E, 0xF, 0xF, true); v += __builtin_amdgcn_mov_dpp(v, 0x141, 0xF, 0xF, true); }
            int T = 0;
#pragma unroll 1
            for (int bit = 30; bit >= 0; --bit) { const int T2 = T | (1 << bit); int cnt = 0;
#pragma unroll
                for (int k = 0; k < 16; ++k) cnt += (key[k] >= T2) ? 1 : 0;
                GRP8_SUM(cnt)
                T = cnt >= 13 ? T2 : T; }
            int ngt = 0, nt = 0;
#pragma unroll
            for (int k = 0; k < 16; ++k) { ngt += (key[k] > T) ? 1 : 0; nt += (key[k] == T) ? 1 : 0; }
            int pre = nt;
            { int s1 = __builtin_amdgcn_mov_dpp(pre, 0x111, 0xF, 0xF, true); if (sub >= 1) pre += s1;
              int s2 = __builtin_amdgcn_mov_dpp(pre, 0x112, 0xF, 0xF, true); if (sub >= 2) pre += s2;
              int s4 = __builtin_amdgcn_mov_dpp(pre, 0x114, 0xF, 0xF, true); if (sub >= 4) pre += s4; }
            GRP8_SUM(ngt)
            const int need = 13 - ngt; int run = pre - nt;
#pragma unroll
            for (int k = 0; k < 16; ++k) { const bool tie = key[k] == T; if (key[k] > T || (tie && run < need)) sel16 |= 1u << k; run += tie ? 1 : 0; }
#undef GRP8_SUM
            if (sub == 0) sel16 |= 1u;
            if (sub == ((c - 1) >> 4)) sel16 |= 1u << ((c - 1) & 15);
            if (sub == (c >> 4)) sel16 |= 1u << (c & 15);
        }
        ((unsigned short*)SEL)[((plane * SEQ + 64 * c + tk) * 8) + sub] = (unsigned short)sel16;
    }
}

DI void compress_task(int which, int plane, int n0, const bf16_t* src, const bf16_t* W1T, const float* cbias, const bf16_t* W2T, const float* kgain, bf16_t* KCMP, bf16_t* VCMPT, int lane) {
    const int r32 = lane & 31, hi = lane >> 5, n = n0 + r32;
    const bf16_t* arow = src + (size_t)plane * SEQ * 64 + (size_t)n * 16 * 64 + 8 * hi;
    const bf16_t* w0 = W1T + (size_t)r32 * 2048 + 8 * hi; const bf16_t* w1 = w0 + 32 * 2048;
    f32x16 p0, p1;
#pragma unroll
    for (int i = 0; i < 16; ++i) { p0[i] = 0.f; p1[i] = 0.f; }
#pragma unroll 1
    for (int ks = 0; ks < 128; ks += 8) {
        bf16x8 a[8], b0[8], b1[8];
#pragma unroll
        for (int j = 0; j < 8; ++j) { a[j] = *(const bf16x8*)(arow + 16 * (ks + j)); b0[j] = *(const bf16x8*)(w0 + 16 * (ks + j)); b1[j] = *(const bf16x8*)(w1 + 16 * (ks + j)); }
        __builtin_amdgcn_sched_barrier(0);
#pragma unroll
        for (int j = 0; j < 8; ++j) { p0 = MFMA32(b0[j], a[j], p0); p1 = MFMA32(b1[j], a[j], p1); }
    }
#pragma unroll
    for (int r = 0; r < 16; ++r) { p0[r] = gelu_tanh(p0[r] + cbias[crow(r, hi)]); p1[r] = gelu_tanh(p1[r] + cbias[32 + crow(r, hi)]); }
    f32x16 y[2];
#pragma unroll
    for (int i = 0; i < 16; ++i) { y[0][i] = 0.f; y[1][i] = 0.f; }
#pragma unroll
    for (int ks = 0; ks < 4; ++ks) {
        const bf16x8 pf = (ks < 2) ? pack_p(p0, ks) : pack_p(p1, ks - 2);
#pragma unroll
        for (int oh = 0; oh < 2; ++oh) {
            const bf16_t* wr_ = W2T + (size_t)(32 * oh + r32) * 64 + 16 * ks + 4 * hi;
            const u32x2 lo = *(const u32x2*)wr_, hi2 = *(const u32x2*)(wr_ + 8);
            u32x4 w; w.x = lo.x; w.y = lo.y; w.z = hi2.x; w.w = hi2.y;
            y[oh] = MFMA32(__builtin_bit_cast(bf16x8, w), pf, y[oh]);
        }
    }
    const bool dead = (n >= NCMP);
    if (which == 0) {
        float s = 0.f;
#pragma unroll
        for (int i = 0; i < 16; ++i) s += y[0][i] * y[0][i] + y[1][i] * y[1][i];
        s += __shfl_xor(s, 32);
        const float rr = dead ? 0.f : rsqrtf(s * (1.0f / 64.0f) + EPS);
        bf16_t* dst = KCMP + ((size_t)plane * NCMPP + n) * 64;
#pragma unroll
        for (int oh = 0; oh < 2; ++oh)
#pragma unroll
            for (int q = 0; q < 4; ++q) { const int d = 32 * oh + 8 * q + 4 * hi; const f32x4 gv = *(const f32x4*)(kgain + d);
                u32x2 w; w.x = cvtpk(dead ? 0.f : y[oh][4 * q] * rr * gv[0], dead ? 0.f : y[oh][4 * q + 1] * rr * gv[1]); w.y = cvtpk(dead ? 0.f : y[oh][4 * q + 2] * rr * gv[2], dead ? 0.f : y[oh][4 * q + 3] * rr * gv[3]);
                *(u32x2*)(dst + d) = w; }
    } else {
        bf16_t* dst = VCMPT + (size_t)plane * 64 * NCMPP + perm_kv(n);
#pragma unroll
        for (int oh = 0; oh < 2; ++oh)
#pragma unroll
            for (int r = 0; r < 16; ++r) dst[(size_t)(32 * oh + crow(r, hi)) * NCMPP] = dead ? (bf16_t)0 : f2bf(y[oh][r]);
    }
}
}
namespace thin {
enum { MAP_ID = 0, MAP_GLU = 1, MAP_HEAD = 2, MAP_WIN = 3 };
DI int colmap(int map, int N, int np) {
    if (map == MAP_ID) return np;
    const int pn = np >> 8, c = np & 255;
    if (map == MAP_GLU) { const int q = c >> 3, i8 = c & 7; return (i8 >> 2) * (N >> 1) + 128 * pn + 4 * q + (i8 & 3); }
    const int bj = c >> 7, wc = (c >> 5) & 3, w = c & 31, hd = 32 * bj + w;
    if (map == MAP_HEAD) return 256 * pn + 64 * wc + hd;
    if (pn == 0) return c;
    if (pn <= 2) { const int q = c >> 3, i8 = c & 7; return 256 + (i8 >> 2) * 256 + 128 * (pn - 1) + 4 * q + (i8 & 3); }
    if (pn <= 4) return 768 + (4 * (pn - 3) + wc) * 64 + hd;
    if (pn <= 7) return 1280 + 256 * (pn - 5) + (wc >> 1) * 128 + (wc & 1) * 64 + hd;
    return c < 24 ? 2048 + c : -1;
}
struct XDesc { const float* W; const float* gain; bf16_t* out; int K, N, Nout, map; int nbatch, f8; size_t wstride, ostride; };

DI void xload(const XDesc& D, int item, f32x4 (&v)[8], float (&gv)[8], int lane) {
    const int per = (D.K / 64) * (D.Nout / 32), bi = item / per, it = item % per, nblk = D.Nout / 32, kb = it / nblk, nb = it % nblk, k0 = 64 * kb, n0 = 32 * nb;
    const float* W = D.W + (size_t)bi * D.wstride;
    const int r8 = lane >> 3, q4 = (lane & 7) * 4, col = colmap(D.map, D.N, n0 + q4);
#pragma unroll
    for (int i = 0; i < 8; ++i) { const int kk = 8 * i + r8; v[i] = (f32x4){0.f, 0.f, 0.f, 0.f}; gv[i] = 1.f;
        if (col >= 0) { v[i] = *(const f32x4*)(W + (size_t)(k0 + kk) * D.N + col); if (D.gain) gv[i] = D.gain[k0 + kk]; } }
}
DI void xstore(const XDesc& D, int item, const f32x4 (&v)[8], const float (&gv)[8], LAS float* scr, int lane) {
    const int per = (D.K / 64) * (D.Nout / 32), bi = item / per, it = item % per, nblk = D.Nout / 32, kb = it / nblk, nb = it % nblk, k0 = 64 * kb, n0 = 32 * nb;
    bf16_t* O = D.out + (size_t)bi * D.ostride;
    unsigned char* O8 = (unsigned char*)D.out + (size_t)bi * D.ostride;
    const int r8 = lane >> 3, q4 = (lane & 7) * 4;
#pragma unroll
    for (int i = 0; i < 8; ++i) { const int kk = 8 * i + r8; LAS float* d = scr + kk * 33 + q4; d[0] = v[i][0] * gv[i]; d[1] = v[i][1] * gv[i]; d[2] = v[i][2] * gv[i]; d[3] = v[i][3] * gv[i]; }
    LDS_WAIT(); asm volatile("" ::: "memory");
    const int c = lane & 7;
#pragma unroll
    for (int j = 0; j < 4; ++j) { const int n = (lane >> 3) + 8 * j; const LAS float* s = scr + (8 * c) * 33 + n;
        if (D.f8) { u32x2 o; o.x = pack_fp8x4(s[0 * 33] * W8_SCALE, s[1 * 33] * W8_SCALE, s[2 * 33] * W8_SCALE, s[3 * 33] * W8_SCALE); o.y = pack_fp8x4(s[4 * 33] * W8_SCALE, s[5 * 33] * W8_SCALE, s[6 * 33] * W8_SCALE, s[7 * 33] * W8_SCALE);
            *(u32x2*)(O8 + (size_t)(n0 + n) * D.K + k0 + 8 * c) = o; }
        else { u32x4 o; o.x = cvtpk(s[0 * 33], s[1 * 33]); o.y = cvtpk(s[2 * 33], s[3 * 33]); o.z = cvtpk(s[4 * 33], s[5 * 33]); o.w = cvtpk(s[6 * 33], s[7 * 33]);
            *(u32x4*)(O + (size_t)(n0 + n) * D.K + k0 + 8 * c) = o; } }
    LDS_WAIT(); asm volatile("" ::: "memory");
}
DI void row_to_bf16_ss(const float* xrow, bf16_t* orow, u64* ss, int lane) {
    const f32x4* xr = (const f32x4*)xrow + lane; float s = 0.f; f32x4 v[4];
#pragma unroll
    for (int j = 0; j < 4; ++j) { v[j] = xr[64 * j]; s += (v[j][0] * v[j][0] + v[j][1] * v[j][1]) + (v[j][2] * v[j][2] + v[j][3] * v[j][3]); }
    s = wave_sum(s);
    u32x2* o8 = (u32x2*)orow + lane;
#pragma unroll
    for (int j = 0; j < 4; ++j) { u32x2 w; w.x = cvtpk(v[j][0], v[j][1]); w.y = cvtpk(v[j][2], v[j][3]); o8[64 * j] = w; }
    if (lane == 0) *ss = (u64)(s * SS_FIX + 0.5f);
}
DI void row2_to_bf16_ss(const float* xrow, bf16_t* orow, u64* ss, int lane) {
    const f32x4* xr = (const f32x4*)xrow + lane; float s0 = 0.f, s1 = 0.f; f32x4 v[8];
#pragma unroll
    for (int j = 0; j < 8; ++j) v[j] = xr[64 * j];
#pragma unroll
    for (int j = 0; j < 4; ++j) { s0 += (v[j][0] * v[j][0] + v[j][1] * v[j][1]) + (v[j][2] * v[j][2] + v[j][3] * v[j][3]);
        s1 += (v[4 + j][0] * v[4 + j][0] + v[4 + j][1] * v[4 + j][1]) + (v[4 + j][2] * v[4 + j][2] + v[4 + j][3] * v[4 + j][3]); }
    s0 = dpp_sum16(s0); s1 = dpp_sum16(s1);
#pragma unroll
    for (int o = 16; o < 64; o <<= 1) { s0 += __shfl_xor(s0, o); s1 += __shfl_xor(s1, o); }
    u32x2* o8 = (u32x2*)orow + lane;
#pragma unroll
    for (int j = 0; j < 8; ++j) { u32x2 w; w.x = cvtpk(v[j][0], v[j][1]); w.y = cvtpk(v[j][2], v[j][3]); o8[64 * j] = w; }
    if (lane == 0) { ss[0] = (u64)(s0 * SS_FIX + 0.5f); ss[1] = (u64)(s1 * SS_FIX + 0.5f); }
}
DI int t5_bucket(int n) {
    if (n < 16) return n;
    int large = 16 + (int)(logf((float)n / 16.0f) / 2.0794415416798357f * 16.0f);
    return large < 31 ? large : 31;
}
struct S5P { const float *lre, *lim, *ldt, *bre, *bim, *cre, *cim, *dsk; };
DI void lam_pow(const S5P& P, int g, int p, float tau, float& wr, float& wi) {
    const float dt = expf(P.ldt[g]), lr = P.lre[g * 64 + p], li = P.lim[g * 64 + p];
    const float mag = expf(lr * dt * tau); float sn, cs; sincosf(li * dt * tau, &sn, &cs); wr = mag * cs; wi = mag * sn;
}
DI void zoh_f(const S5P& P, int g, int p, float& fr, float& fi) {
    const float lr = P.lre[g * 64 + p], li = P.lim[g * 64 + p]; float ar, ai; lam_pow(P, g, p, 1.f, ar, ai);
    const float den = lr * lr + li * li; fr = ((ar - 1.f) * lr + ai * li) / den; fi = (ai * lr - (ar - 1.f) * li) / den;
}
DI void ktab_task(const S5P& P, float* ktab, int g, int tau, LAS float* scr, int lane) {
    LAS float* cs = scr + 2048;
#pragma unroll
    for (int i = 0; i < 4; ++i) { *(LAS f32x4*)(cs + 4 * lane + 256 * i) = *(const f32x4*)(P.cre + g * 1024 + 4 * lane + 256 * i); *(LAS f32x4*)(cs + 1024 + 4 * lane + 256 * i) = *(const f32x4*)(P.cim + g * 1024 + 4 * lane + 256 * i); }
    { const int p = lane; float wr, wi, fr, fi; lam_pow(P, g, p, (float)tau, wr, wi); zoh_f(P, g, p, fr, fi);
      const float gr = wr * fr - wi * fi, gi = wr * fi + wi * fr;
#pragma unroll
      for (int h = 0; h < 16; ++h) { const float br = P.bre[(g * 64 + p) * 16 + h], bi = P.bim[(g * 64 + p) * 16 + h];
          scr[(p * 16 + h) * 2] = gr * br - gi * bi; scr[(p * 16 + h) * 2 + 1] = gr * bi + gi * br; } }
    LDS_WAIT(); asm volatile("" ::: "memory");
#pragma unroll 1
    for (int k = 0; k < 4; ++k) { const int idx = lane + 64 * k, ho = idx >> 4, hi = idx & 15; float a = 0.f;
#pragma unroll 8
        for (int p = 0; p < 64; ++p) a += cs[ho * 64 + p] * scr[(p * 16 + hi) * 2] - cs[1024 + ho * 64 + p] * scr[(p * 16 + hi) * 2 + 1];
        ktab[((size_t)(g * 64 + tau) * 16 + ho) * 16 + hi] = a; }
    LDS_WAIT(); asm volatile("" ::: "memory");
}
DI void st_load8(const float* ktab, int g, int n, int k0, f32x4& a, f32x4& b) {
    const int to = n >> 4, ho = n & 15, ti = k0 >> 4, h0 = k0 & 15;
    a = (f32x4){0.f, 0.f, 0.f, 0.f}; b = a;
    if (to >= ti) { const float* kp = ktab + ((size_t)(g * 64 + (to - ti)) * 16 + ho) * 16 + h0; a = *(const f32x4*)kp; b = *(const f32x4*)(kp + 4); }
}
DI void st_store8(const S5P& P, bf16_t* ST, int g, int n, int k0, f32x4 a, f32x4 b) {
    const int to = n >> 4, ho = n & 15, ti = k0 >> 4, h0 = k0 & 15;
    if (to == ti && (ho >> 3) == (h0 >> 3)) { const float d = P.dsk[g * 16 + ho]; const int j = ho & 7;
        a[0] += (j == 0) ? d : 0.f; a[1] += (j == 1) ? d : 0.f; a[2] += (j == 2) ? d : 0.f; a[3] += (j == 3) ? d : 0.f;
        b[0] += (j == 4) ? d : 0.f; b[1] += (j == 5) ? d : 0.f; b[2] += (j == 6) ? d : 0.f; b[3] += (j == 7) ? d : 0.f; }
    u32x4 w; w.x = cvtpk(a[0], a[1]); w.y = cvtpk(a[2], a[3]); w.z = cvtpk(b[0], b[1]); w.w = cvtpk(b[2], b[3]);
    *(u32x4*)(ST + ((size_t)g * 1024 + n) * SKX + 128 + k0) = w;
}
DI void st_carry(const S5P& P, bf16_t* ST, int g, int to, int p) {
    float wr, wi; lam_pow(P, g, p, (float)(to + 1), wr, wi);
#pragma unroll 4
    for (int ho = 0; ho < 16; ++ho) { const float cr = P.cre[(g * 16 + ho) * 64 + p], ci = P.cim[(g * 16 + ho) * 64 + p];
        bf16_t* row = ST + ((size_t)g * 1024 + to * 16 + ho) * SKX;
        row[p] = f2bf(cr * wr - ci * wi); row[64 + p] = f2bf(-(cr * wi + ci * wr)); }
}
DI void sz_fill8(const S5P& P, bf16_t* SZ, int g, int n, int k0) {
    float v[8];
    if (n < 128) { const int p = n & 63, ti = k0 >> 4, h0 = k0 & 15; float wr, wi, fr, fi; lam_pow(P, g, p, (float)(63 - ti), wr, wi); zoh_f(P, g, p, fr, fi);
        const float gr = wr * fr - wi * fi, gi = wr * fi + wi * fr;
#pragma unroll
        for (int j = 0; j < 8; ++j) { const float br = P.bre[(g * 64 + p) * 16 + h0 + j], bi = P.bim[(g * 64 + p) * 16 + h0 + j]; v[j] = (n < 64) ? (gr * br - gi * bi) : (gr * bi + gi * br); }
    } else {
#pragma unroll
        for (int j = 0; j < 8; ++j) v[j] = 0.f;
    }
    u32x4 w; w.x = cvtpk(v[0], v[1]); w.y = cvtpk(v[2], v[3]); w.z = cvtpk(v[4], v[5]); w.w = cvtpk(v[6], v[7]);
    *(u32x4*)(SZ + ((size_t)g * 256 + n) * 1024 + k0) = w;
}

DI void conv_unit(LAS unsigned char* lds, int tile, const bf16_t* CVIN, const float* wdw, const float* bdw, const float* lng, const float* lnb, bf16_t* CV, const int tid) {
    const int c = tid & 255, half = tid >> 8, lane = tid & 63, wid = __builtin_amdgcn_readfirstlane(tid >> 6);
    const int row0 = tile * 64 + 32 * half, s0 = row0 & (SEQ - 1);
    LAS float* y = (LAS float*)lds;
    float w[31];
#pragma unroll
    for (int k = 0; k < 31; ++k) w[k] = wdw[k * 256 + c];
    const float bias = bdw[c];
    float v[62];
#pragma unroll
    for (int i = 0; i < 62; ++i) { const int sp = s0 - 30 + i; v[i] = sp >= 0 ? bf2f(CVIN[(size_t)(row0 - 30 + i) * 256 + c]) : 0.f; }
    __syncthreads();
#pragma unroll
    for (int tt = 0; tt < 32; ++tt) { float a = bias;
#pragma unroll
        for (int k = 0; k < 31; ++k) a += w[k] * v[tt + k];
        y[(32 * half + tt) * 256 + c] = a; }
    __syncthreads();
    const f32x4 gg = *(const f32x4*)(lng + 4 * lane), bb = *(const f32x4*)(lnb + 4 * lane);
#pragma unroll
    for (int i = 0; i < 8; ++i) { const int tk = 8 * wid + i; const f32x4 x = *(const LAS f32x4*)(y + tk * 256 + 4 * lane);
        const float mean = wave_sum((x[0] + x[1]) + (x[2] + x[3])) * (1.0f / 256.0f);
        const f32x4 d = x - mean; const float var = wave_sum((d[0] * d[0] + d[1] * d[1]) + (d[2] * d[2] + d[3] * d[3])) * (1.0f / 256.0f);
        const float rs = rsqrtf(var + EPS);
        f32x4 o = d * rs * gg + bb;
        u32x2 wv; wv.x = cvtpk(siluf_(o[0]), siluf_(o[1])); wv.y = cvtpk(siluf_(o[2]), siluf_(o[3]));
        *(u32x2*)(CV + (size_t)(tile * 64 + tk) * 256 + 4 * lane) = wv; }
}

DI void s5_combine(const float* __restrict__ a64, const float* __restrict__ ZC, bf16_t* __restrict__ UX, int gt) {
    const int p = gt & 63, g = (gt >> 6) & 15, b = gt >> 10;
    const float ar = a64[(g * 64 + p) * 2], ai = a64[(g * 64 + p) * 2 + 1];
    float xr = 0.f, xi = 0.f;
    const size_t ch0 = (size_t)g * NCHUNK + b * 128;
    float zr[2][16], zi[2][16];
#pragma unroll
    for (int j = 0; j < 16; ++j) { zr[0][j] = ZC[(ch0 + j) * 128 + p]; zi[0][j] = ZC[(ch0 + j) * 128 + 64 + p]; }
#pragma unroll
    for (int c8 = 0; c8 < 8; ++c8) {
        if (c8 < 7) {
#pragma unroll
            for (int j = 0; j < 16; ++j) { const size_t ch = ch0 + 16 * (c8 + 1) + j; zr[(c8 + 1) & 1][j] = ZC[ch * 128 + p]; zi[(c8 + 1) & 1][j] = ZC[ch * 128 + 64 + p]; }
        }
#pragma unroll
        for (int j = 0; j < 16; ++j) { const size_t ch = ch0 + 16 * c8 + j;
            UX[ch * SKX + p] = f2bf(xr); UX[ch * SKX + 64 + p] = f2bf(xi);
            const float nr = ar * xr - ai * xi + zr[c8 & 1][j], ni = ar * xi + ai * xr + zi[c8 & 1][j]; xr = nr; xi = ni; }
    }
}

template <bool F8OUT> DI void mixnorm_row2(int row, const bf16_t* YSSM, const bf16_t* YCONV, const bf16_t* OC, const bf16_t* OS, const bf16_t* OW, const float* GATE, bf16_t* AMIX, int lane) {
    u32x4 q[2][6]; float gt[2][3];
#pragma unroll
    for (int t = 0; t < 2; ++t) {
        if (lane < 32) { const bf16_t* src = (lane < 16 ? YSSM : YCONV) + (size_t)(row + t) * 256 + 16 * (lane & 15); q[t][0] = *(const u32x4*)src; q[t][1] = *(const u32x4*)(src + 8); }
        else { const int head = (lane - 32) >> 2; const size_t off = (size_t)(row + t) * 512 + 16 * (lane - 32);
            gt[t][0] = GATE[(size_t)(row + t) * 24 + head * 3]; gt[t][1] = GATE[(size_t)(row + t) * 24 + head * 3 + 1]; gt[t][2] = GATE[(size_t)(row + t) * 24 + head * 3 + 2];
            q[t][0] = *(const u32x4*)(OC + off); q[t][1] = *(const u32x4*)(OS + off); q[t][2] = *(const u32x4*)(OW + off);
            q[t][3] = *(const u32x4*)(OC + off + 8); q[t][4] = *(const u32x4*)(OS + off + 8); q[t][5] = *(const u32x4*)(OW + off + 8); }
    }
#pragma unroll
    for (int t = 0; t < 2; ++t) {
        float v[16];
        if (lane < 32) { const u32x4 a = q[t][0], b = q[t][1];
            v[0] = bflo(a.x); v[1] = bfhi(a.x); v[2] = bflo(a.y); v[3] = bfhi(a.y); v[4] = bflo(a.z); v[5] = bfhi(a.z); v[6] = bflo(a.w); v[7] = bfhi(a.w);
            v[8] = bflo(b.x); v[9] = bfhi(b.x); v[10] = bflo(b.y); v[11] = bfhi(b.y); v[12] = bflo(b.z); v[13] = bfhi(b.z); v[14] = bflo(b.w); v[15] = bfhi(b.w);
        } else { const float g0 = gt[t][0], g1 = gt[t][1], g2 = gt[t][2];
#pragma unroll
            for (int h8 = 0; h8 < 2; ++h8) { const u32x4 a = q[t][3 * h8], b = q[t][3 * h8 + 1], c = q[t][3 * h8 + 2];
                v[8 * h8 + 0] = g0 * bflo(a.x) + g1 * bflo(b.x) + g2 * bflo(c.x); v[8 * h8 + 1] = g0 * bfhi(a.x) + g1 * bfhi(b.x) + g2 * bfhi(c.x);
                v[8 * h8 + 2] = g0 * bflo(a.y) + g1 * bflo(b.y) + g2 * bflo(c.y); v[8 * h8 + 3] = g0 * bfhi(a.y) + g1 * bfhi(b.y) + g2 * bfhi(c.y);
                v[8 * h8 + 4] = g0 * bflo(a.z) + g1 * bflo(b.z) + g2 * bflo(c.z); v[8 * h8 + 5] = g0 * bfhi(a.z) + g1 * bfhi(b.z) + g2 * bfhi(c.z);
                v[8 * h8 + 6] = g0 * bflo(a.w) + g1 * bflo(b.w) + g2 * bflo(c.w); v[8 * h8 + 7] = g0 * bfhi(a.w) + g1 * bfhi(b.w) + g2 * bfhi(c.w); }
        }
        float s = 0.f;
#pragma unroll
        for (int i = 0; i < 16; ++i) s += v[i] * v[i];
        s = dpp_sum16(s);
        const float s16 = __shfl_xor(s, 16);
        const float tot = lane < 32 ? s : s + s16;
        const float rs = rsqrtf(tot * (lane < 32 ? 1.0f / 256.0f : 1.0f / 512.0f) + EPS);
        if constexpr (F8OUT) {
        u32x4 w8; w8.x = pack_fp8x4(v[0] * rs, v[1] * rs, v[2] * rs, v[3] * rs); w8.y = pack_fp8x4(v[4] * rs, v[5] * rs, v[6] * rs, v[7] * rs);
        w8.z = pack_fp8x4(v[8] * rs, v[9] * rs, v[10] * rs, v[11] * rs); w8.w = pack_fp8x4(v[12] * rs, v[13] * rs, v[14] * rs, v[15] * rs);
        *(u32x4*)((unsigned char*)AMIX + (size_t)(row + t) * 1024 + 16 * lane) = w8;
        } else {
        u32x4 w0, w1; w0.x = cvtpk(v[0] * rs, v[1] * rs); w0.y = cvtpk(v[2] * rs, v[3] * rs); w0.z = cvtpk(v[4] * rs, v[5] * rs); w0.w = cvtpk(v[6] * rs, v[7] * rs);
        w1.x = cvtpk(v[8] * rs, v[9] * rs); w1.y = cvtpk(v[10] * rs, v[11] * rs); w1.z = cvtpk(v[12] * rs, v[13] * rs); w1.w = cvtpk(v[14] * rs, v[15] * rs);
        bf16_t* dst = AMIX + (size_t)(row + t) * 1024 + 16 * lane; *(u32x4*)dst = w0; *(u32x4*)(dst + 8) = w1; }
    }
}
}
namespace moe {
using pg8::Unit;
constexpr int NCHK = 256, CHKT = 256;
struct Route { int* counts; int* startp; int* tok_e; int* tok_rank; float* tok_g; int* row_tok; float* row_gate; };
constexpr int L_WRT = 0  , L_LE = 32768  , L_CNT = 0  , L_SP = 16384  , L_TOT = 16384 + 128  ;

DI void load_router(LAS unsigned char* lds, const float* wr, const float* gain, int tid) {
    LAS float* wrt = (LAS float*)(lds + L_WRT);
    float wv[16], gv[16];
#pragma unroll
    for (int q = 0; q < 16; ++q) { const int i = tid + 512 * q; wv[q] = wr[i]; gv[q] = gain[i >> 3]; }
#pragma unroll
    for (int q = 0; q < 16; ++q) { const int i = tid + 512 * q, k = i >> 3, e = i & 7; wrt[e * 1024 + k] = wv[q] * gv[q]; }
}
DI void route1_chunk(LAS unsigned char* lds, int chunk, const bf16_t* H, const u64* ss, const Route& R, const int tid) {
    const int lane = tid & 63, wid = __builtin_amdgcn_readfirstlane(tid >> 6);
    const LAS float* wrt = (const LAS float*)(lds + L_WRT); LAS int* le = (LAS int*)(lds + L_LE);
    u32x2 qa[4], qb[4];
    { const int tok0 = chunk * CHKT + 32 * wid;
#pragma unroll
      for (int j = 0; j < 4; ++j) { qa[j] = *(const u32x2*)(H + (size_t)tok0 * DM + 4 * lane + 256 * j); qb[j] = *(const u32x2*)(H + (size_t)(tok0 + 1) * DM + 4 * lane + 256 * j); } }
    for (int i = 0; i < 32; i += 2) {
        const int tok = chunk * CHKT + 32 * wid + i;
        f32x4 ha[4], hb[4];
#pragma unroll
        for (int j = 0; j < 4; ++j) { ha[j] = (f32x4){bflo(qa[j].x), bfhi(qa[j].x), bflo(qa[j].y), bfhi(qa[j].y)}; hb[j] = (f32x4){bflo(qb[j].x), bfhi(qb[j].x), bflo(qb[j].y), bfhi(qb[j].y)}; }
        { const int tn = (i + 2 < 32) ? tok + 2 : tok;
#pragma unroll
          for (int j = 0; j < 4; ++j) { qa[j] = *(const u32x2*)(H + (size_t)tn * DM + 4 * lane + 256 * j); qb[j] = *(const u32x2*)(H + (size_t)(tn + 1) * DM + 4 * lane + 256 * j); } }
        const float rsa = rsqrtf((float)ss[tok] * (1.0f / (SS_FIX * 1024.0f)) + EPS), rsb = rsqrtf((float)ss[tok + 1] * (1.0f / (SS_FIX * 1024.0f)) + EPS);
        float la[8], lb[8];
#pragma unroll
        for (int e = 0; e < 8; ++e) { la[e] = 0.f; lb[e] = 0.f; }
#pragma unroll
        for (int j = 0; j < 4; ++j)
#pragma unroll
            for (int e = 0; e < 8; ++e) { const f32x4 wv = *(const LAS f32x4*)(wrt + e * 1024 + 4 * lane + 256 * j);
                la[e] += (ha[j][0] * wv[0] + ha[j][1] * wv[1]) + (ha[j][2] * wv[2] + ha[j][3] * wv[3]); lb[e] += (hb[j][0] * wv[0] + hb[j][1] * wv[1]) + (hb[j][2] * wv[2] + hb[j][3] * wv[3]); }
#pragma unroll
        for (int e = 0; e < 8; ++e) { la[e] = dpp_sum16(la[e]); lb[e] = dpp_sum16(lb[e]); }
#pragma unroll
        for (int o_ = 16; o_ < 64; o_ <<= 1)
#pragma unroll
            for (int e = 0; e < 8; ++e) { la[e] += __shfl_xor(la[e], o_); lb[e] += __shfl_xor(lb[e], o_); }
#pragma unroll
        for (int tt = 0; tt < 2; ++tt) {
            float lg[8];
#pragma unroll
            for (int e = 0; e < 8; ++e) lg[e] = tt ? lb[e] * rsb : la[e] * rsa;
            int e0 = 0; float v0 = lg[0];
#pragma unroll
            for (int e = 1; e < 8; ++e) if (lg[e] > v0) { v0 = lg[e]; e0 = e; }
            int e1 = -1; float v1 = -INFINITY;
#pragma unroll
            for (int e = 0; e < 8; ++e) if (e != e0 && (e1 < 0 || lg[e] > v1)) { v1 = lg[e]; e1 = e; }
            const float g0 = 1.f / (1.f + __expf(v1 - v0));
            if (lane == 0) { le[32 * wid + i + tt] = e0 | (e1 << 8); R.tok_g[(size_t)(tok + tt) * 2] = g0; R.tok_g[(size_t)(tok + tt) * 2 + 1] = 1.f - g0; }
        }
    }
    __syncthreads();
    if (wid == 0) {
#pragma unroll
        for (int s = 0; s < 2; ++s) {
            int run = 0;
            for (int rd = 0; rd < 4; ++rd) { const int tl = 64 * rd + lane, es = (le[tl] >> (8 * s)) & 0xff; int rank = 0;
#pragma unroll
                for (int e = 0; e < 8; ++e) { const u64 mk = __ballot(es == e); const int before = __popcll(mk & ((1ull << lane) - 1ull)), tot = __popcll(mk);
                    const int re = __shfl(run, e); if (es == e) rank = re + before; if (lane == e) run += tot; }
                const int tok = chunk * CHKT + tl; R.tok_e[(size_t)s * MTOK + tok] = es; R.tok_rank[(size_t)s * MTOK + tok] = rank; }
            if (lane < 8) R.counts[(chunk * 2 + s) * 8 + lane] = run;
        }
    }
    __syncthreads();
}
DI void route2(LAS unsigned char* lds, const Route& R, int G, const int tid) {
    LAS int* cnt = (LAS int*)(lds + L_CNT); LAS int* sp = (LAS int*)(lds + L_SP); LAS int* tot = (LAS int*)(lds + L_TOT);
    __syncthreads();
    { int cv[8];
#pragma unroll
      for (int q = 0; q < 8; ++q) cv[q] = R.counts[tid + 512 * q];
#pragma unroll
      for (int q = 0; q < 8; ++q) cnt[tid + 512 * q] = cv[q]; }
    __syncthreads();
    LAS int* seg = (LAS int*)(lds + L_SP + 256);
    { const int col = tid & 15, sg = tid >> 4; int run = 0;
#pragma unroll
      for (int k = 0; k < 8; ++k) { const int ix = (8 * sg + k) * 16 + col; const int v = cnt[ix]; cnt[ix] = run; run += v; }
      seg[sg * 16 + col] = run; }
    __syncthreads();
    if (tid < 16) { int a = 0; for (int sg = 0; sg < 32; ++sg) { const int v = seg[sg * 16 + tid]; seg[sg * 16 + tid] = a; a += v; } tot[tid] = a; }
    __syncthreads();
    if (tid < 2) { int a = 0; for (int e = 0; e < 8; ++e) { sp[tid * 16 + e] = a; a += (tot[tid * 8 + e] + 255) & ~255; } sp[tid * 16 + 8] = a;
        if (blockIdx.x == 0) for (int e = 0; e < 9; ++e) R.startp[tid * 16 + e] = sp[tid * 16 + e]; }
    __syncthreads();
    for (int chunk = blockIdx.x; chunk < NCHK; chunk += G) {
        if (tid < CHKT) { const int tok = chunk * CHKT + tid;
#pragma unroll
            for (int s = 0; s < 2; ++s) { const int e = R.tok_e[(size_t)s * MTOK + tok]; const int dest = sp[s * 16 + e] + seg[(chunk >> 3) * 16 + s * 8 + e] + cnt[chunk * 16 + s * 8 + e] + R.tok_rank[(size_t)s * MTOK + tok];
                R.row_tok[(size_t)s * MOEROWS + dest] = tok; R.row_gate[(size_t)s * MOEROWS + dest] = R.tok_g[(size_t)tok * 2 + s]; } }
    }
    if (blockIdx.x < 16) { const int s = blockIdx.x >> 3, e = blockIdx.x & 7; const int lo = sp[s * 16 + e] + tot[s * 8 + e], hi = sp[s * 16 + e + 1];
        for (int r = lo + tid; r < hi; r += 512) { R.row_tok[(size_t)s * MOEROWS + r] = -1; R.row_gate[(size_t)s * MOEROWS + r] = 0.f; } }
}
DI void gather_rows(const Route& R, int s, const unsigned char* H8, unsigned char* XB8, int gw, int NGW, int lane) {
    const int nrows = R.startp[s * 16 + 8], per = (nrows + NGW - 1) / NGW, lo = gw * per, hi = (lo + per < nrows) ? lo + per : nrows;
    for (int r0 = lo; r0 < hi; r0 += 11) {
        const int tv = (lane < 11 && r0 + lane < hi) ? R.row_tok[(size_t)s * MOEROWS + r0 + lane] : -1;
        u32x4 a[11];
#pragma unroll
        for (int j = 0; j < 11; ++j) { const int tok = __builtin_amdgcn_readlane(tv, j); a[j] = ((const u32x4*)(H8 + (size_t)(tok < 0 ? 0 : tok) * DM))[lane];
            if (tok < 0) a[j] = (u32x4){0u, 0u, 0u, 0u}; }
#pragma unroll
        for (int j = 0; j < 11; ++j) if (r0 + j < hi) ((u32x4*)(XB8 + (size_t)(r0 + j) * DM))[lane] = a[j];
    }
}
struct MoeOrder {
    int nN, G, c, T; int s1, s2, s3, s4, s5, s6, s7; const char* A; const char* B; size_t tA, tB, eB;
    DI void init(const int* startp, int nN_, int G_, int c_, const void* A_, size_t tA_, const void* B_, size_t tB_, size_t eB_) {
        nN = nN_; G = G_; c = c_; A = (const char*)A_; B = (const char*)B_; tA = tA_; tB = tB_; eB = eB_;
        s1 = startp[1]; s2 = startp[2]; s3 = startp[3]; s4 = startp[4]; s5 = startp[5]; s6 = startp[6]; s7 = startp[7]; T = startp[8] >> 8; }
    DI bool next(int i, Unit& u) const {
        if ((G & 7) == 0) {
            const int x = c & 7, lc = c >> 3, GL = G >> 3;
            const int r0 = (x * T) >> 3, r1 = ((x + 1) * T) >> 3, nr = r1 - r0;
            const int Lx = i * GL + lc; if (Lx >= nr * nN) return false;
            const int nig = 8 * nN, gid = Lx / nig, fm = gid * 8, gsz = (nr - fm) < 8 ? (nr - fm) : 8, w = Lx - gid * nig;
            u.pm = r0 + fm + (w % gsz); u.pn = w / gsz;
        } else {
            const long L = (long)i * G + c; if (L >= (long)T * nN) return false;
            u.pm = (int)(L / nN); u.pn = (int)(L % nN);
        }
        const int r = u.pm << 8;
        const int e = (r >= s1) + (r >= s2) + (r >= s3) + (r >= s4) + (r >= s5) + (r >= s6) + (r >= s7);
        u.g = e; u.A = A + (size_t)u.pm * tA; u.B = B + (size_t)e * eB + (size_t)u.pn * tB; return true;
    }
};
}
#ifndef MK_N_LAUNCHES
#define MK_N_LAUNCHES 1
#endif
#ifndef REP_SEL
#define REP_SEL 1
#endif
#ifndef REP_ATT
#define REP_ATT 1
#endif
#ifndef REP_GEMM
#define REP_GEMM 1
#endif
#ifndef REP_UP
#define REP_UP 1
#endif
#ifndef REP_PRO
#define REP_PRO 1
#endif
#ifndef REP_WIN
#define REP_WIN 1
#endif
#ifndef REP_CMP
#define REP_CMP 1
#endif
#ifndef REP_MIX
#define REP_MIX 1
#endif
#ifndef REP_GA
#define REP_GA 1
#endif
#ifndef REP_X
#define REP_X 1
#endif
#ifndef REP_FILL
#define REP_FILL 1
#endif
#ifndef REP_KT
#define REP_KT 1
#endif
#ifndef TAIL_R
#define TAIL_R 2
#endif
#ifndef REP_THIN
#define REP_THIN 1
#endif
constexpr int NWAVES = 8, NTHR = 512;
constexpr int LDS_MISC = 131072, LDS_BYTES = 147456;
constexpr int PH_PER_LAYER = 17, N_PHASES = 2 + NLAYER * PH_PER_LAYER;
enum { I_X = 0, I_MEM, I_NORM_MIX, I_W_IN, I_LRE, I_LIM, I_LDT, I_BRE, I_BIM, I_CRE, I_CIM, I_DSK, I_WGLU, I_CWDW, I_CBDW, I_CLNG, I_CLNB, I_CWPW, I_QNORM, I_KNORM, I_CPE, I_CW1, I_CW2,
       I_MIXNORM, I_WOUT, I_T5, I_NCROSS, I_NMEM, I_XWQ, I_XWKV, I_XQN, I_XKN, I_XWO, I_NFFN, I_FUP, I_FDN, I_ROUTER, I_MUP, I_MDN, N_IN };
constexpr int xt_cnt(int nb, int K, int Nout) { return nb * (K / 64) * (Nout / 32); }
constexpr int XT_LAYER = xt_cnt(1, DM, PROJP) + xt_cnt(1, 256, 512) + xt_cnt(1, 256, 256) + xt_cnt(1, DM, DM) + xt_cnt(1, DM, XW) + xt_cnt(1, DM, 2 * XW) + xt_cnt(1, XW, DM) + xt_cnt(2, 2048, 64) + xt_cnt(2, 64, 64);
constexpr int XT_TOTAL = NLAYER * XT_LAYER + xt_cnt(1, DM, 2 * DFF) + xt_cnt(1, DFF, DM) + xt_cnt(NEXP, DM, 2 * DFF) + xt_cnt(NEXP, DFF, DM);
struct Args { const float* in[N_IN]; float* out; unsigned char* ws; int ph_lo, ph_hi; };
typedef const Args __attribute__((address_space(4)))* ArgsP;

#define UX ((bf16_t*)(ws + A_UX))
#define CVIN ((bf16_t*)(ws + A_CVIN))
#define Q ((bf16_t*)(ws + A_Q))
#define KC ((bf16_t*)(ws + A_KC))
#define VC ((bf16_t*)(ws + A_VC))
#define KS ((bf16_t*)(ws + A_KS))
#define KW ((bf16_t*)(ws + A_KW))
#define VST ((bf16_t*)(ws + A_VST))
#define VWT ((bf16_t*)(ws + A_VWT))
#define OC ((bf16_t*)(ws + A_OC))
#define OS ((bf16_t*)(ws + A_OS))
#define OW ((bf16_t*)(ws + A_OW))
#define YG ((bf16_t*)(ws + A_YG))
#define YSSM ((bf16_t*)(ws + A_YSSM))
#define CV ((bf16_t*)(ws + A_CV))
#define YCONV ((bf16_t*)(ws + A_YCONV))
#define KCMP ((bf16_t*)(ws + A_KCMP))
#define VCMPT ((bf16_t*)(ws + A_VCMPT))
#define AMIX ((bf16_t*)(ws + A_AMIX))
#define QX ((bf16_t*)(ws + A_QX))
#define OX ((bf16_t*)(ws + A_OX))
#define FFA ((bf16_t*)(ws + A_FFA))
#define XB ((bf16_t*)(ws + A_XB))
#define GATE ((float*)(ws + A_GATE))
#define ZC ((float*)(ws + A_ZC))
#define SEL ((unsigned*)(ws + A_SEL))
#define HB ((bf16_t*)(ws + WS_HB))
#define SS ((u64*)(ws + CTL_SS))
#define SSMEM ((u64*)(ws + CTL_SSMEM))
__global__ void __launch_bounds__(NTHR, 2) trunk_fwd(Args args) {
    extern __shared__ __attribute__((aligned(16))) unsigned char lds_raw[];
    LAS unsigned char* lds = (LAS unsigned char*)lds_raw;
    volatile LAS unsigned* MISC = (volatile LAS unsigned*)(lds + LDS_MISC);
    const int tid0 = threadIdx.x; const int wid0 = __builtin_amdgcn_readfirstlane(tid0 >> 6);
#define PHASE_IDS int bid = blockIdx.x, G = gridDim.x; asm volatile("" : "+s"(bid), "+s"(G)); const int NGW = G * NWAVES; (void)NGW; int lane; asm volatile("v_mbcnt_lo_u32_b32 %0, -1, 0\n\tv_mbcnt_hi_u32_b32 %0, -1, %0" : "=v"(lane)); const int wid = wid0, tid = wid * 64 + lane, gw = bid * NWAVES + wid; (void)gw; ArgsP ap = (ArgsP)__builtin_amdgcn_kernarg_segment_ptr(); asm volatile("" : "+s"(ap)); unsigned char* const ws = ap->ws; float* const out = ap->out; (void)out;
    if (tid0 < 64) MISC[tid0] = 0u;
    __syncthreads();
    XcdBarrier bar; bar.bar = (unsigned*)(args.ws + CTL_BAR); bar.x = 0; bar.st = nullptr;
    if (MK_N_LAUNCHES == 1) bar = xcd_barrier_post((unsigned*)(args.ws + CTL_BAR), MISC + 8);
    const int lo = args.ph_lo, hi = args.ph_hi;
#ifndef ONLY
#define ONLY -1
#endif
#define PHON(k) (ONLY < 0 || ONLY == (k))
#define IN(k) (lo <= (k) && (k) < hi)
#define SEAM(k) do { if (IN(k) && IN((k) + 1)) xcd_barrier(bar); } while (0)

    for (int rep0 = 0; rep0 < REP_PRO; ++rep0) if (IN(0) && PHON(100)) { PHASE_IDS
        LAS float* scr = (LAS float*)(lds + wid * 16384);
#define XD(W_, gain_, out_, K_, N_, Nout_, map_, nb_, wst_, ost_) { constexpr int cnt_ = (nb_) * ((K_) / 64) * ((Nout_) / 32); \
            if (!found_) { if (r < cnt_) { dsel = thin::XDesc{(W_), (gain_), (bf16_t*)(out_), (K_), (N_), (Nout_), (map_), (nb_), XF8, (size_t)(wst_), (size_t)(ost_)}; found_ = true; } else r -= cnt_; } }
        auto pick = [&](int it_, thin::XDesc& dsel, int& r) { r = it_; bool found_ = false;
#define XF8 0
#pragma unroll
            for (int L = 0; L < NLAYER; ++L) {
                XD(ap->in[I_W_IN] + (size_t)L * DM * PROJW, ap->in[I_NORM_MIX] + L * DM, ws + W_IN + (size_t)L * PROJP * DM * 2, DM, PROJW, PROJP, thin::MAP_WIN, 1, 0, 0)
                XD(ap->in[I_WGLU] + (size_t)L * 256 * 512, nullptr, ws + W_GLU + (size_t)L * 512 * 256 * 2, 256, 512, 512, thin::MAP_GLU, 1, 0, 0)
                XD(ap->in[I_CWPW] + (size_t)L * 256 * 256, nullptr, ws + W_PW + (size_t)L * 256 * 256 * 2, 256, 256, 256, thin::MAP_ID, 1, 0, 0)
                if ((WOUT_F8 >> L) & 1) {
#undef XF8
#define XF8 1
                XD(ap->in[I_WOUT] + (size_t)L * DM * DM, ap->in[I_MIXNORM] + L * DM, ws + W_OUT + (size_t)L * DM * DM * 2, DM, DM, DM, thin::MAP_ID, 1, 0, 0)
#undef XF8
#define XF8 0
                } else {
                XD(ap->in[I_WOUT] + (size_t)L * DM * DM, ap->in[I_MIXNORM] + L * DM, ws + W_OUT + (size_t)L * DM * DM * 2, DM, DM, DM, thin::MAP_ID, 1, 0, 0)
                }
                XD(ap->in[I_XWQ] + (size_t)L * DM * XW, ap->in[I_NCROSS] + L * DM, ws + W_XQ + (size_t)L * XW * DM * 2, DM, XW, XW, thin::MAP_HEAD, 1, 0, 0)
                XD(ap->in[I_XWKV] + (size_t)L * DM * 2 * XW, ap->in[I_NMEM] + L * DM, ws + W_XKV + (size_t)L * 2 * XW * DM * 2, DM, 2 * XW, 2 * XW, thin::MAP_HEAD, 1, 0, 0)
                XD(ap->in[I_XWO] + (size_t)L * XW * DM, nullptr, ws + W_XO + (size_t)L * DM * XW * 2, XW, DM, DM, thin::MAP_ID, 1, 0, 0)
                XD(ap->in[I_CW1] + (size_t)L * 2 * 2048 * 64, nullptr, ws + W_C1 + (size_t)L * 2 * 64 * 2048 * 2, 2048, 64, 64, thin::MAP_ID, 2, 2048 * 64, 64 * 2048)
                XD(ap->in[I_CW2] + (size_t)L * 2 * 64 * 64, nullptr, ws + W_C2 + (size_t)L * 2 * 64 * 64 * 2, 64, 64, 64, thin::MAP_ID, 2, 64 * 64, 64 * 64)
            }
#undef XF8
#define XF8 1
            XD(ap->in[I_FUP], ap->in[I_NFFN], ws + W_UP, DM, 2 * DFF, 2 * DFF, thin::MAP_GLU, 1, 0, 0)
            XD(ap->in[I_FDN], nullptr, ws + W_DN, DFF, DM, DM, thin::MAP_ID, 1, 0, 0)
            XD(ap->in[I_MUP], ap->in[I_NFFN] + DM, ws + W_MUP, DM, 2 * DFF, 2 * DFF, thin::MAP_GLU, NEXP, (size_t)DM * 2 * DFF, (size_t)2 * DFF * DM)
            XD(ap->in[I_MDN], nullptr, ws + W_MDN, DFF, DM, DM, thin::MAP_ID, NEXP, (size_t)DFF * DM, (size_t)DM * DFF)
#undef XF8
        };
        for (int it = gw; it < XT_TOTAL; it += 2 * NGW) {
            thin::XDesc dA{}, dB{}; int rA, rB; const bool hasB = it + NGW < XT_TOTAL;
            pick(it, dA, rA); pick(hasB ? it + NGW : it, dB, rB);
            f32x4 vA[8], vB[8]; float gA[8], gB[8];
            thin::xload(dA, rA, vA, gA, lane); thin::xload(dB, rB, vB, gB, lane);
            thin::xstore(dA, rA, vA, gA, scr, lane);
            if (hasB) thin::xstore(dB, rB, vB, gB, scr, lane);
        }
#undef XD
        for (int repx = 0; repx < REP_X; ++repx) for (int r = 2 * gw; r < MTOK; r += 2 * NGW) thin::row2_to_bf16_ss(ap->in[I_X] + (size_t)r * DM, HB + (size_t)r * DM, SS + r, lane);
        for (int r = gw; r < MMEM; r += NGW) thin::row_to_bf16_ss(ap->in[I_MEM] + (size_t)r * DM, (bf16_t*)(ws + T_MEMB) + (size_t)r * DM, SSMEM + r, lane);
        for (int o = gw; o < 256; o += NGW) {
            const int lk = o >> 6, u = o & 63; const float* pe = ap->in[I_CPE] + (size_t)lk * 2048; const float* w1 = ap->in[I_CW1] + (size_t)lk * 2048 * 64; float a = 0.f;
#pragma unroll 1
            for (int k0 = 0; k0 < 2048; k0 += 1024) {
                float pv[16], wv[16];
#pragma unroll
                for (int i = 0; i < 16; ++i) { const int k = k0 + lane + 64 * i; pv[i] = pe[k]; wv[i] = w1[(size_t)k * 64 + u]; }
#pragma unroll
                for (int i = 0; i < 16; ++i) a += pv[i] * wv[i]; }
            a = wave_sum(a); if (lane == 0) ((float*)(ws + T_CB))[o] = a; }
        if (bid == 1 && tid < 64) {
            const int L = tid >> 5, br = (tid >> 3) & 3, h = tid & 7; float G = 0.f, bmax = 0.f;
            if (br < 3) { for (int d = 0; d < 64; ++d) G = fmaxf(G, fabsf(ap->in[I_QNORM][L * 64 + d] * ap->in[I_KNORM][L * 192 + br * 64 + d]));
                for (int d = 0; d <= 128; ++d) bmax = fmaxf(bmax, (ap->in[I_T5][thin::t5_bucket(d) * 8 + h] - ap->in[I_T5][31 * 8 + h]) * LOG2E); }
            else { for (int d = 0; d < 64; ++d) G = fmaxf(G, fabsf(ap->in[I_XQN][L * 64 + d] * ap->in[I_XKN][L * 64 + d])); }
            ((float*)(ws + T_BND))[tid] = QSCALE * 64.0f * G * 1.001f + bmax; }
        if (bid == 0) for (int i = tid; i < 8 * 132; i += NTHR) { const int h = i / 132, d = i % 132; ((float*)(ws + T_BIAS))[i] = (ap->in[I_T5][thin::t5_bucket(d < 128 ? d : 128) * 8 + h] - ap->in[I_T5][31 * 8 + h]) * LOG2E; }
        for (int repk = 0; repk < REP_KT; ++repk) for (int tk = gw; tk < 2 * 16 * 64; tk += NGW) { const int L = tk >> 10, g = (tk >> 6) & 15, tau = tk & 63;
            const thin::S5P P{ap->in[I_LRE] + L * 1024, ap->in[I_LIM] + L * 1024, ap->in[I_LDT] + L * 16, ap->in[I_BRE] + L * 16384, ap->in[I_BIM] + L * 16384, ap->in[I_CRE] + L * 16384, ap->in[I_CIM] + L * 16384, ap->in[I_DSK] + L * 256};
            thin::ktab_task(P, (float*)(ws + T_KTAB) + (size_t)L * 16 * 64 * 256, g, tau, scr, lane); }
        for (int i = bid * NTHR + tid; i < 2 * 1024; i += G * NTHR) { const int L = i >> 10, g = (i >> 6) & 15, p = i & 63;
            const thin::S5P P{ap->in[I_LRE] + L * 1024, ap->in[I_LIM] + L * 1024, ap->in[I_LDT] + L * 16, nullptr, nullptr, nullptr, nullptr, nullptr};
            float wr, wi; thin::lam_pow(P, g, p, 64.f, wr, wi); ((float*)(ws + T_A64))[i * 2] = wr; ((float*)(ws + T_A64))[i * 2 + 1] = wi; }
    }
    SEAM(0);
    if (IN(1) && PHON(101)) { PHASE_IDS
        for (int i0 = bid * NTHR + tid; i0 < 2 * 16 * 1024 * 128; i0 += 4 * G * NTHR) {
            f32x4 fa[4], fb[4];
#pragma unroll
            for (int q = 0; q < 4; ++q) { const int i = i0 + q * G * NTHR; fa[q] = (f32x4){0.f, 0.f, 0.f, 0.f}; fb[q] = fa[q];
                if (i < 2 * 16 * 1024 * 128) { const int k8 = i & 127, r = i >> 7, n = r & 1023, g = (r >> 10) & 15, L = r >> 14; if (8 * k8 < 256 * ((n >> 8) + 1)) thin::st_load8((const float*)(ws + T_KTAB) + (size_t)L * 16 * 64 * 256, g, n, 8 * k8, fa[q], fb[q]); } }
#pragma unroll
            for (int q = 0; q < 4; ++q) { const int i = i0 + q * G * NTHR;
                if (i < 2 * 16 * 1024 * 128) { const int k8 = i & 127, r = i >> 7, n = r & 1023, g = (r >> 10) & 15, L = r >> 14;
                    const thin::S5P P{nullptr, nullptr, nullptr, nullptr, nullptr, nullptr, nullptr, ap->in[I_DSK] + L * 256};
                    if (8 * k8 < 256 * ((n >> 8) + 1))
                    thin::st_store8(P, (bf16_t*)(ws + W_ST) + (size_t)L * 16 * 1024 * SKX, g, n, 8 * k8, fa[q], fb[q]); } } }
        for (int rep = 0; rep < REP_FILL; ++rep) for (int i = bid * NTHR + tid; i < 2 * 16 * 64 * 64; i += G * NTHR) { const int p = i & 63, to = (i >> 6) & 63, g = (i >> 12) & 15, L = i >> 16;
            const thin::S5P P{ap->in[I_LRE] + L * 1024, ap->in[I_LIM] + L * 1024, ap->in[I_LDT] + L * 16, nullptr, nullptr, ap->in[I_CRE] + L * 16384, ap->in[I_CIM] + L * 16384, nullptr};
            thin::st_carry(P, (bf16_t*)(ws + W_ST) + (size_t)L * 16 * 1024 * SKX, g, to, p); }
        for (int rep = 0; rep < REP_FILL; ++rep) for (long i = (long)bid * NTHR + tid; i < 2L * 16 * 256 * 128; i += (long)G * NTHR) { const int k8 = (int)(i & 127); const long r = i >> 7; const int n = (int)(r & 255), g = (int)((r >> 8) & 15), L = (int)(r >> 12);
            const thin::S5P P{ap->in[I_LRE] + L * 1024, ap->in[I_LIM] + L * 1024, ap->in[I_LDT] + L * 16, ap->in[I_BRE] + L * 16384, ap->in[I_BIM] + L * 16384, nullptr, nullptr, nullptr};
            thin::sz_fill8(P, (bf16_t*)(ws + W_SZ) + (size_t)L * 16 * 256 * 1024, g, n, 8 * k8); }
    }

    for (int layer = 0; layer < NLAYER; ++layer) {
        const int pb = 2 + layer * PH_PER_LAYER;
        if (hi <= pb || lo >= pb + PH_PER_LAYER) continue;
        if (IN(pb + 0) && PHON(0)) { PHASE_IDS
            pg8::TileOrder S; S.init(MTOK / 256, PROJP / 256, 1, G, bid, HB, (size_t)256 * DM * 2, 0, ws + W_IN + (size_t)layer * PROJP * DM * 2, (size_t)256 * DM * 2, 0);
            epi::EpiWin E{SS + (size_t)(3 * layer) * MTOK, UX, CVIN, Q, KC, VC, KS, KW, VST, VWT, GATE, ap->in[I_QNORM] + layer * 64, ap->in[I_KNORM] + layer * 192};
            for (int rep = 0; rep < REP_WIN; ++rep) pg8::gemm_phase<epi::EpiWin, pg8::TileOrder, true>(lds, pg8::Gemm{DM, DM, DM}, S, E, tid);
        }
        SEAM(pb + 0);
        if (IN(pb + 1) && PHON(1)) { PHASE_IDS
            { pg8::TileOrder S; S.init(4, 1, 16, G, bid, UX + 128, (size_t)256 * SKX * 2, (size_t)NCHUNK * SKX * 2, ws + W_SZ + (size_t)layer * 16 * 256 * 1024 * 2, (size_t)256 * 1024 * 2, (size_t)256 * 1024 * 2);
              epi::EpiS5State E{ZC};
              for (int rep = 0; rep < REP_GEMM; ++rep) pg8::gemm_phase<epi::EpiS5State, pg8::TileOrder, false>(lds, pg8::Gemm{1024, SKX, 1024}, S, E, tid); }
            if (layer == 0) {
              pg8::TileOrder S; S.init(8, 2, 2, G, (bid + G - 128 % G) % G, ws + T_MEMB, (size_t)256 * DM * 2, 0, ws + W_XKV, (size_t)256 * DM * 2, (size_t)512 * DM * 2);
              epi::EpiMemKV E{SSMEM, (bf16_t*)(ws + T_KM), (bf16_t*)(ws + T_VMT), ap->in[I_XKN]};
              pg8::gemm_phase<epi::EpiMemKV, pg8::TileOrder, false>(lds, pg8::Gemm{DM, DM, DM}, S, E, tid); }
            __syncthreads();
            for (int rep = 0; rep < REP_THIN; ++rep) for (int tk = (gw + NGW - 512 % NGW) % NGW; tk < 512; tk += NGW) { const int which = tk >> 8, plane = (tk >> 4) & 15, n0 = (tk & 15) * 32; const int lk = layer * 2 + which;
                att::compress_task(which, plane, n0, which ? VC : KC, (const bf16_t*)(ws + W_C1) + (size_t)lk * 64 * 2048, (const float*)(ws + T_CB) + lk * 64, (const bf16_t*)(ws + W_C2) + (size_t)lk * 64 * 64,
                                   ap->in[I_KNORM] + layer * 192, KCMP, VCMPT, lane); }
            { const int nu = MTOK / 64, rstat = (nu / G > 2) ? nu / G - 2 : 0;
              unsigned* ctr = (unsigned*)(ws + CTL_MOE + 524288) + layer * 64 + 32;
              volatile LAS unsigned* dq = (volatile LAS unsigned*)(lds + LDS_MISC + 128);
#pragma unroll 1
              for (int round = 0;; ++round) { int u;
                if (round < rstat) u = bid + round * G;
                else { __syncthreads(); if (tid == 0) *dq = (unsigned)(rstat * G) + __hip_atomic_fetch_add(ctr, 1u, __ATOMIC_RELAXED, __HIP_MEMORY_SCOPE_AGENT); __syncthreads(); u = (int)*dq; }
                if (u >= nu) break;
                thin::conv_unit(lds, u, CVIN, ap->in[I_CWDW] + layer * 31 * 256, ap->in[I_CBDW] + layer * 256, ap->in[I_CLNG] + layer * 256, ap->in[I_CLNB] + layer * 256, CV, tid); } }
        }
        SEAM(pb + 1);
        if (IN(pb + 2) && PHON(2)) { PHASE_IDS
            for (int rep = 0; rep < REP_THIN; ++rep) if (bid < 16) thin::s5_combine((const float*)(ws + T_A64) + layer * 2048, ZC, UX, bid * NTHR + tid);
            { pg8::TileOrder S; S.init(MTOK / 256, 1, 1, G, bid, CV, (size_t)256 * 256 * 2, 0, ws + W_PW + (size_t)layer * 256 * 256 * 2, (size_t)256 * 256 * 2, 0);
              epi::EpiPlain E{YCONV, 256};
              for (int rep = 0; rep < REP_GEMM; ++rep) pg8::gemm_phase<epi::EpiPlain, pg8::TileOrder, false>(lds, pg8::Gemm{256, 256, 256}, S, E, tid); }
            for (int i = tid; i < 8 * 132; i += NTHR) ((LAS float*)(lds + att::L_BIAS))[i] = ((const float*)(ws + T_BIAS))[i];
            att::build_ovt(lds, tid);
            __syncthreads();
            for (int rep = 0; rep < REP_CMP; ++rep) for (int u = bid; u < 2048; u += G) { const int c = 127 - (u >> 4), pl = u & 15; int lf_; asm volatile("v_mbcnt_lo_u32_b32 %0, -1, 0\n\tv_mbcnt_hi_u32_b32 %0, -1, %0" : "=v"(lf_)); att::cmp_unit(lds, pl >> 1, pl & 1, c, Q, KCMP, VCMPT, OC, SEL, (const float*)(ws + T_BND) + layer * 32 + 0, wid * 64 + lf_); }
            __syncthreads();
            att::fill_xt((LAS float*)(lds + att::L_IMP), (const LAS float*)(lds + att::L_BIAS), att::XT_WIN, 512, tid);
            __syncthreads();
            for (int rep = 0; rep < REP_ATT; ++rep) for (int u = bid; u < 2048; u += G) { const int c = 127 - (u >> 4), pl = u & 15; int lf_; asm volatile("v_mbcnt_lo_u32_b32 %0, -1, 0\n\tv_mbcnt_hi_u32_b32 %0, -1, %0" : "=v"(lf_)); att::window_unit(lds, pl >> 1, pl & 1, c, Q, KW, VWT, OW, (const float*)(ws + T_BND) + layer * 32 + 16, wid * 64 + lf_); }
        }
        SEAM(pb + 2);
        if (IN(pb + 3) && PHON(3)) { PHASE_IDS
            { pg8::TileOrder S; S.init(4, 4, 16, G, bid, UX, (size_t)256 * SKX * 2, (size_t)NCHUNK * SKX * 2, ws + W_ST + (size_t)layer * 16 * 1024 * SKX * 2, (size_t)256 * SKX * 2, (size_t)1024 * SKX * 2);
              epi::EpiS5Out E{YG};
              for (int rep = 0; rep < REP_GEMM; ++rep) pg8::gemm_phase<epi::EpiS5Out, pg8::TileOrder, false>(lds, pg8::Gemm{SKX, SKX, SKX}, S, E, tid); }
            __syncthreads();
            { float tbv[3];
#pragma unroll
              for (int q = 0; q < 3; ++q) { const int i = tid + 512 * q; tbv[q] = i < 8 * 132 ? ((const float*)(ws + T_BIAS))[i] : 0.f; }
#pragma unroll
              for (int q = 0; q < 3; ++q) { const int i = tid + 512 * q; if (i < 8 * 132) ((LAS float*)(lds + att::SP_BIAS))[i] = tbv[q]; } }
            __syncthreads();
            att::fill_xt((LAS float*)(lds + att::SP_END), (const LAS float*)(lds + att::SP_BIAS), att::XT_SEL, 1 << 30, tid);
            __syncthreads();
            { const int nstat = (2048 / G > TAIL_R) ? (2048 / G - TAIL_R) * G : 0;
              for (int u = bid; u < nstat; u += G) { const int c = 127 - (u >> 4), pl = u & 15; int lf_; asm volatile("v_mbcnt_lo_u32_b32 %0, -1, 0\n\tv_mbcnt_hi_u32_b32 %0, -1, %0" : "=v"(lf_));
                att::sel_sparse_unit(lds, pl >> 1, pl & 1, c, Q, KS, VST, SEL, OS, (const float*)(ws + T_BND) + layer * 32 + 8, wid * 64 + lf_); }
              unsigned* ctr = (unsigned*)(ws + CTL_MOE + 524288) + layer * 64;
              volatile LAS unsigned* dq = (volatile LAS unsigned*)(lds + LDS_MISC + 128);
              for (;;) {
                __syncthreads();
                if (tid == 0) *dq = (unsigned)nstat + __hip_atomic_fetch_add(ctr, 1u, __ATOMIC_RELAXED, __HIP_MEMORY_SCOPE_AGENT);
                __syncthreads();
                const int u = (int)*dq; if (u >= 2048) break;
                const int c = 127 - (u >> 4), pl = u & 15; int lf_; asm volatile("v_mbcnt_lo_u32_b32 %0, -1, 0\n\tv_mbcnt_hi_u32_b32 %0, -1, %0" : "=v"(lf_));
                att::sel_sparse_unit(lds, pl >> 1, pl & 1, c, Q, KS, VST, SEL, OS, (const float*)(ws + T_BND) + layer * 32 + 8, wid * 64 + lf_); } }
        }
        SEAM(pb + 3);
        if (IN(pb + 4) && PHON(4)) { PHASE_IDS
            pg8::TileOrder S; S.init(MTOK / 256, 2, 1, G, bid, YG, (size_t)256 * 256 * 2, 0, ws + W_GLU + (size_t)layer * 512 * 256 * 2, (size_t)256 * 256 * 2, 0);
            epi::EpiGate<0> E{YSSM, 256, nullptr, nullptr};
            for (int rep = 0; rep < REP_GEMM; ++rep) pg8::gemm_phase<epi::EpiGate<0>, pg8::TileOrder, true>(lds, pg8::Gemm{256, 256, 256}, S, E, tid);
        }
        SEAM(pb + 4);
        if (IN(pb + 5) && PHON(5)) { PHASE_IDS if ((WOUT_F8 >> layer) & 1) { for (int r = 2 * gw; r < MTOK; r += 2 * NGW) thin::mixnorm_row2<true>(r, YSSM, YCONV, OC, OS, OW, GATE, AMIX, lane); }
            else for (int rep = 0; rep < REP_MIX; ++rep) for (int r = 2 * gw; r < MTOK; r += 2 * NGW) thin::mixnorm_row2<false>(r, YSSM, YCONV, OC, OS, OW, GATE, AMIX, lane); }
        SEAM(pb + 5);
        if (IN(pb + 6) && PHON(6)) { PHASE_IDS
            if ((WOUT_F8 >> layer) & 1) {
            pg8::TileOrder S; S.init(MTOK / 256, 4, 1, G, bid, AMIX, (size_t)256 * DM, 0, ws + W_OUT + (size_t)layer * DM * DM * 2, (size_t)256 * DM, 0);
            epi::EpiRes<false, true> E{HB, nullptr, HB, SS + (size_t)(3 * layer + 1) * MTOK, nullptr, nullptr, 1.0f / W8_SCALE, nullptr};
            pg8::gemm_phase<epi::EpiRes<false, true>, pg8::TileOrder, true, true>(lds, pg8::Gemm{DM / 2, DM / 2, DM / 2}, S, E, tid);
            } else {
            pg8::TileOrder S; S.init(MTOK / 256, 4, 1, G, bid, AMIX, (size_t)256 * DM * 2, 0, ws + W_OUT + (size_t)layer * DM * DM * 2, (size_t)256 * DM * 2, 0);
            epi::EpiRes<false, true> E{HB, nullptr, HB, SS + (size_t)(3 * layer + 1) * MTOK, nullptr, nullptr, 1.f, nullptr};
            pg8::gemm_phase<epi::EpiRes<false, true>, pg8::TileOrder, true>(lds, pg8::Gemm{DM, DM, DM}, S, E, tid);
            }
        }
        SEAM(pb + 6);
        if (IN(pb + 7) && PHON(7)) { PHASE_IDS
            pg8::TileOrder S; S.init(MTOK / 256, 1, 1, G, bid, HB, (size_t)256 * DM * 2, 0, ws + W_XQ + (size_t)layer * XW * DM * 2, (size_t)256 * DM * 2, 0);
            epi::EpiXQ E{SS + (size_t)(3 * layer + 1) * MTOK, QX, ap->in[I_XQN] + layer * 64};
            for (int rep = 0; rep < REP_GEMM; ++rep) pg8::gemm_phase<epi::EpiXQ, pg8::TileOrder, false>(lds, pg8::Gemm{DM, DM, DM}, S, E, tid);
        }
        SEAM(pb + 7);
        if (IN(pb + 8) && PHON(8)) { PHASE_IDS
            __syncthreads();
            for (int rep = 0; rep < REP_ATT; ++rep) for (int u = bid; u < 1024; u += G) { const int qt = u & 31, h = (u >> 5) & 3, b = u >> 7;
                att::cross_unit(lds, b, h, qt, QX, (const bf16_t*)(ws + T_KM) + (size_t)layer * 8 * 4 * 256 * 64, (const bf16_t*)(ws + T_VMT) + (size_t)layer * 8 * 4 * 64 * 256, OX, (const float*)(ws + T_BND) + layer * 32 + 24, tid); }
        }
        SEAM(pb + 8);
        if (IN(pb + 9) && PHON(9)) { PHASE_IDS
            pg8::TileOrder S; S.init(MTOK / 256, 4, 1, G, bid, OX, (size_t)256 * XW * 2, 0, ws + W_XO + (size_t)layer * DM * XW * 2, (size_t)256 * XW * 2, 0);
            epi::EpiRes<false, true> E{HB, nullptr, HB, SS + (size_t)(3 * layer + 2) * MTOK, nullptr, nullptr, 1.f, ws + A_H8};
            pg8::gemm_phase<epi::EpiRes<false, true>, pg8::TileOrder, true>(lds, pg8::Gemm{XW, XW, XW}, S, E, tid);
        }
        SEAM(pb + 9);
        if (layer == 0) {
            if (IN(pb + 10) && PHON(10)) { PHASE_IDS
                pg8::TileOrder S; S.init(MTOK / 256, 2 * DFF / 256, 1, G, bid, ws + A_H8, (size_t)256 * DM, 0, ws + W_UP, (size_t)256 * DM, 0);
                epi::EpiGate<1, true> E{FFA, DFF, SS + (size_t)2 * MTOK, nullptr};
                pg8::gemm_phase<epi::EpiGate<1, true>, pg8::TileOrder, true, true>(lds, pg8::Gemm{DM / 2, DM / 2, DM / 2}, S, E, tid);
            }
            SEAM(pb + 10);
            if (IN(pb + 11) && PHON(11)) { PHASE_IDS
                pg8::TileOrder S; S.init(MTOK / 256, 4, 1, G, bid, FFA, (size_t)256 * DFF, 0, ws + W_DN, (size_t)256 * DFF, 0);
                epi::EpiRes<false, true> E{HB, nullptr, HB, SS + (size_t)3 * MTOK, nullptr, nullptr, 1.0f / W8_SCALE, nullptr};
                pg8::gemm_phase<epi::EpiRes<false, true>, pg8::TileOrder, true, true>(lds, pg8::Gemm{DFF / 2, DFF / 2, DFF / 2}, S, E, tid);
            }
            if (IN(pb + 11) && IN(pb + PH_PER_LAYER)) xcd_barrier(bar);
        } else {
#define MK_ROUTE int* mi = (int*)(ws + T_ROUTE); const moe::Route R{(int*)(ws + CTL_MOE), (int*)(ws + CTL_MOE + 65536), mi, mi + 2 * MTOK, (float*)(mi + 4 * MTOK), mi + 6 * MTOK, (float*)(mi + 6 * MTOK + 2 * MOEROWS)};
            if (IN(pb + 10) && PHON(10)) { PHASE_IDS MK_ROUTE
                __syncthreads();
                moe::load_router(lds, ap->in[I_ROUTER], ap->in[I_NFFN] + DM, tid);
                __syncthreads();
                for (int rep = 0; rep < REP_THIN; ++rep) for (int ch = bid; ch < moe::NCHK; ch += G) moe::route1_chunk(lds, ch, HB, SS + (size_t)5 * MTOK, R, tid);
            }
            SEAM(pb + 10);
            if (IN(pb + 11) && PHON(11)) { PHASE_IDS MK_ROUTE for (int rep = 0; rep < REP_THIN; ++rep) moe::route2(lds, R, G, tid); }
            SEAM(pb + 11);
            if (IN(pb + 12) && PHON(12)) { PHASE_IDS MK_ROUTE for (int rep = 0; rep < REP_GA; ++rep) moe::gather_rows(R, 0, ws + A_H8, ws + A_XB, gw, NGW, lane); }
            SEAM(pb + 12);
#pragma unroll 1
            for (int s = 0; s < 2; ++s) {
                if (IN(pb + 13 + 2 * s) && PHON(13)) { PHASE_IDS MK_ROUTE
                    moe::MoeOrder S; S.init(R.startp + s * 16, 2 * DFF / 256, G, bid, XB, (size_t)256 * DM, ws + W_MUP, (size_t)256 * DM, (size_t)2 * DFF * DM);
                    epi::EpiGate<2, true> E{FFA, DFF, SS + (size_t)5 * MTOK, R.row_tok + (size_t)s * MOEROWS};
                    pg8::gemm_phase<epi::EpiGate<2, true>, moe::MoeOrder, true, true>(lds, pg8::Gemm{DM / 2, DM / 2, DM / 2}, S, E, tid);
                }
                SEAM(pb + 13 + 2 * s);
                if (IN(pb + 14 + 2 * s) && PHON(14)) { PHASE_IDS MK_ROUTE
                    moe::MoeOrder S; S.init(R.startp + s * 16, 4, G, bid, FFA, (size_t)256 * DFF, ws + W_MDN, (size_t)256 * DFF, (size_t)DM * DFF);
                    epi::EpiRes<true, false> E{HB, s == 1 ? out : nullptr, s == 0 ? HB : nullptr, nullptr, R.row_tok + (size_t)s * MOEROWS, R.row_gate + (size_t)s * MOEROWS, 1.0f / W8_SCALE, nullptr};
                    pg8::gemm_phase<epi::EpiRes<true, false>, moe::MoeOrder, true, true>(lds, pg8::Gemm{DFF / 2, DFF / 2, DFF / 2}, S, E, tid);
                    if (s == 0) for (int rep = 0; rep < REP_GA; ++rep) moe::gather_rows(R, 1, ws + A_H8, ws + A_XB, gw, NGW, lane);
                }
                if (s == 0) SEAM(pb + 14);
            }
        }
    }
#undef IN
#undef SEAM
}

extern "C" void kernel_launch(void* const* d_in, const int* in_sizes, int n_in, void* d_out, int out_size, void* d_ws, size_t ws_size, hipStream_t stream) {
    static int grid = 0;
    if (grid == 0) {
        if (n_in != N_IN || in_sizes[0] != MTOK * DM || out_size != MTOK * DM || ws_size < WS_END) {
            fprintf(stderr, "kernel_launch: built for %d inputs, x/out of %d floats and >= %zu bytes of workspace; got n_in %d, in0 %d, out %d, ws %zu; nothing launched\n", N_IN, MTOK * DM, (size_t)WS_END, n_in, n_in > 0 ? in_sizes[0] : -1, out_size, ws_size);
            grid = -1; return; }
        int dev = 0, cus = 0, per_cu = 0;
        if (hipGetDevice(&dev) != hipSuccess || hipDeviceGetAttribute(&cus, hipDeviceAttributeMultiprocessorCount, dev) != hipSuccess) { grid = -1; return; }
        if (hipFuncSetAttribute((const void*)trunk_fwd, hipFuncAttributeMaxDynamicSharedMemorySize, LDS_BYTES) != hipSuccess) { fprintf(stderr, "kernel_launch: hipFuncSetAttribute failed\n"); grid = -1; return; }
        if (hipOccupancyMaxActiveBlocksPerMultiprocessor(&per_cu, (const void*)trunk_fwd, NTHR, LDS_BYTES) != hipSuccess || per_cu < 1) { fprintf(stderr, "kernel_launch: occupancy query says %d workgroups per CU\n", per_cu); (void)hipGetLastError(); grid = -1; return; }
        grid = cus;
        if (grid > 256) grid = 256;
    }
    if (grid < 0) return;
    unsigned char* ws = (unsigned char*)d_ws;
    (void)hipMemsetAsync(ws + WS_CTL, 0, CTL_ZERO_BYTES, stream);
    Args a{};
    for (int i = 0; i < N_IN; ++i) a.in[i] = (const float*)d_in[i];
    a.out = (float*)d_out; a.ws = ws;
#if MK_N_LAUNCHES == 1
    a.ph_lo = 0; a.ph_hi = N_PHASES;
    hipLaunchKernelGGL(trunk_fwd, dim3(grid), dim3(NTHR), LDS_BYTES, stream, a);
#else
    for (int p = 0; p < N_PHASES; ++p) {
        if (p >= 2 && p < 2 + PH_PER_LAYER && (p - 2) >= 12) continue;
        a.ph_lo = p; a.ph_hi = p + 1;
        hipLaunchKernelGGL(trunk_fwd, dim3(grid), dim3(NTHR), LDS_BYTES, stream, a);
    }
#endif
    const hipError_t le = hipPeekAtLastError();
    if (le != hipSuccess) fprintf(stderr, "kernel_launch: launch failed: %s (grid %d x %d threads, %d B LDS)\n", hipGetErrorName(le), grid, NTHR, LDS_BYTES);
}
```
